# Optimizing an MI355X kernel written in HIP

```python
import jax, jax.numpy as jnp
from jax import lax
import numpy as np

D_MODEL = 2048
BATCH = 1
SEQ = 8192
DEPTH = 1

D_POOL = D_MODEL // 2
POOL_WINDOWS = (2, 4, 8, 16)
POOL_GROUPS = len(POOL_WINDOWS)
POOL_GW = D_POOL // POOL_GROUPS
D_HGRN = D_MODEL // 2
HGRN_HEAD_DIM = 128
HGRN_HEADS = D_HGRN // HGRN_HEAD_DIM
CHUNK = 64
D_IN = D_POOL + 4 * D_HGRN + 2 * D_MODEL
D_FF = ((8 * D_MODEL // 3 + 127) // 128) * 128
CONV_WIDTH = 3
PLE_DIM = 256
EPS = 1e-6

kernel_name = "hybrid_pool_hgrn2_gated_block"


def rms_norm(x, w):
    xf = x.astype(jnp.float32)
    y = xf * lax.rsqrt(jnp.mean(xf * xf, axis=-1, keepdims=True) + EPS)
    return (y * w.astype(jnp.float32)).astype(x.dtype)


def multiscale_pool(u, w_mix, scale):
    B, S, _ = u.shape
    uf = u.astype(jnp.float32)
    cs0 = jnp.concatenate([jnp.zeros((B, 1, D_POOL), jnp.float32), jnp.cumsum(uf, axis=1)], axis=1)
    pos = jnp.arange(1, S + 1, dtype=jnp.float32)
    outs = []
    for g, w in enumerate(POOL_WINDOWS):
        c0 = cs0[..., g * POOL_GW:(g + 1) * POOL_GW]
        upper = c0[:, 1:]
        lower = jnp.concatenate([jnp.zeros((B, w - 1, POOL_GW), jnp.float32), c0[:, :S - w + 1]], axis=1)
        cnt = jnp.minimum(pos, float(w))[None, :, None]
        outs.append((upper - lower) / cnt)
    pooled = jnp.stack(outs, axis=2)
    d = (pooled - uf.reshape(B, S, POOL_GROUPS, POOL_GW)).astype(u.dtype)
    y = jnp.einsum('bsgc,gcd->bsgd', d, w_mix).reshape(B, S, D_POOL)
    return y * scale


def hgrn2(q, f_logit, inp, g, lb, norm_w):
    B, S, _ = q.shape
    H, Dh, C = HGRN_HEADS, HGRN_HEAD_DIM, CHUNK
    N = S // C
    f32 = jnp.float32
    lbf = lb.astype(f32)
    fl = f_logit.astype(f32)
    f = lbf + (1.0 - lbf) * jax.nn.sigmoid(fl)
    log_f = jnp.log(f)
    k = (1.0 - lbf) * jax.nn.sigmoid(-fl)

    def to_chunks(t):
        t = t.astype(f32).reshape(B, N, C, H, Dh)
        return jnp.transpose(t, (1, 0, 3, 2, 4))

    qc, kc, vc = to_chunks(q), to_chunks(k), to_chunks(inp)
    bc = jnp.cumsum(to_chunks(log_f), axis=-2)
    mask = jnp.tril(jnp.ones((C, C), dtype=bool))[:, :, None]

    def step(state, xs):
        q_, k_, v_, b_ = xs
        o_inter = jnp.einsum('bhtk,bhkv->bhtv', q_ * jnp.exp(b_), state)
        diff = b_[:, :, :, None, :] - b_[:, :, None, :, :]
        decay = jnp.exp(jnp.where(mask, diff, -jnp.inf))
        scores = jnp.einsum('bhtk,bhtsk,bhsk->bhts', q_, decay, k_)
        o = o_inter + jnp.einsum('bhts,bhsv->bhtv', scores, v_)
        b_last = b_[:, :, -1:, :]
        new_state = jnp.exp(b_last[:, :, 0, :])[..., None] * state + \
            jnp.einsum('bhsk,bhsv->bhkv', k_ * jnp.exp(b_last - b_), v_)
        return new_state, o

    state0 = jnp.zeros((B, H, Dh, Dh), f32)
    _, o = lax.scan(step, state0, (qc, kc, vc, bc))
    o = jnp.transpose(o, (1, 0, 3, 2, 4)).reshape(B, S, H, Dh)
    o = o * lax.rsqrt(jnp.mean(o * o, axis=-1, keepdims=True) + EPS)
    o = o * norm_w.astype(f32).reshape(H, Dh)
    o = o.reshape(B, S, D_HGRN) * jax.nn.silu(g.astype(f32))
    return o.astype(q.dtype)


def causal_depthwise_conv(z, w, b):
    S = z.shape[1]
    zp = jnp.pad(z, ((0, 0), (CONV_WIDTH - 1, 0), (0, 0)))
    y = b
    for j in range(CONV_WIDTH):
        y = y + w[j] * zp[:, j:j + S]
    return y


def setup_inputs(seed: int = 0) -> dict:
    key = jax.random.key(seed)
    ks = jax.random.split(key, 24)
    f32 = jnp.float32

    def nrm(k, shape, scale):
        return jax.random.normal(k, shape, f32) * scale

    L = DEPTH
    return {
        "x": nrm(ks[0], (BATCH, SEQ, D_MODEL), 1.0),
        "p": nrm(ks[1], (DEPTH, BATCH, SEQ, PLE_DIM), 1.0),
        "ln_mix_w": 1.0 + nrm(ks[2], (L, D_MODEL), 0.02),
        "w_in": nrm(ks[3], (L, D_MODEL, D_IN), D_MODEL ** -0.5),
        "pool_mix_w": nrm(ks[4], (L, POOL_GROUPS, POOL_GW, POOL_GW), POOL_GW ** -0.5),
        "pool_scale": 1.0 + nrm(ks[5], (L, D_POOL), 0.02),
        "hgrn_lb_logits": nrm(ks[6], (DEPTH + 1, D_HGRN), 0.1),
        "hgrn_norm_w": 1.0 + nrm(ks[7], (L, D_HGRN), 0.02),
        "w_branch_a": nrm(ks[8], (L, D_POOL, D_MODEL), D_POOL ** -0.5),
        "w_branch_b": nrm(ks[9], (L, D_HGRN, D_MODEL), D_HGRN ** -0.5),
        "w_out": nrm(ks[10], (L, D_MODEL, D_MODEL), D_MODEL ** -0.5),
        "ln_ffn_w": 1.0 + nrm(ks[11], (L, D_MODEL), 0.02),
        "w_up": nrm(ks[12], (L, D_MODEL, 2 * D_FF), D_MODEL ** -0.5),
        "conv_w": nrm(ks[13], (L, CONV_WIDTH, 2 * D_FF), CONV_WIDTH ** -0.5),
        "conv_b": nrm(ks[14], (L, 2 * D_FF), 0.01),
        "w_down": nrm(ks[15], (L, D_FF, D_MODEL), D_FF ** -0.5),
        "ln_ple_w": 1.0 + nrm(ks[16], (L, D_MODEL), 0.02),
        "w_ple_gate": nrm(ks[17], (L, D_MODEL, D_MODEL), D_MODEL ** -0.5),
        "w_ple": nrm(ks[18], (L, PLE_DIM, D_MODEL), PLE_DIM ** -0.5),
        "ln_final_w": 1.0 + nrm(ks[19], (D_MODEL,), 0.02),
    }


def reference(x, p, ln_mix_w, w_in, pool_mix_w, pool_scale, hgrn_lb_logits, hgrn_norm_w,
              w_branch_a, w_branch_b, w_out, ln_ffn_w, w_up, conv_w, conv_b, w_down,
              ln_ple_w, w_ple_gate, w_ple, ln_final_w):
    lb_all = jnp.cumsum(jax.nn.softmax(hgrn_lb_logits.astype(jnp.float32), axis=0), axis=0)
    split_idx = [D_POOL + j * D_HGRN for j in range(5)] + [D_POOL + 4 * D_HGRN + D_MODEL]
    for i in range(DEPTH):
        h = rms_norm(x, ln_mix_w[i])
        proj = h @ w_in[i]
        u_pool, q, f_logit, inp, g, gate_a, gate_b = jnp.split(proj, split_idx, axis=-1)
        y_a = multiscale_pool(u_pool, pool_mix_w[i], pool_scale[i]) @ w_branch_a[i]
        y_b = hgrn2(q, f_logit, inp, g, lb_all[i], hgrn_norm_w[i]) @ w_branch_b[i]
        merged = jax.nn.sigmoid(gate_a) * y_a + jax.nn.sigmoid(gate_b) * y_b
        x = x + merged @ w_out[i]
        h2 = rms_norm(x, ln_ffn_w[i])
        u = causal_depthwise_conv(h2 @ w_up[i], conv_w[i], conv_b[i])
        u_gate, u_val = jnp.split(u, 2, axis=-1)
        x = x + (jax.nn.silu(u_gate) * u_val) @ w_down[i]
        h3 = rms_norm(x, ln_ple_w[i])
        x = x + jax.nn.sigmoid(h3 @ w_ple_gate[i]) * (p[i] @ w_ple[i])
    return rms_norm(x, ln_final_w)
```

```cpp
#include <hip/hip_runtime.h>
#include <cstdio>
#include <cstdint>

namespace gold {
constexpr int S = 8192, DM = 2048, DP = 1024, DH = 1024, DIN = 9216, DFF = 5504, DFF2 = 11008, PLE = 256;
constexpr float EPS = 1e-6f;
constexpr int TB = 1024;

__device__ __forceinline__ float sigmoidf_(float v) { return 1.0f / (1.0f + __expf(-v)); }
__device__ __forceinline__ float wave_sum(float v) {
#pragma unroll
    for (int o = 32; o >= 1; o >>= 1) v += __shfl_xor(v, o);
    return v;
}

__global__ void k_rowscale(const float* __restrict__ x, float* __restrict__ r, int rows, int cols) {
    const int row = blockIdx.x * (blockDim.x >> 6) + (threadIdx.x >> 6), lane = threadIdx.x & 63;
    if (row >= rows) return;
    float s = 0.f;
    for (int c = lane; c < cols; c += 64) { const float v = x[(size_t)row * cols + c]; s += v * v; }
    s = wave_sum(s);
    if (lane == 0) r[row] = rsqrtf(s / (float)cols + EPS);
}

__global__ void __launch_bounds__(256) k_gemm(const float* __restrict__ A, int lda, const float* __restrict__ rs, const float* __restrict__ kw,
                                             const float* __restrict__ B, int ldb, float* __restrict__ C, int ldc,
                                             const float* __restrict__ base, int ldbase, int K) {
    __shared__ float As[16][65];
    __shared__ float Bs[16][64];
    const int tx = threadIdx.x & 15, ty = threadIdx.x >> 4;
    const int m0 = blockIdx.y * 64, n0 = blockIdx.x * 64;
    float acc[4][4] = {};
    for (int k0 = 0; k0 < K; k0 += 16) {
        for (int i = threadIdx.x; i < 64 * 16; i += 256) {
            const int mm = i >> 4, kk = i & 15;
            float a = A[(size_t)(m0 + mm) * lda + k0 + kk];
            if (rs) a *= rs[m0 + mm];
            if (kw) a *= kw[k0 + kk];
            As[kk][mm] = a;
        }
        for (int i = threadIdx.x; i < 16 * 64; i += 256) {
            const int kk = i >> 6, nn = i & 63;
            Bs[kk][nn] = B[(size_t)(k0 + kk) * ldb + n0 + nn];
        }
        __syncthreads();
#pragma unroll
        for (int kk = 0; kk < 16; ++kk) {
            float a[4], b[4];
#pragma unroll
            for (int i = 0; i < 4; ++i) a[i] = As[kk][ty * 4 + i];
#pragma unroll
            for (int j = 0; j < 4; ++j) b[j] = Bs[kk][tx * 4 + j];
#pragma unroll
            for (int i = 0; i < 4; ++i)
#pragma unroll
                for (int j = 0; j < 4; ++j) acc[i][j] += a[i] * b[j];
        }
        __syncthreads();
    }
#pragma unroll
    for (int i = 0; i < 4; ++i)
#pragma unroll
        for (int j = 0; j < 4; ++j) {
            const int m = m0 + ty * 4 + i, n = n0 + tx * 4 + j;
            float v = acc[i][j];
            if (base) v += base[(size_t)m * ldbase + n];
            C[(size_t)m * ldc + n] = v;
        }
}

__global__ void k_copy_upool(const float* __restrict__ proj, float* __restrict__ upall, int t0) {
    const size_t i = (size_t)blockIdx.x * blockDim.x + threadIdx.x;
    if (i >= (size_t)TB * DP) return;
    const int t = (int)(i / DP), c = (int)(i % DP);
    upall[(size_t)(t0 + t) * DP + c] = proj[(size_t)t * DIN + c];
}
__global__ void k_pool(const float* __restrict__ upall, float* __restrict__ d, int t0) {
    const size_t i = (size_t)blockIdx.x * blockDim.x + threadIdx.x;
    if (i >= (size_t)TB * DP) return;
    const int tl = (int)(i / DP), c = (int)(i % DP), t = t0 + tl;
    const int g = c >> 8, w = 2 << g;
    float s = 0.f; int cnt = 0;
    for (int j = 0; j < w; ++j) { if (t - j >= 0) { s += upall[(size_t)(t - j) * DP + c]; ++cnt; } }
    d[(size_t)tl * DP + c] = s / (float)cnt - upall[(size_t)t * DP + c];
}
__global__ void k_colscale(float* __restrict__ y, const float* __restrict__ scale, int rows, int cols) {
    const size_t i = (size_t)blockIdx.x * blockDim.x + threadIdx.x;
    if (i >= (size_t)rows * cols) return;
    y[i] *= scale[i % cols];
}
__global__ void k_zero(float* p, size_t n) { const size_t i = (size_t)blockIdx.x * blockDim.x + threadIdx.x; if (i < n) p[i] = 0.f; }

__global__ void __launch_bounds__(512) k_hgrn(const float* __restrict__ proj, const float* __restrict__ lbl, float* __restrict__ state, float* __restrict__ oraw, int ntok) {
    __shared__ float red[2][8];
    const int h = blockIdx.x >> 5, vs = blockIdx.x & 31, tid = threadIdx.x, k = tid & 127, vv = tid >> 7, wave = tid >> 6, lane = tid & 63;
    const int ck = h * 128 + k, cv = h * 128 + vs * 4 + vv;
    const float l0 = lbl[ck], l1 = lbl[DH + ck];
    const float mx = fmaxf(l0, l1), e0 = __expf(l0 - mx), e1 = __expf(l1 - mx), lb = e0 / (e0 + e1);
    float Sst = state[((size_t)h * 128 + k) * 128 + vs * 4 + vv];
    for (int t = 0; t < ntok; ++t) {
        const float* row = proj + (size_t)t * DIN;
        const float q = row[DP + ck], fl = row[DP + DH + ck], iv = row[DP + 2 * DH + cv];
        const float sg = sigmoidf_(fl);
        const float f = lb + (1.f - lb) * sg, kk = (1.f - lb) * (1.f - sg);
        Sst = f * Sst + kk * iv;
        float pr = wave_sum(Sst * q);
        if (lane == 0) red[t & 1][wave] = pr;
        __syncthreads();
        if (tid < 4) oraw[(size_t)t * DH + h * 128 + vs * 4 + tid] = red[t & 1][2 * tid] + red[t & 1][2 * tid + 1];
    }
    state[((size_t)h * 128 + k) * 128 + vs * 4 + vv] = Sst;
}
__global__ void k_hgrn_norm(const float* __restrict__ oraw, const float* __restrict__ proj, const float* __restrict__ nw, float* __restrict__ ob) {
    const int idx = blockIdx.x * (blockDim.x >> 6) + (threadIdx.x >> 6), lane = threadIdx.x & 63;
    if (idx >= TB * 8) return;
    const int t = idx >> 3, h = idx & 7;
    const float a = oraw[(size_t)t * DH + h * 128 + lane], b = oraw[(size_t)t * DH + h * 128 + 64 + lane];
    const float r = rsqrtf(wave_sum(a * a + b * b) / 128.f + EPS);
    const float g0 = proj[(size_t)t * DIN + DP + 3 * DH + h * 128 + lane], g1 = proj[(size_t)t * DIN + DP + 3 * DH + h * 128 + 64 + lane];
    ob[(size_t)t * DH + h * 128 + lane] = a * r * nw[h * 128 + lane] * (g0 * sigmoidf_(g0));
    ob[(size_t)t * DH + h * 128 + 64 + lane] = b * r * nw[h * 128 + 64 + lane] * (g1 * sigmoidf_(g1));
}
__global__ void k_merge(const float* __restrict__ proj, const float* __restrict__ ya, const float* __restrict__ yb, float* __restrict__ mg) {
    const size_t i = (size_t)blockIdx.x * blockDim.x + threadIdx.x;
    if (i >= (size_t)TB * DM) return;
    const int t = (int)(i / DM), c = (int)(i % DM);
    const float ga = proj[(size_t)t * DIN + DP + 4 * DH + c], gb = proj[(size_t)t * DIN + DP + 4 * DH + DM + c];
    mg[i] = sigmoidf_(ga) * ya[i] + sigmoidf_(gb) * yb[i];
}
__global__ void k_conv_act(const float* __restrict__ upre, const float* __restrict__ tail, const float* __restrict__ cw, const float* __restrict__ cb, float* __restrict__ act, int t0) {
    const size_t i = (size_t)blockIdx.x * blockDim.x + threadIdx.x;
    if (i >= (size_t)TB * DFF) return;
    const int t = (int)(i / DFF), c = (int)(i % DFF);
    float u[2];
#pragma unroll
    for (int hh = 0; hh < 2; ++hh) {
        const int cc = c + hh * DFF;
        float y = cb[cc];
#pragma unroll
        for (int j = 0; j < 3; ++j) {
            const int tt = t - 2 + j;
            float z;
            if (tt >= 0) z = upre[(size_t)tt * DFF2 + cc];
            else z = (t0 == 0) ? 0.f : tail[(size_t)(tt + 2) * DFF2 + cc];
            y += cw[(size_t)j * DFF2 + cc] * z;
        }
        u[hh] = y;
    }
    act[i] = u[0] * sigmoidf_(u[0]) * u[1];
}
__global__ void k_save_tail(const float* __restrict__ upre, float* __restrict__ tail) {
    const size_t i = (size_t)blockIdx.x * blockDim.x + threadIdx.x;
    if (i >= (size_t)2 * DFF2) return;
    tail[i] = upre[(size_t)(TB - 2) * DFF2 + i];
}
__global__ void k_final(const float* __restrict__ x2, const float* __restrict__ gp, const float* __restrict__ e, const float* __restrict__ wf, float* __restrict__ out) {
    const int row = blockIdx.x * (blockDim.x >> 6) + (threadIdx.x >> 6), lane = threadIdx.x & 63;
    if (row >= TB) return;
    float v[32]; float s = 0.f;
#pragma unroll
    for (int j = 0; j < 32; ++j) { const size_t o = (size_t)row * DM + lane + 64 * j; v[j] = x2[o] + sigmoidf_(gp[o]) * e[o]; s += v[j] * v[j]; }
    const float r = rsqrtf(wave_sum(s) / (float)DM + EPS);
#pragma unroll
    for (int j = 0; j < 32; ++j) { const int c = lane + 64 * j; out[(size_t)row * DM + c] = v[j] * r * wf[c]; }
}
}

extern "C" void kernel_launch(void* const* d_in, const int* in_sizes, int n_in, void* d_out, int out_size, void* d_ws, size_t ws_size, hipStream_t stream) {
    using namespace gold;
    const float* x = (const float*)d_in[0]; const float* p = (const float*)d_in[1]; const float* ln_mix_w = (const float*)d_in[2]; const float* w_in = (const float*)d_in[3];
    const float* pool_mix_w = (const float*)d_in[4]; const float* pool_scale = (const float*)d_in[5]; const float* lbl = (const float*)d_in[6]; const float* hnw = (const float*)d_in[7];
    const float* w_a = (const float*)d_in[8]; const float* w_b = (const float*)d_in[9]; const float* w_out = (const float*)d_in[10]; const float* ln_ffn_w = (const float*)d_in[11];
    const float* w_up = (const float*)d_in[12]; const float* conv_w = (const float*)d_in[13]; const float* conv_b = (const float*)d_in[14]; const float* w_down = (const float*)d_in[15];
    const float* ln_ple_w = (const float*)d_in[16]; const float* w_pg = (const float*)d_in[17]; const float* w_ple = (const float*)d_in[18]; const float* ln_final_w = (const float*)d_in[19];
    float* out = (float*)d_out;
    float* ws = (float*)d_ws; size_t off = 0;
    auto take = [&](size_t n) { float* q = ws + off; off += (n + 63) & ~(size_t)63; return q; };
    float* upall = take((size_t)S * DP);
    float* state = take((size_t)8 * 128 * 128);
    float* tail = take((size_t)2 * DFF2);
    float* r1 = take(TB); float* r2 = take(TB); float* r3 = take(TB);
    float* big = take((size_t)TB * DFF2);
    float* dbuf = take((size_t)TB * DP);
    float* y1 = take((size_t)TB * DP);
    float* ya = take((size_t)TB * DM);
    float* oraw = take((size_t)TB * DH);
    float* ob = take((size_t)TB * DH);
    float* yb = take((size_t)TB * DM);
    float* mg = take((size_t)TB * DM);
    float* x1 = take((size_t)TB * DM);
    float* act = take((size_t)TB * DFF);
    float* x2 = take((size_t)TB * DM);
    float* gp = take((size_t)TB * DM);
    float* eb = take((size_t)TB * DM);
    if (off * 4 > ws_size) { fprintf(stderr, "workspace too small: need %zu have %zu\n", off * 4, ws_size); return; }
    float* proj = big; float* upre = big;

    k_zero<<<(8 * 128 * 128 + 255) / 256, 256, 0, stream>>>(state, (size_t)8 * 128 * 128);
    for (int blk = 0; blk < S / TB; ++blk) {
        const int t0 = blk * TB;
        const float* xb = x + (size_t)t0 * DM;
        k_rowscale<<<TB / 4, 256, 0, stream>>>(xb, r1, TB, DM);
        k_gemm<<<dim3(DIN / 64, TB / 64), 256, 0, stream>>>(xb, DM, r1, ln_mix_w, w_in, DIN, proj, DIN, nullptr, 0, DM);
        k_copy_upool<<<(TB * DP + 255) / 256, 256, 0, stream>>>(proj, upall, t0);
        k_pool<<<(TB * DP + 255) / 256, 256, 0, stream>>>(upall, dbuf, t0);
        for (int g = 0; g < 4; ++g)
            k_gemm<<<dim3(256 / 64, TB / 64), 256, 0, stream>>>(dbuf + g * 256, DP, nullptr, nullptr, pool_mix_w + (size_t)g * 256 * 256, 256, y1 + g * 256, DP, nullptr, 0, 256);
        k_colscale<<<(TB * DP + 255) / 256, 256, 0, stream>>>(y1, pool_scale, TB, DP);
        k_gemm<<<dim3(DM / 64, TB / 64), 256, 0, stream>>>(y1, DP, nullptr, nullptr, w_a, DM, ya, DM, nullptr, 0, DP);
        k_hgrn<<<256, 512, 0, stream>>>(proj, lbl, state, oraw, TB);
        k_hgrn_norm<<<TB * 8 / 4, 256, 0, stream>>>(oraw, proj, hnw, ob);
        k_gemm<<<dim3(DM / 64, TB / 64), 256, 0, stream>>>(ob, DH, nullptr, nullptr, w_b, DM, yb, DM, nullptr, 0, DH);
        k_merge<<<(TB * DM + 255) / 256, 256, 0, stream>>>(proj, ya, yb, mg);
        k_gemm<<<dim3(DM / 64, TB / 64), 256, 0, stream>>>(mg, DM, nullptr, nullptr, w_out, DM, x1, DM, xb, DM, DM);
        k_rowscale<<<TB / 4, 256, 0, stream>>>(x1, r2, TB, DM);
        k_gemm<<<dim3(DFF2 / 64, TB / 64), 256, 0, stream>>>(x1, DM, r2, ln_ffn_w, w_up, DFF2, upre, DFF2, nullptr, 0, DM);
        k_conv_act<<<(TB * DFF + 255) / 256, 256, 0, stream>>>(upre, tail, conv_w, conv_b, act, t0);
        k_save_tail<<<(2 * DFF2 + 255) / 256, 256, 0, stream>>>(upre, tail);
        k_gemm<<<dim3(DM / 64, TB / 64), 256, 0, stream>>>(act, DFF, nullptr, nullptr, w_down, DM, x2, DM, x1, DM, DFF);
        k_rowscale<<<TB / 4, 256, 0, stream>>>(x2, r3, TB, DM);
        k_gemm<<<dim3(DM / 64, TB / 64), 256, 0, stream>>>(x2, DM, r3, ln_ple_w, w_pg, DM, gp, DM, nullptr, 0, DM);
        k_gemm<<<dim3(DM / 64, TB / 64), 256, 0, stream>>>(p + (size_t)t0 * PLE, PLE, nullptr, nullptr, w_ple, DM, eb, DM, nullptr, 0, PLE);
        k_final<<<TB / 4, 256, 0, stream>>>(x2, gp, eb, ln_final_w, out + (size_t)t0 * DM);
    }
}
```

```cpp
#include <hip/hip_runtime.h>
#include <cstdio>
#include <cstdint>

#define LAS __attribute__((address_space(3)))
#define GAS __attribute__((address_space(1)))
typedef unsigned short bf16_t;
typedef short bf16x8 __attribute__((ext_vector_type(8)));
typedef short s16x4 __attribute__((ext_vector_type(4)));
typedef float f32x4 __attribute__((ext_vector_type(4)));
typedef float f32x2 __attribute__((ext_vector_type(2)));
typedef float f32x16 __attribute__((ext_vector_type(16)));
typedef unsigned u32x4 __attribute__((ext_vector_type(4)));
typedef unsigned u32x2 __attribute__((ext_vector_type(2)));
typedef __bf16 bf16v2 __attribute__((ext_vector_type(2)));
#define DI __device__ __forceinline__

constexpr int S = 8192, DM = 2048, DP = 1024, DH = 1024, DIN = 9216, DFF = 5504, DFF2 = 11008, PLE = 256, NCHUNK = 128;
constexpr float EPS = 1e-6f;

DI unsigned pk2(float lo, float hi) { f32x2 v = {lo, hi}; bf16v2 r = __builtin_convertvector(v, bf16v2); return __builtin_bit_cast(unsigned, r); }
DI float bf_lo(unsigned w) { return __builtin_bit_cast(float, w << 16); }
DI float bf_hi(unsigned w) { return __builtin_bit_cast(float, w & 0xffff0000u); }
DI float sigm(float v) { return __builtin_amdgcn_rcpf(1.0f + __expf(-v)); }
DI float wave_sum(float v) {
#pragma unroll
    for (int o = 1; o < 64; o <<= 1) v += __shfl_xor(v, o);
    return v;
}
template <int CTRL> DI float dppf(float v) { return __builtin_bit_cast(float, __builtin_amdgcn_update_dpp(0, __builtin_bit_cast(int, v), CTRL, 0xf, 0xf, true)); }
DI u32x4 pack8(f32x4 a, f32x4 b) { u32x4 w; w.x = pk2(a.x, a.y); w.y = pk2(a.z, a.w); w.z = pk2(b.x, b.y); w.w = pk2(b.z, b.w); return w; }
DI void unpack8(u32x4 w, f32x4& a, f32x4& b) { a.x = bf_lo(w.x); a.y = bf_hi(w.x); a.z = bf_lo(w.y); a.w = bf_hi(w.y); b.x = bf_lo(w.z); b.y = bf_hi(w.z); b.z = bf_lo(w.w); b.w = bf_hi(w.w); }

namespace pg8 {
constexpr int BM = 256, BK = 64, HALF = 128, HTB = HALF * BK * 2, STAGE_BYTES = 8 * HTB, NXCD = 8, WGM = 8;
__host__ __device__ __forceinline__ int lds_byte(int r, int c) { const int st = (r >> 4) * 2 + (c >> 5), rr = r & 15, cc = c & 31, ob = rr * 64 + cc * 2; return st * 1024 + (ob ^ (((ob >> 9) & 1) << 5)); }
__host__ __device__ __forceinline__ void stage_rc(int b, int& R, int& C) { const int st = b / 1024, sb = b % 1024, swz = sb ^ (((sb >> 9) & 1) << 5); R = (st >> 1) * 16 + swz / 64; C = (st & 1) * 32 + (swz % 64) / 2; }
__host__ __device__ __forceinline__ int perm32(int rho) { const int n = rho >> 4, i = rho & 15; return 8 * (i >> 2) + 4 * n + (i & 3); }

struct Unit { int pm, pn; };
struct Gemm { const bf16_t* A; const bf16_t* Bt; int lda, ldb, K; };

struct StaticOrder {
    int nM, nN, nwg, G, c;
    DI void init(int M, int N, int G_, int c_) { nM = M / BM; nN = N / BM; nwg = nM * nN; G = G_; c = c_; }
    DI bool next(int i, Unit& u) const {
        const long L = (long)i * G + c; if (L >= nwg) return false;
        int wgid = (int)L; { const int q = nwg / NXCD, r = nwg % NXCD, xcd = wgid % NXCD, off = wgid / NXCD; wgid = (xcd < r ? xcd * (q + 1) : r * (q + 1) + (xcd - r) * q) + off; }
        const int nig = WGM * nN, gid = wgid / nig, fm = gid * WGM, gsz = (nM - fm) < WGM ? (nM - fm) : WGM;
        u.pm = fm + ((wgid % nig) % gsz); u.pn = (wgid % nig) / gsz; return true;
    }
};

template <class Epi, bool ALIGN_EPI>
DI void gemm_phase(LAS unsigned char* lds, const Gemm g, const StaticOrder& S, const Epi& E) {
    const int tid = threadIdx.x, wid = __builtin_amdgcn_readfirstlane(tid >> 6), lane = tid & 63, wr = wid >> 2, wc = wid & 3, fr = lane & 15, fq = lane >> 4;
    const int K = g.K, nt = K / BK;
    unsigned voffA[2], voffB[2];
#pragma unroll
    for (int i = 0; i < 2; ++i) { int R, C; stage_rc(tid * 16 + i * 8192, R, C); const int Rb = (R & ~31) + perm32(R & 31);
        voffA[i] = (unsigned)(R * g.lda + C) * 2u; voffB[i] = (unsigned)(Rb * g.ldb + C) * 2u; }
    const size_t kstep = (size_t)(BK * 2);
    const size_t hstepA = (size_t)HALF * g.lda * 2, hstepB = (size_t)HALF * g.ldb * 2;
    const size_t tstepA = 2 * hstepA, tstepB = 2 * hstepB;
    const unsigned ldsw = (unsigned)wid * 1024u;
    const int aoff = lds_byte(wr * 64 + fr, fq * 8), boff = lds_byte(wc * 32 + fr, fq * 8);
#define PG8_SA(b, h) (((b) * 2 + (h)) * HTB)
#define PG8_SB(b, h) ((4 + (b) * 2 + (h)) * HTB)
#define PG8_STAGE(bufoff, gbase, voff) do { _Pragma("unroll") for (int _i = 0; _i < 2; ++_i) \
        __builtin_amdgcn_global_load_lds((const unsigned*)((const char*)(gbase) + (voff)[_i]), (LAS unsigned*)(lds + (bufoff) + ldsw + _i * 8192), 16, 0, 0); } while (0)
#define PG8_LDA(dst, b, h) do { _Pragma("unroll") for (int m = 0; m < 4; ++m) _Pragma("unroll") for (int k = 0; k < 2; ++k) dst[m][k] = *(const LAS bf16x8*)(lds + PG8_SA(b, h) + aoff + m * 2048 + k * 1024); } while (0)
#define PG8_LDB(dst, b, h) do { _Pragma("unroll") for (int n = 0; n < 2; ++n) _Pragma("unroll") for (int k = 0; k < 2; ++k) dst[n][k] = *(const LAS bf16x8*)(lds + PG8_SB(b, h) + boff + n * 2048 + k * 1024); } while (0)
#define PG8_MMA(ai, bj, At, Bt) do { __builtin_amdgcn_s_setprio(1); _Pragma("unroll") for (int m = 0; m < 4; ++m) _Pragma("unroll") for (int n = 0; n < 2; ++n) _Pragma("unroll") for (int k = 0; k < 2; ++k) \
        acc[ai][bj][m][n] = __builtin_amdgcn_mfma_f32_16x16x32_bf16(Bt[n][k], At[m][k], acc[ai][bj][m][n], 0, 0, 0); __builtin_amdgcn_s_setprio(0); } while (0)
#define PG8_WAIT_V(n) asm volatile("s_waitcnt vmcnt(" #n ")" ::: "memory")
#define PG8_WAIT_L(n) asm volatile("s_waitcnt lgkmcnt(" #n ")" ::: "memory")
#define PG8_BAR __builtin_amdgcn_s_barrier()
#define PG8_SCHED __builtin_amdgcn_sched_barrier(0)
    Unit cur, nxt; int ui = 0;
    if (!S.next(0, cur)) return;
    f32x4 acc[2][2][4][2];
#pragma unroll
    for (int a = 0; a < 2; ++a)
#pragma unroll
        for (int b = 0; b < 2; ++b)
#pragma unroll
            for (int m = 0; m < 4; ++m)
#pragma unroll
                for (int n = 0; n < 2; ++n) acc[a][b][m][n] = (f32x4){0.f, 0.f, 0.f, 0.f};
    bf16x8 At[4][2], B0[2][2], B1[2][2];
    const char* cA = (const char*)g.A + (size_t)cur.pm * tstepA; const char* cB = (const char*)g.Bt + (size_t)cur.pn * tstepB;
    PG8_STAGE(PG8_SB(0, 0), cB, voffB); PG8_STAGE(PG8_SB(0, 1), cB + hstepB, voffB); PG8_STAGE(PG8_SA(0, 0), cA, voffA); PG8_STAGE(PG8_SA(0, 1), cA + hstepA, voffA);
    if (wr == 1) PG8_BAR;
    PG8_WAIT_V(2); PG8_BAR;
    PG8_STAGE(PG8_SB(1, 0), cB + kstep, voffB); PG8_STAGE(PG8_SA(1, 0), cA + kstep, voffA); PG8_STAGE(PG8_SB(1, 1), cB + hstepB + kstep, voffB);
    PG8_WAIT_V(6); PG8_BAR;
    for (;;) {
        const bool has_next = S.next(ui + 1, nxt);
        const char* nA = has_next ? (const char*)g.A + (size_t)nxt.pm * tstepA : cA; const char* nB = has_next ? (const char*)g.Bt + (size_t)nxt.pn * tstepB : cB;
        for (int t = 0; t < nt; t += 2) {
            const bool last = (t == nt - 2);
            const char* a1 = cA + (size_t)(t + 1) * kstep;
            const char* a2 = last ? nA : cA + (size_t)(t + 2) * kstep; const char* b2 = last ? nB : cB + (size_t)(t + 2) * kstep;
            const char* a3 = a2 + kstep; const char* b3 = b2 + kstep;
            PG8_LDB(B0, 0, 0); PG8_LDB(B1, 0, 1); PG8_SCHED; PG8_LDA(At, 0, 0); PG8_STAGE(PG8_SA(1, 1), a1 + hstepA, voffA);
            PG8_WAIT_V(8); PG8_WAIT_L(0); PG8_BAR; PG8_MMA(0, 0, At, B0); PG8_MMA(0, 1, At, B1); PG8_BAR; PG8_SCHED;
            PG8_LDA(At, 0, 1); PG8_STAGE(PG8_SB(0, 0), b2, voffB); PG8_STAGE(PG8_SB(0, 1), b2 + hstepB, voffB); PG8_STAGE(PG8_SA(0, 0), a2, voffA);
            PG8_WAIT_V(8); PG8_WAIT_L(0); PG8_BAR; PG8_MMA(1, 0, At, B0); PG8_MMA(1, 1, At, B1); PG8_BAR; PG8_SCHED;
            PG8_LDB(B0, 1, 0); PG8_LDB(B1, 1, 1); PG8_SCHED; PG8_LDA(At, 1, 0); PG8_STAGE(PG8_SA(0, 1), a2 + hstepA, voffA);
            PG8_WAIT_V(8); PG8_WAIT_L(0); PG8_BAR; PG8_MMA(0, 0, At, B0); PG8_MMA(0, 1, At, B1); PG8_BAR; PG8_SCHED;
            PG8_LDA(At, 1, 1); PG8_STAGE(PG8_SB(1, 0), b3, voffB); PG8_STAGE(PG8_SB(1, 1), b3 + hstepB, voffB); PG8_STAGE(PG8_SA(1, 0), a3, voffA);
            PG8_WAIT_V(8); PG8_WAIT_L(0); PG8_BAR; PG8_MMA(1, 0, At, B0); PG8_MMA(1, 1, At, B1); PG8_BAR; PG8_SCHED;
        }
        if constexpr (ALIGN_EPI) { if (wr == 0) PG8_BAR; }
        E(acc, cur, wr, wc, fr, fq);
        if (!has_next) break;
#pragma unroll
        for (int a = 0; a < 2; ++a)
#pragma unroll
            for (int b = 0; b < 2; ++b)
#pragma unroll
                for (int m = 0; m < 4; ++m)
#pragma unroll
                    for (int n = 0; n < 2; ++n) acc[a][b][m][n] = (f32x4){0.f, 0.f, 0.f, 0.f};
        cur = nxt; cA = nA; cB = nB; ++ui;
        if constexpr (ALIGN_EPI) { if (wr == 1) PG8_BAR; }
    }
    PG8_WAIT_V(0);
    if constexpr (!ALIGN_EPI) { if (wr == 0) PG8_BAR; }
    PG8_BAR;
#undef PG8_SA
#undef PG8_SB
#undef PG8_STAGE
#undef PG8_LDA
#undef PG8_LDB
#undef PG8_MMA
#undef PG8_WAIT_V
#undef PG8_WAIT_L
#undef PG8_BAR
#undef PG8_SCHED
}
}
using pg8::Unit;
typedef f32x4 AccT[2][2][4][2];

constexpr size_t MiB = 1u << 20;
constexpr size_t WS_CTL = 0, CTL_ZERO_BYTES = 1 * MiB;
constexpr size_t WS_R1 = 1 * MiB, WS_LB = WS_R1 + 65536;
constexpr size_t WS_SSQ1 = 2 * MiB, WS_SSQ2 = 3 * MiB, WS_SSQ3 = 4 * MiB;
constexpr size_t WS_WAB = 6 * MiB, WS_WOUT = 14 * MiB, WS_WPG = 22 * MiB, WS_WPLE = 30 * MiB, WS_WDOWN = 31 * MiB, WS_WUP = 53 * MiB, WS_WIN = 96 * MiB;
constexpr size_t WS_XB = 132 * MiB;
constexpr size_t WS_UP = 164 * MiB, WS_Q = 180 * MiB, WS_KK = 196 * MiB, WS_V = 212 * MiB, WS_SG = 228 * MiB;
constexpr size_t WS_BC = 244 * MiB;
constexpr size_t WS_DOB = 276 * MiB;
constexpr size_t WS_PB = 308 * MiB;
constexpr size_t WS_ZB = 312 * MiB;
constexpr size_t WS_END = 334 * MiB;
constexpr size_t WS_LT = 96 * MiB;
constexpr size_t WS_TMP = 164 * MiB;
constexpr size_t WS_MG = 244 * MiB;
constexpr size_t WS_E = 96 * MiB;
constexpr size_t WS_ACT = 164 * MiB;
static_assert(WS_WUP + (size_t)DFF2 * DM * 2 <= WS_WIN && WS_WIN + (size_t)DIN * DM * 2 <= WS_XB && WS_LT + (size_t)1024 * 16384 * 4 <= WS_XB + (size_t)S * DM * 2, "ws map");
static_assert(WS_ACT + (size_t)S * DFF * 2 <= WS_DOB && WS_ZB + (size_t)128 * 4 * DFF2 * 4 <= WS_END, "ws map 2");

constexpr int CW_BAR = 4096;
constexpr int RING_BYTES = 131072, LDSCTL_OFF = RING_BYTES, MISC_OFF = LDSCTL_OFF + 320, LDS_BYTES = 147456;
constexpr int NWAVES = 8;

typedef GAS unsigned gu32;
#define RLX_AGENT __ATOMIC_RELAXED, __HIP_MEMORY_SCOPE_AGENT
#define LDS_WAIT() asm volatile("s_waitcnt lgkmcnt(0)" ::: "memory")

#define XB_TMO      128
#define XB_XCNT(j)  (256  + 64 * (j))
#define XB_XSUB(j)  (1280 + 64 * (j))
#define XB_XGEN(j)  (2304 + 64 * (j))
#define XB_TOP      3328
#define XB_TOPGEN   3392
#define XCD_BAR_WORDS 3456
#define XB_SPIN_CAP (1u << 22)
DI unsigned xb_ld(unsigned* p)              { return __hip_atomic_load(p, __ATOMIC_RELAXED, __HIP_MEMORY_SCOPE_AGENT); }
DI unsigned xb_add(unsigned* p, unsigned v) { return __hip_atomic_fetch_add(p, v, __ATOMIC_RELAXED, __HIP_MEMORY_SCOPE_AGENT); }
DI unsigned xb_xcc_id() { return (unsigned)__builtin_amdgcn_s_getreg((3 << 11) | 20) & 0xFu; }
#define XB_SPIN(cond, bar) do { unsigned _sp = 0; while (cond) { __builtin_amdgcn_s_sleep(1); \
    if ((++_sp & 255u) == 0u) { if (xb_ld(&(bar)[XB_TMO])) break; if (_sp > XB_SPIN_CAP) { atomicAdd(&(bar)[XB_TMO], 1u); break; } } } } while (0)
struct XcdBarrier { unsigned* bar; unsigned x; volatile LAS unsigned* st; };
DI XcdBarrier xcd_barrier_post(unsigned* bar, volatile LAS unsigned* st) {
    XcdBarrier b; b.bar = bar; b.x = xb_xcc_id(); b.st = st;
    if (threadIdx.x == 0) (void)xb_add(&bar[XB_XCNT(b.x)], 1u);
    return b;
}
DI void xcd_barrier_complete(unsigned* bar, unsigned x, unsigned& nloc, unsigned& nx) {
    const unsigned G = gridDim.x * gridDim.y * gridDim.z;
    unsigned sum, cnt, mine, sp = 0u;
    for (;;) {
        sum = 0u; cnt = 0u; mine = 0u;
#pragma unroll
        for (unsigned j = 0; j < 16; ++j) { const unsigned c = xb_ld(&bar[XB_XCNT(j)]); sum += c; cnt += (c > 0u) ? 1u : 0u; mine = (j == x) ? c : mine; }
        if (sum == G) break;
        __builtin_amdgcn_s_sleep(1);
        if ((++sp & 255u) == 0u) { if (xb_ld(&bar[XB_TMO])) break; if (sp > XB_SPIN_CAP) { atomicAdd(&bar[XB_TMO], 1u); break; } }
    }
    nloc = mine > 0u ? mine : 1u; nx = cnt > 0u ? cnt : 1u;
}
DI void xcd_barrier(const XcdBarrier& b) {
    asm volatile("s_waitcnt vmcnt(0)" ::: "memory");
    __syncthreads();
    if (threadIdx.x == 0) {
        unsigned* bar = b.bar;
        __builtin_amdgcn_s_waitcnt(0);
        unsigned nloc = b.st[0], nx = b.st[1];
        if (nloc == 0u) { xcd_barrier_complete(bar, b.x, nloc, nx); b.st[0] = nloc; b.st[1] = nx; }
        const unsigned old = xb_add(&bar[XB_XSUB(b.x)], 1u);
        const unsigned gen = old / nloc;
        if (old + 1u == (gen + 1u) * nloc) {
            __builtin_amdgcn_fence(__ATOMIC_RELEASE, "agent");
            asm volatile("s_waitcnt vmcnt(0)" ::: "memory");
            const unsigned og = xb_add(&bar[XB_TOP], 1u);
            const unsigned tg = og / nx;
            if (og + 1u == (tg + 1u) * nx) xb_add(&bar[XB_TOPGEN], 1u);
            else XB_SPIN(xb_ld(&bar[XB_TOPGEN]) == tg, bar);
            __builtin_amdgcn_fence(__ATOMIC_ACQUIRE, "agent");
            xb_add(&bar[XB_XGEN(b.x)], 1u);
            asm volatile("s_waitcnt vmcnt(0)" ::: "memory");
        } else {
            XB_SPIN(xb_ld(&bar[XB_XGEN(b.x)]) == gen, bar);
            __builtin_amdgcn_fence(__ATOMIC_ACQUIRE, "agent");
            asm volatile("s_waitcnt vmcnt(0)" ::: "memory");
        }
    }
    __syncthreads();
}

struct Frame {
    LAS unsigned char* lds;
    int tid, lane, wave, vcu, G;
    unsigned char* ws;
    const float* const* in;
    float* out;
};

template <bool UPMAP>
DI void p0_transpose_item(const float* W, int K, int N, const float* ks, bf16_t* WT, int ldo, int coff, LAS float* scr, int item, int lane) {
    const int nblk = N / 32, kb = item / nblk, nb = item % nblk, k0 = 64 * kb, n0 = 32 * nb;
#pragma unroll 8
    for (int i = 0; i < 32; ++i) { const int kk = 2 * i + (lane >> 5); float v = W[(size_t)(k0 + kk) * N + n0 + (lane & 31)]; if (ks) v *= ks[k0 + kk]; scr[kk * 33 + (lane & 31)] = v; }
    LDS_WAIT(); asm volatile("" ::: "memory");
    const int c = lane & 7;
    int orow0 = n0;
    if (UPMAP) { const int half = n0 >= DFF ? 1 : 0, ch = n0 - half * DFF; orow0 = 256 * (ch >> 7) + 128 * half + (ch & 127); }
#pragma unroll
    for (int j = 0; j < 4; ++j) { const int n = (lane >> 3) + 8 * j; const LAS float* s = scr + (8 * c) * 33 + n;
        u32x4 o; o.x = pk2(s[0 * 33], s[1 * 33]); o.y = pk2(s[2 * 33], s[3 * 33]); o.z = pk2(s[4 * 33], s[5 * 33]); o.w = pk2(s[6 * 33], s[7 * 33]);
        *(u32x4*)(WT + (size_t)(orow0 + n) * ldo + coff + k0 + 8 * c) = o; }
    LDS_WAIT(); asm volatile("" ::: "memory");
}

DI void p0_fold_wa(Frame& F, const float* wmix, const float* scale, const float* wa, bf16_t* WAB) {
    LAS float* sWm = (LAS float*)(F.lds);
    LAS float* sWa = (LAS float*)(F.lds + 64 * 33 * 4);
    const int tid = F.tid, c = tid >> 3, n8 = (tid & 7) * 8;
    for (int tile = F.vcu; tile < 512; tile += F.G) {
        const int g = tile >> 7, cb = (tile >> 5) & 3, nb = tile & 31, c0 = 64 * cb, n0 = 64 * nb;
        float acc[8];
#pragma unroll
        for (int j = 0; j < 8; ++j) acc[j] = 0.f;
        for (int d0 = 0; d0 < 256; d0 += 32) {
            __syncthreads();
#pragma unroll
            for (int i = 0; i < 4; ++i) { const int e = tid + 512 * i; const int cc = e >> 5, dd = e & 31; sWm[cc * 33 + dd] = wmix[((size_t)g * 256 + c0 + cc) * 256 + d0 + dd]; }
#pragma unroll
            for (int i = 0; i < 4; ++i) { const int e = tid + 512 * i; const int dd = e >> 6, nn = e & 63; sWa[dd * 64 + nn] = scale[g * 256 + d0 + dd] * wa[(size_t)(g * 256 + d0 + dd) * DM + n0 + nn]; }
            __syncthreads();
#pragma unroll 8
            for (int dd = 0; dd < 32; ++dd) { const float a = sWm[c * 33 + dd]; const LAS float* b = sWa + dd * 64 + n8;
#pragma unroll
                for (int j = 0; j < 8; ++j) acc[j] += a * b[j]; }
        }
#pragma unroll
        for (int j = 0; j < 8; ++j) WAB[(size_t)(n0 + n8 + j) * DM + g * 256 + c0 + c] = (bf16_t)(pk2(acc[j], 0.f) & 0xffffu);
    }
    __syncthreads();
}

DI void p0_prologue(Frame& F) {
    unsigned char* ws = F.ws;
    LAS float* scr = (LAS float*)(F.lds + F.wave * 16384);
    const int gw = F.vcu * NWAVES + F.wave, NGW = F.G * NWAVES;
    const float* w_in = F.in[3]; const float* w_b = F.in[9]; const float* w_out = F.in[10]; const float* w_up = F.in[12]; const float* w_down = F.in[15]; const float* w_pg = F.in[17]; const float* w_ple = F.in[18];
    constexpr int I_IN = (DM / 64) * (DIN / 32), I_B = (DH / 64) * (DM / 32), I_OUT = (DM / 64) * (DM / 32), I_UP = (DM / 64) * (DFF2 / 32), I_DOWN = (DFF / 64) * (DM / 32), I_PG = I_OUT, I_PLE = (PLE / 64) * (DM / 32);
    constexpr int NITEMS = I_IN + I_B + I_OUT + I_UP + I_DOWN + I_PG + I_PLE;
    for (int it = gw; it < NITEMS; it += NGW) {
        int r = it;
        if (r < I_IN) { p0_transpose_item<false>(w_in, DM, DIN, F.in[2], (bf16_t*)(ws + WS_WIN), DM, 0, scr, r, F.lane); continue; } r -= I_IN;
        if (r < I_UP) { p0_transpose_item<true>(w_up, DM, DFF2, F.in[11], (bf16_t*)(ws + WS_WUP), DM, 0, scr, r, F.lane); continue; } r -= I_UP;
        if (r < I_DOWN) { p0_transpose_item<false>(w_down, DFF, DM, nullptr, (bf16_t*)(ws + WS_WDOWN), DFF, 0, scr, r, F.lane); continue; } r -= I_DOWN;
        if (r < I_B) { p0_transpose_item<false>(w_b, DH, DM, nullptr, (bf16_t*)(ws + WS_WAB), DM, DP, scr, r, F.lane); continue; } r -= I_B;
        if (r < I_OUT) { p0_transpose_item<false>(w_out, DM, DM, nullptr, (bf16_t*)(ws + WS_WOUT), DM, 0, scr, r, F.lane); continue; } r -= I_OUT;
        if (r < I_PG) { p0_transpose_item<false>(w_pg, DM, DM, F.in[16], (bf16_t*)(ws + WS_WPG), DM, 0, scr, r, F.lane); continue; } r -= I_PG;
        p0_transpose_item<false>(w_ple, PLE, DM, nullptr, (bf16_t*)(ws + WS_WPLE), PLE, 0, scr, r, F.lane);
    }
    {
        const float* x = F.in[0]; bf16_t* XB = (bf16_t*)(ws + WS_XB); float* R1 = (float*)(ws + WS_R1);
        for (int m = gw; m < S; m += NGW) {
            const f32x4* xr = (const f32x4*)(x + (size_t)m * DM) + F.lane;
            f32x4 v[8]; float s = 0.f;
#pragma unroll
            for (int j = 0; j < 8; ++j) { v[j] = xr[64 * j]; s += (v[j].x * v[j].x + v[j].y * v[j].y) + (v[j].z * v[j].z + v[j].w * v[j].w); }
            s = wave_sum(s);
            if (F.lane == 0) R1[m] = rsqrtf(s * (1.f / DM) + EPS);
            u32x2* o = (u32x2*)(XB + (size_t)m * DM) + F.lane;
#pragma unroll
            for (int j = 0; j < 8; ++j) { u32x2 w; w.x = pk2(v[j].x, v[j].y); w.y = pk2(v[j].z, v[j].w); o[64 * j] = w; }
        }
    }
    {
        const f32x4* p = (const f32x4*)F.in[1]; u32x2* PB = (u32x2*)(ws + WS_PB);
        const int gt = F.vcu * 512 + F.tid, NGT = F.G * 512;
        for (int i = gt; i < S * PLE / 4; i += NGT) { const f32x4 v = p[i]; u32x2 w; w.x = pk2(v.x, v.y); w.y = pk2(v.z, v.w); PB[i] = w; }
        float* LB = (float*)(ws + WS_LB); const float* lbl = F.in[6];
        if (gt < DH) { const float l0 = lbl[gt], l1 = lbl[DH + gt], mx = fmaxf(l0, l1), e0 = __expf(l0 - mx), e1 = __expf(l1 - mx); LB[gt] = e0 / (e0 + e1); }
    }
    p0_fold_wa(F, F.in[4], F.in[5], F.in[8], (bf16_t*)(ws + WS_WAB));
}

DI float row_rstd(const float* ssq, int row, int fq) {
    const f32x4* p = (const f32x4*)(ssq + (size_t)row * 32 + fq * 8);
    const f32x4 a = p[0], b = p[1];
    float s = ((a.x + a.y) + (a.z + a.w)) + ((b.x + b.y) + (b.z + b.w));
    s += __shfl_xor(s, 16); s += __shfl_xor(s, 32);
    return rsqrtf(s * (1.f / DM) + EPS);
}

struct EpiProj {
    unsigned char* ws; float* dout;
    DI void operator()(const AccT& acc, const Unit& u, int wr, int wc, int fr, int fq) const {
        asm volatile("" : "+v"(fr), "+v"(fq));
        const float* R1 = (const float*)(ws + WS_R1);
        const int pn = u.pn, row0 = u.pm * 256 + wr * 64 + fr, cl = wc * 32 + 8 * fq;
        float rs[2][4];
#pragma unroll
        for (int ai = 0; ai < 2; ++ai)
#pragma unroll
            for (int m = 0; m < 4; ++m) rs[ai][m] = R1[row0 + ai * 128 + m * 16];
        if (pn >= 8 && pn < 12) {
            const float* LB = (const float*)(ws + WS_LB); float* BC = (float*)(ws + WS_BC); bf16_t* KK = (bf16_t*)(ws + WS_KK);
            const int colb = (pn - 8) * 256 + cl;
            const int lane = fq * 16 + fr, bsel = ((lane & ~15) | 15) << 2;
#pragma unroll
            for (int bj = 0; bj < 2; ++bj) {
#pragma unroll
                for (int n = 0; n < 2; ++n) {
                    const f32x4 lb = *(const f32x4*)(LB + colb + bj * 128 + 4 * n);
#pragma unroll
                    for (int ai = 0; ai < 2; ++ai) {
                        f32x4 lf[4], kk[4];
#pragma unroll
                        for (int m = 0; m < 4; ++m)
#pragma unroll
                            for (int c = 0; c < 4; ++c) { const float v = acc[ai][bj][m][n][c] * rs[ai][m]; const float sg = sigm(v); const float f = lb[c] + (1.f - lb[c]) * sg;
                                lf[m][c] = __logf(f); kk[m][c] = (1.f - lb[c]) * (1.f - sg); }
#pragma unroll
                        for (int c = 0; c < 4; ++c) {
                            float carry = 0.f;
#pragma unroll
                            for (int m = 0; m < 4; ++m) {
                                float x = lf[m][c];
                                x += dppf<0x111>(x); x += dppf<0x112>(x); x += dppf<0x114>(x); x += dppf<0x118>(x);
                                const float tot = __builtin_bit_cast(float, __builtin_amdgcn_ds_bpermute(bsel, __builtin_bit_cast(int, x)));
                                lf[m][c] = x + carry; carry += tot;
                            }
                        }
#pragma unroll
                        for (int m = 0; m < 4; ++m) {
                            const size_t o = (size_t)(row0 + ai * 128 + m * 16) * DH + colb + bj * 128 + 4 * n;
                            *(f32x4*)(BC + o) = lf[m];
                            u32x2 w; w.x = pk2(kk[m].x, kk[m].y); w.y = pk2(kk[m].z, kk[m].w);
                            *(u32x2*)(KK + o) = w;
                        }
                    }
                }
            }
        } else {
        bf16_t* O; int ld, colt, act;
        if (pn < 4) { O = (bf16_t*)(ws + WS_UP); ld = DP; colt = pn * 256; act = 0; }
        else if (pn < 8) { O = (bf16_t*)(ws + WS_Q); ld = DH; colt = (pn - 4) * 256; act = 0; }
        else if (pn < 16) { O = (bf16_t*)(ws + WS_V); ld = DH; colt = (pn - 12) * 256; act = 0; }
        else if (pn < 20) { O = (bf16_t*)(ws + WS_SG); ld = DH; colt = (pn - 16) * 256; act = 1; }
        else if (pn < 28) { O = (bf16_t*)dout; ld = DM; colt = (pn - 20) * 256; act = 2; }
        else { O = (bf16_t*)dout + (size_t)S * DM; ld = DM; colt = (pn - 28) * 256; act = 2; }
#pragma unroll
        for (int ai = 0; ai < 2; ++ai)
#pragma unroll
            for (int m = 0; m < 4; ++m) {
                bf16_t* rowp = O + (size_t)(row0 + ai * 128 + m * 16) * ld + colt + cl;
#pragma unroll
                for (int bj = 0; bj < 2; ++bj) {
                    f32x4 v0 = acc[ai][bj][m][0] * rs[ai][m], v1 = acc[ai][bj][m][1] * rs[ai][m];
                    if (act == 1) {
#pragma unroll
                        for (int c = 0; c < 4; ++c) { v0[c] = v0[c] * sigm(v0[c]); v1[c] = v1[c] * sigm(v1[c]); } }
                    else if (act == 2) {
#pragma unroll
                        for (int c = 0; c < 4; ++c) { v0[c] = sigm(v0[c]); v1[c] = sigm(v1[c]); } }
                    *(u32x4*)(rowp + bj * 128) = pack8(v0, v1);
                }
            }
        }
        asm volatile("" :: "v"(rs[0][0]), "v"(rs[0][1]), "v"(rs[0][2]), "v"(rs[0][3]), "v"(rs[1][0]), "v"(rs[1][1]), "v"(rs[1][2]), "v"(rs[1][3]));
    }
};

struct EpiBf {
    bf16_t* O; int ld;
    DI void operator()(const AccT& acc, const Unit& u, int wr, int wc, int fr, int fq) const {
        asm volatile("" : "+v"(fr), "+v"(fq));
        const int row0 = u.pm * 256 + wr * 64 + fr, col0 = u.pn * 256 + wc * 32 + 8 * fq;
#pragma unroll
        for (int ai = 0; ai < 2; ++ai)
#pragma unroll
            for (int m = 0; m < 4; ++m)
#pragma unroll
                for (int bj = 0; bj < 2; ++bj) *(u32x4*)(O + (size_t)(row0 + ai * 128 + m * 16) * ld + col0 + bj * 128) = pack8(acc[ai][bj][m][0], acc[ai][bj][m][1]);
    }
};
template <int MODE> struct EpiGate {
    const bf16_t* G; float* TMP; bf16_t* MG;
    DI void operator()(const AccT& acc, const Unit& u, int wr, int wc, int fr, int fq) const {
        asm volatile("" : "+v"(fr), "+v"(fq));
        const int row0 = u.pm * 256 + wr * 64 + fr, col0 = u.pn * 256 + wc * 32 + 8 * fq;
#pragma unroll
        for (int ai = 0; ai < 2; ++ai)
#pragma unroll
            for (int m = 0; m < 4; ++m)
#pragma unroll
                for (int bj = 0; bj < 2; ++bj) {
                    const size_t o = (size_t)(row0 + ai * 128 + m * 16) * DM + col0 + bj * 128;
                    f32x4 g0, g1; unpack8(*(const u32x4*)(G + o), g0, g1);
                    f32x4 v0 = acc[ai][bj][m][0] * g0, v1 = acc[ai][bj][m][1] * g1;
                    if (MODE == 0) { *(f32x4*)(TMP + o) = v0; *(f32x4*)(TMP + o + 4) = v1; }
                    else { v0 += *(const f32x4*)(TMP + o); v1 += *(const f32x4*)(TMP + o + 4); *(u32x4*)(MG + o) = pack8(v0, v1); }
                }
    }
};
struct EpiRes {
    const float* base; float* xo; bf16_t* xb; float* ssq;
    DI void operator()(const AccT& acc, const Unit& u, int wr, int wc, int fr, int fq) const {
        asm volatile("" : "+v"(fr), "+v"(fq));
        const int row0 = u.pm * 256 + wr * 64 + fr, col0 = u.pn * 256 + wc * 32 + 8 * fq;
#pragma unroll
        for (int ai = 0; ai < 2; ++ai)
#pragma unroll
            for (int m = 0; m < 4; ++m) {
                const int row = row0 + ai * 128 + m * 16; float s = 0.f;
#pragma unroll
                for (int bj = 0; bj < 2; ++bj) {
                    const size_t o = (size_t)row * DM + col0 + bj * 128;
                    const f32x4 v0 = acc[ai][bj][m][0] + *(const f32x4*)(base + o), v1 = acc[ai][bj][m][1] + *(const f32x4*)(base + o + 4);
                    *(f32x4*)(xo + o) = v0; *(f32x4*)(xo + o + 4) = v1; *(u32x4*)(xb + o) = pack8(v0, v1);
                    s += ((v0.x * v0.x + v0.y * v0.y) + (v0.z * v0.z + v0.w * v0.w)) + ((v1.x * v1.x + v1.y * v1.y) + (v1.z * v1.z + v1.w * v1.w));
                }
                s += __shfl_xor(s, 16); s += __shfl_xor(s, 32);
                if (fq == 0) ssq[(size_t)row * 32 + u.pn * 4 + wc] = s;
            }
    }
};
struct EpiUp {
    unsigned char* ws; const float* cw; const float* cb;
    DI void operator()(const AccT& acc, const Unit& u, int wr, int wc, int fr, int fq) const {
        asm volatile("" : "+v"(fr), "+v"(fq));
        const float* SSQ = (const float*)(ws + WS_SSQ1); bf16_t* ACT = (bf16_t*)(ws + WS_ACT); float* ZB = (float*)(ws + WS_ZB);
        const int row0 = u.pm * 256 + wr * 64 + fr, j = u.pn;
#pragma unroll
        for (int ai = 0; ai < 2; ++ai) {
            float r2[4];
#pragma unroll
            for (int m = 0; m < 4; ++m) r2[m] = row_rstd(SSQ, row0 + ai * 128 + m * 16, fq);
            const int blk = 4 * u.pm + 2 * ai + wr;
#pragma unroll
            for (int n = 0; n < 2; ++n) {
                int fq2 = fq; asm volatile("" : "+v"(fq2));
                const int ch = 128 * j + 32 * wc + 8 * fq2 + 4 * n;
                const int pc = 256 * j + 32 * wc + 8 * fq2 + 4 * n;
                float* zb = ZB + (size_t)blk * 4 * DFF2 + pc;
                if (fr < 2) { *(f32x4*)(zb + (size_t)fr * DFF2) = acc[ai][0][0][n] * r2[0]; *(f32x4*)(zb + (size_t)fr * DFF2 + 128) = acc[ai][1][0][n] * r2[0]; }
                if (fr >= 14) { *(f32x4*)(zb + (size_t)(fr - 12) * DFF2) = acc[ai][0][3][n] * r2[3]; *(f32x4*)(zb + (size_t)(fr - 12) * DFF2 + 128) = acc[ai][1][3][n] * r2[3]; }
                f32x4 uv[4];
                {
                    const int oc = ch + DFF;
                    const f32x4 w0 = *(const f32x4*)(cw + oc), w1 = *(const f32x4*)(cw + DFF2 + oc), w2 = *(const f32x4*)(cw + 2 * DFF2 + oc), bb = *(const f32x4*)(cb + oc);
#pragma unroll
                    for (int m = 0; m < 4; ++m) {
                        const f32x4 zc = acc[ai][1][m][n] * r2[m], zp = acc[ai][1][m > 0 ? m - 1 : 0][n] * r2[m > 0 ? m - 1 : 0];
#pragma unroll
                        for (int c = 0; c < 4; ++c) {
                            const float s1 = (m > 0 && fr == 15) ? zp[c] : zc[c], s2 = (m > 0 && fr >= 14) ? zp[c] : zc[c];
                            uv[m][c] = bb[c] + w2[c] * zc[c] + w1[c] * dppf<0x121>(s1) + w0[c] * dppf<0x122>(s2);
                        }
                    }
                }
                {
                    const f32x4 w0 = *(const f32x4*)(cw + ch), w1 = *(const f32x4*)(cw + DFF2 + ch), w2 = *(const f32x4*)(cw + 2 * DFF2 + ch), bb = *(const f32x4*)(cb + ch);
#pragma unroll
                    for (int m = 0; m < 4; ++m) {
                        const f32x4 zc = acc[ai][0][m][n] * r2[m], zp = acc[ai][0][m > 0 ? m - 1 : 0][n] * r2[m > 0 ? m - 1 : 0];
                        f32x4 ug;
#pragma unroll
                        for (int c = 0; c < 4; ++c) {
                            const float s1 = (m > 0 && fr == 15) ? zp[c] : zc[c], s2 = (m > 0 && fr >= 14) ? zp[c] : zc[c];
                            ug[c] = bb[c] + w2[c] * zc[c] + w1[c] * dppf<0x121>(s1) + w0[c] * dppf<0x122>(s2);
                        }
                        if (m > 0 || fr >= 2) {
                            u32x2 w; w.x = pk2(ug.x * sigm(ug.x) * uv[m].x, ug.y * sigm(ug.y) * uv[m].y); w.y = pk2(ug.z * sigm(ug.z) * uv[m].z, ug.w * sigm(ug.w) * uv[m].w);
                            *(u32x2*)(ACT + (size_t)(row0 + ai * 128 + m * 16) * DFF + ch) = w;
                        }
                    }
                }
                __builtin_amdgcn_sched_barrier(0);
            }
        }
    }
};
struct EpiPle {
    unsigned char* ws; float* xo;
    DI void operator()(const AccT& acc, const Unit& u, int wr, int wc, int fr, int fq) const {
        asm volatile("" : "+v"(fr), "+v"(fq));
        const float* SSQ = (const float*)(ws + WS_SSQ2); float* ssq = (float*)(ws + WS_SSQ3); const bf16_t* Eb = (const bf16_t*)(ws + WS_E);
        const int row0 = u.pm * 256 + wr * 64 + fr, col0 = u.pn * 256 + wc * 32 + 8 * fq;
#pragma unroll
        for (int ai = 0; ai < 2; ++ai)
#pragma unroll
            for (int m = 0; m < 4; ++m) {
                const int row = row0 + ai * 128 + m * 16; float s = 0.f;
                const float r3 = row_rstd(SSQ, row, fq);
#pragma unroll
                for (int bj = 0; bj < 2; ++bj) {
                    const size_t o = (size_t)row * DM + col0 + bj * 128;
                    f32x4 e0, e1; unpack8(*(const u32x4*)(Eb + o), e0, e1);
                    f32x4 v0 = *(const f32x4*)(xo + o), v1 = *(const f32x4*)(xo + o + 4);
#pragma unroll
                    for (int c = 0; c < 4; ++c) { v0[c] += sigm(acc[ai][bj][m][0][c] * r3) * e0[c]; v1[c] += sigm(acc[ai][bj][m][1][c] * r3) * e1[c]; }
                    *(f32x4*)(xo + o) = v0; *(f32x4*)(xo + o + 4) = v1;
                    s += ((v0.x * v0.x + v0.y * v0.y) + (v0.z * v0.z + v0.w * v0.w)) + ((v1.x * v1.x + v1.y * v1.y) + (v1.z * v1.z + v1.w * v1.w));
                }
                s += __shfl_xor(s, 16); s += __shfl_xor(s, 32);
                if (fq == 0) ssq[(size_t)row * 32 + u.pn * 4 + wc] = s;
            }
    }
};

DI void pool_phase(Frame& F) {
    const bf16_t* UP = (const bf16_t*)(F.ws + WS_UP); bf16_t* DOB = (bf16_t*)(F.ws + WS_DOB);
    const int gt = F.vcu * 512 + F.tid, NGT = F.G * 512;
    for (int idx = gt; idx < S * 128; idx += NGT) {
        const int t = idx >> 7, c0 = (idx & 127) * 8, w = 2 << (c0 >> 8);
        const int cnt = (t + 1 < w) ? t + 1 : w;
        f32x4 s0 = {0.f, 0.f, 0.f, 0.f}, s1 = s0, u0 = s0, u1 = s0;
        for (int jj = 0; jj < cnt; ++jj) { f32x4 a, b; unpack8(*(const u32x4*)(UP + (size_t)(t - jj) * DP + c0), a, b); if (jj == 0) { u0 = a; u1 = b; } s0 += a; s1 += b; }
        const float inv = 1.f / (float)cnt;
        *(u32x4*)(DOB + (size_t)t * DM + c0) = pack8(s0 * inv - u0, s1 * inv - u1);
    }
}

constexpr int TROW = 72;
DI void h1_phase(Frame& F) {
    const bf16_t* V = (const bf16_t*)(F.ws + WS_V); const bf16_t* KK = (const bf16_t*)(F.ws + WS_KK); const float* BC = (const float*)(F.ws + WS_BC); float* LT = (float*)(F.ws + WS_LT);
    LAS short* VT = (LAS short*)(F.lds); LAS short* KT = (LAS short*)(F.lds + 128 * TROW * 2);
    const int tid = F.tid, s = tid & 63, cg = F.wave, lane = F.lane;
    for (int uidx = F.vcu; uidx < NCHUNK * 8; uidx += F.G) {
        const int n = uidx >> 3, h = uidx & 7, t = 64 * n + s, col = h * 128 + 16 * cg;
        {
            const u32x4 v0 = *(const u32x4*)(V + (size_t)t * DH + col), v1 = *(const u32x4*)(V + (size_t)t * DH + col + 8);
            const u32x4 k0 = *(const u32x4*)(KK + (size_t)t * DH + col), k1 = *(const u32x4*)(KK + (size_t)t * DH + col + 8);
            f32x4 b[4], e[4];
#pragma unroll
            for (int i = 0; i < 4; ++i) { b[i] = *(const f32x4*)(BC + (size_t)t * DH + col + 4 * i); e[i] = *(const f32x4*)(BC + (size_t)(64 * n + 63) * DH + col + 4 * i); }
            const unsigned vw[8] = {v0.x, v0.y, v0.z, v0.w, v1.x, v1.y, v1.z, v1.w}, kw[8] = {k0.x, k0.y, k0.z, k0.w, k1.x, k1.y, k1.z, k1.w};
#pragma unroll
            for (int i = 0; i < 8; ++i) {
                const int c = 2 * i;
                VT[(16 * cg + c) * TROW + s] = (short)(vw[i] & 0xffffu); VT[(16 * cg + c + 1) * TROW + s] = (short)(vw[i] >> 16);
                const float ka = bf_lo(kw[i]) * __expf(e[c >> 2][c & 3] - b[c >> 2][c & 3]), kb = bf_hi(kw[i]) * __expf(e[(c + 1) >> 2][(c + 1) & 3] - b[(c + 1) >> 2][(c + 1) & 3]);
                const unsigned kp = pk2(ka, kb);
                KT[(16 * cg + c) * TROW + s] = (short)(kp & 0xffffu); KT[(16 * cg + c + 1) * TROW + s] = (short)(kp >> 16);
            }
        }
        __syncthreads();
        {
            const int vt = F.wave >> 1, kt0 = 2 * (F.wave & 1), r = lane & 31, hh = lane >> 5;
            f32x16 a0, a1;
#pragma unroll
            for (int i = 0; i < 16; ++i) { a0[i] = 0.f; a1[i] = 0.f; }
#pragma unroll
            for (int st = 0; st < 4; ++st) {
                const int s0 = 16 * st + 8 * hh;
                const bf16x8 af = *(const LAS bf16x8*)(VT + (32 * vt + r) * TROW + s0);
                const bf16x8 b0 = *(const LAS bf16x8*)(KT + (32 * kt0 + r) * TROW + s0), b1 = *(const LAS bf16x8*)(KT + (32 * (kt0 + 1) + r) * TROW + s0);
                a0 = __builtin_amdgcn_mfma_f32_32x32x16_bf16(af, b0, a0, 0, 0, 0);
                a1 = __builtin_amdgcn_mfma_f32_32x32x16_bf16(af, b1, a1, 0, 0, 0);
            }
            float* lt = LT + (size_t)uidx * 16384;
#pragma unroll
            for (int i = 0; i < 16; ++i) { const int v = 32 * vt + 8 * (i >> 2) + 4 * hh + (i & 3);
                lt[v * 128 + 32 * kt0 + r] = a0[i]; lt[v * 128 + 32 * (kt0 + 1) + r] = a1[i]; }
        }
        __syncthreads();
    }
}
DI void h2_phase(Frame& F) {
    float* LT = (float*)(F.ws + WS_LT); const float* BC = (const float*)(F.ws + WS_BC);
    const int gt = F.vcu * 512 + F.tid, NGT = F.G * 512;
    for (int idx = gt; idx < 8 * 16384; idx += NGT) {
        const int h = idx >> 14, vk = idx & 16383, k = idx & 127;
        float st = 0.f;
        for (int n0 = 0; n0 < NCHUNK; n0 += 8) {
            float L[8], d[8];
#pragma unroll
            for (int j = 0; j < 8; ++j) { L[j] = LT[(size_t)((n0 + j) * 8 + h) * 16384 + vk]; d[j] = BC[(size_t)(64 * (n0 + j) + 63) * DH + h * 128 + k]; }
#pragma unroll
            for (int j = 0; j < 8; ++j) { LT[(size_t)((n0 + j) * 8 + h) * 16384 + vk] = st; st = __expf(d[j]) * st + L[j]; }
        }
    }
}
DI void h3_phase(Frame& F) {
    const bf16_t* Q = (const bf16_t*)(F.ws + WS_Q); const bf16_t* KK = (const bf16_t*)(F.ws + WS_KK); const bf16_t* V = (const bf16_t*)(F.ws + WS_V); const bf16_t* SG = (const bf16_t*)(F.ws + WS_SG);
    const float* BC = (const float*)(F.ws + WS_BC); const float* LT = (const float*)(F.ws + WS_LT); bf16_t* DOB = (bf16_t*)(F.ws + WS_DOB); const float* NW = F.in[7];
    const int tid = F.tid, lane = F.lane, r = lane & 31, hh = lane >> 5;
    for (int pass = F.vcu; pass < NCHUNK * 8 / 4; pass += F.G) {
        {
            const int s = tid & 63, cg = F.wave;
#pragma unroll
            for (int q = 0; q < 4; ++q) {
                const int uidx = 4 * pass + q, n = uidx >> 3, h = uidx & 7, t = 64 * n + s, col = h * 128 + 16 * cg;
                LAS short* VT = (LAS short*)(F.lds + q * (128 * TROW * 2));
                const u32x4 v0 = *(const u32x4*)(V + (size_t)t * DH + col), v1 = *(const u32x4*)(V + (size_t)t * DH + col + 8);
                const unsigned vw[8] = {v0.x, v0.y, v0.z, v0.w, v1.x, v1.y, v1.z, v1.w};
#pragma unroll
                for (int i = 0; i < 8; ++i) { VT[(16 * cg + 2 * i) * TROW + s] = (short)(vw[i] & 0xffffu); VT[(16 * cg + 2 * i + 1) * TROW + s] = (short)(vw[i] >> 16); }
            }
        }
        __syncthreads();
        {
            const int q = F.wave >> 1, ti = F.wave & 1, uidx = 4 * pass + q, n = uidx >> 3, h = uidx & 7, t0 = 64 * n, hc = h * 128;
            const LAS short* VT = (const LAS short*)(F.lds + q * (128 * TROW * 2));
            const int tq = t0 + 32 * ti + r;
            bf16x8 qf[8];
#pragma unroll
            for (int st = 0; st < 8; ++st) {
                const int k0 = 16 * st + 8 * hh;
                f32x4 a, b; unpack8(*(const u32x4*)(Q + (size_t)tq * DH + hc + k0), a, b);
                const f32x4 b0 = *(const f32x4*)(BC + (size_t)tq * DH + hc + k0), b1 = *(const f32x4*)(BC + (size_t)tq * DH + hc + k0 + 4);
#pragma unroll
                for (int c = 0; c < 4; ++c) { a[c] *= __expf(b0[c]); b[c] *= __expf(b1[c]); }
                qf[st] = __builtin_bit_cast(bf16x8, pack8(a, b));
            }
            f32x16 X[2];
#pragma unroll
            for (int i = 0; i < 16; ++i) { X[0][i] = 0.f; X[1][i] = 0.f; }
#pragma unroll
            for (int sb = 0; sb < 2; ++sb) {
                if (sb <= ti) {
                    const int ts = t0 + 32 * sb + r;
#pragma unroll
                    for (int st = 0; st < 8; ++st) {
                        const int k0 = 16 * st + 8 * hh;
                        f32x4 a, b; unpack8(*(const u32x4*)(KK + (size_t)ts * DH + hc + k0), a, b);
                        const f32x4 b0 = *(const f32x4*)(BC + (size_t)ts * DH + hc + k0), b1 = *(const f32x4*)(BC + (size_t)ts * DH + hc + k0 + 4);
#pragma unroll
                        for (int c = 0; c < 4; ++c) { a[c] *= __expf(-b0[c]); b[c] *= __expf(-b1[c]); }
                        X[sb] = __builtin_amdgcn_mfma_f32_32x32x16_bf16(__builtin_bit_cast(bf16x8, pack8(a, b)), qf[st], X[sb], 0, 0, 0);
                    }
                }
            }
#pragma unroll
            for (int i = 0; i < 16; ++i) { const int sl = 8 * (i >> 2) + 4 * hh + (i & 3); const bool keep = sl <= r;
                if (ti == 0) X[0][i] = keep ? X[0][i] : 0.f; else X[1][i] = keep ? X[1][i] : 0.f; }
            f32x16 O[4];
#pragma unroll
            for (int vt = 0; vt < 4; ++vt)
#pragma unroll
                for (int i = 0; i < 16; ++i) O[vt][i] = 0.f;
#pragma unroll
            for (int sb = 0; sb < 2; ++sb) {
                if (sb <= ti) {
#pragma unroll
                    for (int sp = 0; sp < 2; ++sp) {
                        u32x4 xb; xb.x = pk2(X[sb][8 * sp + 0], X[sb][8 * sp + 1]); xb.y = pk2(X[sb][8 * sp + 2], X[sb][8 * sp + 3]); xb.z = pk2(X[sb][8 * sp + 4], X[sb][8 * sp + 5]); xb.w = pk2(X[sb][8 * sp + 6], X[sb][8 * sp + 7]);
                        const bf16x8 bfrag = __builtin_bit_cast(bf16x8, xb);
                        const int sbase = 32 * sb + 16 * sp + 4 * hh;
#pragma unroll
                        for (int vt = 0; vt < 4; ++vt) {
                            const s16x4 lo = *(const LAS s16x4*)(VT + (32 * vt + r) * TROW + sbase), hi = *(const LAS s16x4*)(VT + (32 * vt + r) * TROW + sbase + 8);
                            const bf16x8 af = __builtin_shufflevector(lo, hi, 0, 1, 2, 3, 4, 5, 6, 7);
                            O[vt] = __builtin_amdgcn_mfma_f32_32x32x16_bf16(af, bfrag, O[vt], 0, 0, 0);
                        }
                    }
                }
            }
            const float* st_ = LT + (size_t)uidx * 16384;
#pragma unroll
            for (int vt = 0; vt < 4; ++vt) {
#pragma unroll
                for (int st = 0; st < 8; ++st) {
                    const int k0 = 16 * st + 8 * hh;
                    const f32x4 s0 = *(const f32x4*)(st_ + (32 * vt + r) * 128 + k0), s1 = *(const f32x4*)(st_ + (32 * vt + r) * 128 + k0 + 4);
                    O[vt] = __builtin_amdgcn_mfma_f32_32x32x16_bf16(__builtin_bit_cast(bf16x8, pack8(s0, s1)), qf[st], O[vt], 0, 0, 0);
                }
            }
            float ss = 0.f;
#pragma unroll
            for (int vt = 0; vt < 4; ++vt)
#pragma unroll
                for (int i = 0; i < 16; ++i) ss += O[vt][i] * O[vt][i];
            ss += __shfl_xor(ss, 32);
            const float rn = rsqrtf(ss * (1.f / 128.f) + EPS);
#pragma unroll
            for (int vt = 0; vt < 4; ++vt)
#pragma unroll
                for (int g4 = 0; g4 < 4; ++g4) {
                    const int v0 = 32 * vt + 8 * g4 + 4 * hh;
                    const f32x4 nw = *(const f32x4*)(NW + hc + v0);
                    const u32x2 sg = *(const u32x2*)(SG + (size_t)tq * DH + hc + v0);
                    u32x2 w;
                    w.x = pk2(O[vt][4 * g4 + 0] * rn * nw.x * bf_lo(sg.x), O[vt][4 * g4 + 1] * rn * nw.y * bf_hi(sg.x));
                    w.y = pk2(O[vt][4 * g4 + 2] * rn * nw.z * bf_lo(sg.y), O[vt][4 * g4 + 3] * rn * nw.w * bf_hi(sg.y));
                    *(u32x2*)(DOB + (size_t)tq * DM + DP + hc + v0) = w;
                }
        }
        __syncthreads();
    }
}
DI void fixup_phase(Frame& F) {
    const float* ZB = (const float*)(F.ws + WS_ZB); bf16_t* ACT = (bf16_t*)(F.ws + WS_ACT); const float* cw = F.in[13]; const float* cb = F.in[14];
    const int gt = F.vcu * 512 + F.tid, NGT = F.G * 512;
    for (int idx = gt; idx < 128 * 2 * DFF; idx += NGT) {
        const int c = idx % DFF, bj = idx / DFF, j = bj & 1, b = bj >> 1;
        const int pg = 256 * (c >> 7) + (c & 127);
        float u2[2];
#pragma unroll
        for (int hv = 0; hv < 2; ++hv) {
            const int p = pg + 128 * hv, oc = c + DFF * hv;
            const float* zb = ZB + (size_t)b * 4 * DFF2 + p;
            const float zt = zb[(size_t)j * DFF2];
            const float* zpv = zb - (b > 0 ? 4 * DFF2 : 0); const float p3 = b > 0 ? zpv[3 * DFF2] : 0.f, p2 = b > 0 ? zpv[2 * DFF2] : 0.f;
            const float z1 = j ? zb[0] : p3, z2 = j ? p3 : p2;
            u2[hv] = cb[oc] + cw[2 * DFF2 + oc] * zt + cw[DFF2 + oc] * z1 + cw[oc] * z2;
        }
        ACT[(size_t)(64 * b + j) * DFF + c] = (bf16_t)(pk2(u2[0] * sigm(u2[0]) * u2[1], 0.f) & 0xffffu);
    }
}
DI void final_phase(Frame& F) {
    const float* SSQ = (const float*)(F.ws + WS_SSQ3); const float* wf = F.in[19]; float* out = F.out;
    const int gw = F.vcu * NWAVES + F.wave, NGW = F.G * NWAVES;
    for (int m = gw; m < S; m += NGW) {
        float s = F.lane < 32 ? SSQ[(size_t)m * 32 + F.lane] : 0.f;
        s = wave_sum(s);
        const float rr = rsqrtf(s * (1.f / DM) + EPS);
        f32x4* xr = (f32x4*)(out + (size_t)m * DM) + F.lane; const f32x4* wr_ = (const f32x4*)wf + F.lane;
#pragma unroll
        for (int j = 0; j < 8; ++j) { const f32x4 v = xr[64 * j], w = wr_[64 * j]; xr[64 * j] = v * rr * w; }
    }
}

struct Args { const float* in[20]; float* out; unsigned char* ws; int ph_lo, ph_hi, li, pad; };
constexpr int NPHASE = 12;
__global__ void __launch_bounds__(NWAVES * 64, 2) mk_fwd(Args args) {
    extern __shared__ __attribute__((aligned(16))) unsigned char lds[];
    Frame F;
    F.lds = (LAS unsigned char*)lds;
    F.tid = threadIdx.x; F.lane = F.tid & 63; F.wave = __builtin_amdgcn_readfirstlane(F.tid >> 6);
    F.G = gridDim.x; { const int bx = blockIdx.x; F.vcu = (F.G % 8 == 0) ? (bx % 8) * (F.G / 8) + bx / 8 : bx; }
    F.ws = args.ws; F.out = args.out; F.in = args.in;
    volatile LAS unsigned* MISC = (volatile LAS unsigned*)(F.lds + MISC_OFF);
    for (int u = F.tid; u < (LDS_BYTES - LDSCTL_OFF) / 4; u += NWAVES * 64) ((LAS unsigned*)(F.lds + LDSCTL_OFF))[u] = 0u;
    __syncthreads();
    const bool multi = (args.ph_hi - args.ph_lo) > 1;
    XcdBarrier bar; bar.bar = (unsigned*)(args.ws + WS_CTL) + CW_BAR + args.li * XCD_BAR_WORDS; bar.x = 0; bar.st = nullptr;
    if (multi) bar = xcd_barrier_post(bar.bar, MISC + 8);
    const int lo = args.ph_lo, hi = args.ph_hi;
#define IN(k) (lo <= (k) && (k) < hi)
#define SEAM(k) do { if (IN(k) && IN((k) + 1)) xcd_barrier(bar); } while (0)
    unsigned char* ws = args.ws;
    const int bid = (int)blockIdx.x;

    if (IN(0)) { p0_prologue(F); } SEAM(0);
    if (IN(1)) {
        pg8::Gemm g{(const bf16_t*)(ws + WS_XB), (const bf16_t*)(ws + WS_WIN), DM, DM, DM}; pg8::StaticOrder So; So.init(S, DIN, F.G, bid);
        EpiProj E{ws, F.out};
        pg8::gemm_phase<EpiProj, true>(F.lds, g, So, E);
    } SEAM(1);
    if (IN(2)) { h1_phase(F); pool_phase(F); } SEAM(2);
    if (IN(3)) { h2_phase(F); } SEAM(3);
    if (IN(4)) { h3_phase(F); } SEAM(4);
    if (IN(5)) {
        { pg8::Gemm g{(const bf16_t*)(ws + WS_DOB), (const bf16_t*)(ws + WS_WAB), DM, DM, DP}; pg8::StaticOrder So; So.init(S, DM, F.G, bid);
          EpiGate<0> E{(const bf16_t*)F.out, (float*)(ws + WS_TMP), nullptr};
          pg8::gemm_phase<EpiGate<0>, false>(F.lds, g, So, E); }
        { pg8::Gemm g{(const bf16_t*)(ws + WS_DOB) + DP, (const bf16_t*)(ws + WS_WAB) + DP, DM, DM, DH}; pg8::StaticOrder So; So.init(S, DM, F.G, bid);
          EpiGate<1> E{(const bf16_t*)F.out + (size_t)S * DM, (float*)(ws + WS_TMP), (bf16_t*)(ws + WS_MG)};
          pg8::gemm_phase<EpiGate<1>, false>(F.lds, g, So, E); }
    } SEAM(5);
    if (IN(6)) {
        { pg8::Gemm g{(const bf16_t*)(ws + WS_MG), (const bf16_t*)(ws + WS_WOUT), DM, DM, DM}; pg8::StaticOrder So; So.init(S, DM, F.G, bid);
          EpiRes E{F.in[0], F.out, (bf16_t*)(ws + WS_XB), (float*)(ws + WS_SSQ1)};
          pg8::gemm_phase<EpiRes, false>(F.lds, g, So, E); }
        { pg8::Gemm g{(const bf16_t*)(ws + WS_PB), (const bf16_t*)(ws + WS_WPLE), PLE, PLE, PLE}; pg8::StaticOrder So; So.init(S, DM, F.G, bid);
          EpiBf E{(bf16_t*)(ws + WS_E), DM};
          pg8::gemm_phase<EpiBf, false>(F.lds, g, So, E); }
    } SEAM(6);
    if (IN(7)) {
        pg8::Gemm g{(const bf16_t*)(ws + WS_XB), (const bf16_t*)(ws + WS_WUP), DM, DM, DM}; pg8::StaticOrder So; So.init(S, DFF2, F.G, bid);
        EpiUp E{ws, F.in[13], F.in[14]};
        pg8::gemm_phase<EpiUp, true>(F.lds, g, So, E);
    } SEAM(7);
    if (IN(8)) { fixup_phase(F); } SEAM(8);
    if (IN(9)) {
        pg8::Gemm g{(const bf16_t*)(ws + WS_ACT), (const bf16_t*)(ws + WS_WDOWN), DFF, DFF, DFF}; pg8::StaticOrder So; So.init(S, DM, F.G, bid);
        EpiRes E{F.out, F.out, (bf16_t*)(ws + WS_XB), (float*)(ws + WS_SSQ2)};
        pg8::gemm_phase<EpiRes, false>(F.lds, g, So, E);
    } SEAM(9);
    if (IN(10)) {
        pg8::Gemm g{(const bf16_t*)(ws + WS_XB), (const bf16_t*)(ws + WS_WPG), DM, DM, DM}; pg8::StaticOrder So; So.init(S, DM, F.G, bid);
        EpiPle E{ws, F.out};
        pg8::gemm_phase<EpiPle, false>(F.lds, g, So, E);
    } SEAM(10);
    if (IN(11)) { final_phase(F); }
#undef IN
#undef SEAM
}

#ifndef MK_N_LAUNCHES
#define MK_N_LAUNCHES 1
#endif
extern "C" void kernel_launch(void* const* d_in, const int* in_sizes, int n_in, void* d_out, int out_size, void* d_ws, size_t ws_size, hipStream_t stream) {
    static int grid = 0;
    if (grid == 0) {
        if (n_in != 20 || in_sizes[0] != S * DM || out_size != S * DM || ws_size < WS_END) { fprintf(stderr, "kernel_launch: unexpected shapes / workspace (%zu < %zu)\n", ws_size, (size_t)WS_END); grid = -1; return; }
        int dev = 0, cus = 0, per_cu = 0;
        if (hipGetDevice(&dev) != hipSuccess || hipDeviceGetAttribute(&cus, hipDeviceAttributeMultiprocessorCount, dev) != hipSuccess) { grid = -1; return; }
        if (hipFuncSetAttribute((const void*)mk_fwd, hipFuncAttributeMaxDynamicSharedMemorySize, LDS_BYTES) != hipSuccess) { fprintf(stderr, "kernel_launch: hipFuncSetAttribute failed\n"); grid = -1; return; }
        if (hipOccupancyMaxActiveBlocksPerMultiprocessor(&per_cu, (const void*)mk_fwd, NWAVES * 64, LDS_BYTES) != hipSuccess || per_cu < 1) { fprintf(stderr, "kernel_launch: occupancy query says %d\n", per_cu); per_cu = 1; }
        (void)hipGetLastError();
        grid = cus;
    }
    if (grid < 0) return;
    (void)hipMemsetAsync((char*)d_ws + WS_CTL, 0, CTL_ZERO_BYTES, stream);
    Args a{};
    for (int i = 0; i < 20; ++i) a.in[i] = (const float*)d_in[i];
    a.out = (float*)d_out; a.ws = (unsigned char*)d_ws;
    if (MK_N_LAUNCHES == 1) {
        a.ph_lo = 0; a.ph_hi = NPHASE; a.li = 0;
        hipLaunchKernelGGL(mk_fwd, dim3(grid), dim3(NWAVES * 64), LDS_BYTES, stream, a);
    } else {
        for (int ph = 0; ph < NPHASE; ++ph) { a.ph_lo = ph; a.ph_hi = ph + 1; a.li = 0; hipLaunchKernelGGL(mk_fwd, dim3(grid), dim3(NWAVES * 64), LDS_BYTES, stream, a); }
    }
}
```

```cpp
#include <hip/hip_runtime.h>
#include <cstdio>
#include <cstdint>

#define LAS __attribute__((address_space(3)))
#define GAS __attribute__((address_space(1)))
typedef unsigned short bf16_t;
typedef short bf16x8 __attribute__((ext_vector_type(8)));
typedef short s16x4 __attribute__((ext_vector_type(4)));
typedef float f32x4 __attribute__((ext_vector_type(4)));
typedef float f32x2 __attribute__((ext_vector_type(2)));
typedef float f32x16 __attribute__((ext_vector_type(16)));
typedef unsigned u32x4 __attribute__((ext_vector_type(4)));
typedef unsigned u32x2 __attribute__((ext_vector_type(2)));
typedef __bf16 bf16v2 __attribute__((ext_vector_type(2)));
#define DI __device__ __forceinline__

constexpr int S = 8192, DM = 2048, DP = 1024, DH = 1024, DIN = 9216, DFF = 5504, DFF2 = 11008, PLE = 256, NCHUNK = 128;
constexpr float EPS = 1e-6f;

DI unsigned pk2(float lo, float hi) { f32x2 v = {lo, hi}; bf16v2 r = __builtin_convertvector(v, bf16v2); return __builtin_bit_cast(unsigned, r); }
DI float bf_lo(unsigned w) { return __builtin_bit_cast(float, w << 16); }
DI float bf_hi(unsigned w) { return __builtin_bit_cast(float, w & 0xffff0000u); }
DI float sigm(float v) { return __builtin_amdgcn_rcpf(1.0f + __expf(-v)); }
DI float wave_sum(float v) {
#pragma unroll
    for (int o = 1; o < 64; o <<= 1) v += __shfl_xor(v, o);
    return v;
}
template <int CTRL> DI float dppf(float v) { return __builtin_bit_cast(float, __builtin_amdgcn_update_dpp(0, __builtin_bit_cast(int, v), CTRL, 0xf, 0xf, true)); }
DI u32x4 pack8(f32x4 a, f32x4 b) { u32x4 w; w.x = pk2(a.x, a.y); w.y = pk2(a.z, a.w); w.z = pk2(b.x, b.y); w.w = pk2(b.z, b.w); return w; }
DI void unpack8(u32x4 w, f32x4& a, f32x4& b) { a.x = bf_lo(w.x); a.y = bf_hi(w.x); a.z = bf_lo(w.y); a.w = bf_hi(w.y); b.x = bf_lo(w.z); b.y = bf_hi(w.z); b.z = bf_lo(w.w); b.w = bf_hi(w.w); }

DI int fq_off(int ti, int st, int lanep) { return ((ti * 8 + st) * 64 + lanep) * 8; }

namespace pg8 {
constexpr int BM = 256, BK = 64, HALF = 128, HTB = HALF * BK * 2, STAGE_BYTES = 8 * HTB, NXCD = 8, WGM = 8;
__host__ __device__ __forceinline__ int lds_byte(int r, int c) { const int st = (r >> 4) * 2 + (c >> 5), rr = r & 15, cc = c & 31, ob = rr * 64 + cc * 2; return st * 1024 + (ob ^ (((ob >> 9) & 1) << 5)); }
__host__ __device__ __forceinline__ void stage_rc(int b, int& R, int& C) { const int st = b / 1024, sb = b % 1024, swz = sb ^ (((sb >> 9) & 1) << 5); R = (st >> 1) * 16 + swz / 64; C = (st & 1) * 32 + (swz % 64) / 2; }
__host__ __device__ __forceinline__ int perm32(int rho) { const int n = rho >> 4, i = rho & 15; return 8 * (i >> 2) + 4 * n + (i & 3); }

struct Unit { int pm, pn, ui; };
struct Gemm { const bf16_t* A; const bf16_t* Bt; int lda, ldb, K; };

struct StaticOrder {
    int nM, nN, nwg, G, c, wgm;
    DI void init(int M, int N, int G_, int c_, int wgm_ = WGM) { nM = M / BM; nN = N / BM; nwg = nM * nN; G = G_; c = c_; wgm = wgm_; }
    DI bool next(int i, Unit& u) const {
        const long L = (long)i * G + c; if (L >= nwg) return false;
        int wgid = (int)L; { const int q = nwg / NXCD, r = nwg % NXCD, xcd = wgid % NXCD, off = wgid / NXCD; wgid = (xcd < r ? xcd * (q + 1) : r * (q + 1) + (xcd - r) * q) + off; }
        const int nig = wgm * nN, gid = wgid / nig, fm = gid * wgm, gsz = (nM - fm) < wgm ? (nM - fm) : wgm;
        u.pm = fm + ((wgid % nig) % gsz); u.pn = (wgid % nig) / gsz; return true;
    }
};

struct TailOrder {
    int nM, nN, nwg, G, c, c0;
    DI void init(int M, int N, int G_, int c_, int c0_) { nM = M / BM; nN = N / BM; nwg = nM * nN; G = G_; c = c_; c0 = c0_; }
    DI bool next(int i, Unit& u) const {
        if (c < c0) return false;
        const int L = (c - c0) + i * (G - c0); if (L >= nwg) return false;
        u.pm = L / nN; u.pn = L - u.pm * nN; return true;
    }
};
template <class Epi, bool ALIGN_EPI, class Sched = StaticOrder>
DI void gemm_phase(LAS unsigned char* lds, const Gemm g, const Sched& S, const Epi& E) {
    int tid_o = threadIdx.x; asm volatile("" : "+v"(tid_o));
    const int tid = tid_o, wid = __builtin_amdgcn_readfirstlane(tid >> 6), lane = tid & 63, wr = wid >> 2, wc = wid & 3, fr = lane & 15, fq = lane >> 4;
    const int K = g.K, nt = K / BK;
    unsigned voffA[2], voffB[2];
#pragma unroll
    for (int i = 0; i < 2; ++i) { int R, C; stage_rc(tid * 16 + i * 8192, R, C); const int Rb = (R & ~31) + perm32(R & 31);
        voffA[i] = (unsigned)(R * g.lda + C) * 2u; voffB[i] = (unsigned)(Rb * g.ldb + C) * 2u; }
    const size_t kstep = (size_t)(BK * 2);
    const size_t hstepA = (size_t)HALF * g.lda * 2, hstepB = (size_t)HALF * g.ldb * 2;
    const size_t tstepA = 2 * hstepA, tstepB = 2 * hstepB;
    const unsigned ldsw = (unsigned)wid * 1024u;
    const int aoff = lds_byte(wr * 64 + fr, fq * 8), boff = lds_byte(wc * 32 + fr, fq * 8);
#define PG8_SA(b, h) (((b) * 2 + (h)) * HTB)
#define PG8_SB(b, h) ((4 + (b) * 2 + (h)) * HTB)
#define PG8_STAGE(bufoff, gbase, voff) do { _Pragma("unroll") for (int _i = 0; _i < 2; ++_i) \
        __builtin_amdgcn_global_load_lds((const unsigned*)((const char*)(gbase) + (voff)[_i]), (LAS unsigned*)(lds + (bufoff) + ldsw + _i * 8192), 16, 0, 0); } while (0)
#define PG8_LDA(dst, b, h) do { _Pragma("unroll") for (int m = 0; m < 4; ++m) _Pragma("unroll") for (int k = 0; k < 2; ++k) dst[m][k] = *(const LAS bf16x8*)(lds + PG8_SA(b, h) + aoff + m * 2048 + k * 1024); } while (0)
#define PG8_LDB(dst, b, h) do { _Pragma("unroll") for (int n = 0; n < 2; ++n) _Pragma("unroll") for (int k = 0; k < 2; ++k) dst[n][k] = *(const LAS bf16x8*)(lds + PG8_SB(b, h) + boff + n * 2048 + k * 1024); } while (0)
#define PG8_MMA(ai, bj, At, Bt) do { __builtin_amdgcn_s_setprio(1); _Pragma("unroll") for (int m = 0; m < 4; ++m) _Pragma("unroll") for (int n = 0; n < 2; ++n) _Pragma("unroll") for (int k = 0; k < 2; ++k) \
        acc[ai][bj][m][n] = __builtin_amdgcn_mfma_f32_16x16x32_bf16(Bt[n][k], At[m][k], acc[ai][bj][m][n], 0, 0, 0); __builtin_amdgcn_s_setprio(0); } while (0)
#define PG8_WAIT_V(n) asm volatile("s_waitcnt vmcnt(" #n ")" ::: "memory")
#define PG8_WAIT_L(n) asm volatile("s_waitcnt lgkmcnt(" #n ")" ::: "memory")
#define PG8_BAR __builtin_amdgcn_s_barrier()
#define PG8_SCHED __builtin_amdgcn_sched_barrier(0)
    Unit cur, nxt; int ui = 0;
    if (!S.next(0, cur)) return;
    cur.ui = 0;
    if constexpr (Epi::HAS_PRE) E.pre(lds, cur, wid, lane);
    f32x4 acc[2][2][4][2];
#pragma unroll
    for (int a = 0; a < 2; ++a)
#pragma unroll
        for (int b = 0; b < 2; ++b)
#pragma unroll
            for (int m = 0; m < 4; ++m)
#pragma unroll
                for (int n = 0; n < 2; ++n) acc[a][b][m][n] = (f32x4){0.f, 0.f, 0.f, 0.f};
    bf16x8 At[4][2], B0[2][2], B1[2][2];
    const char* cA = (const char*)g.A + (size_t)cur.pm * tstepA; const char* cB = (const char*)g.Bt + (size_t)cur.pn * tstepB;
    PG8_STAGE(PG8_SB(0, 0), cB, voffB); PG8_STAGE(PG8_SB(0, 1), cB + hstepB, voffB); PG8_STAGE(PG8_SA(0, 0), cA, voffA); PG8_STAGE(PG8_SA(0, 1), cA + hstepA, voffA);
    if (wr == 1) PG8_BAR;
    PG8_WAIT_V(2); PG8_BAR;
    PG8_STAGE(PG8_SB(1, 0), cB + kstep, voffB); PG8_STAGE(PG8_SA(1, 0), cA + kstep, voffA); PG8_STAGE(PG8_SB(1, 1), cB + hstepB + kstep, voffB);
    PG8_WAIT_V(6); PG8_BAR;
    for (;;) {
        const bool has_next = S.next(ui + 1, nxt);
        const char* nA = has_next ? (const char*)g.A + (size_t)nxt.pm * tstepA : cA; const char* nB = has_next ? (const char*)g.Bt + (size_t)nxt.pn * tstepB : cB;
        for (int t = 0; t < nt; t += 2) {
            const bool last = (t == nt - 2);
            const char* a1 = cA + (size_t)(t + 1) * kstep;
            const char* a2 = last ? nA : cA + (size_t)(t + 2) * kstep; const char* b2 = last ? nB : cB + (size_t)(t + 2) * kstep;
            const char* a3 = a2 + kstep; const char* b3 = b2 + kstep;
            if constexpr (Epi::MIDK != 0) { if (t == Epi::MIDK) E.mid(acc, cur, wr, wc, fr, fq); }
            PG8_LDB(B0, 0, 0); PG8_LDB(B1, 0, 1); PG8_SCHED; PG8_LDA(At, 0, 0); PG8_STAGE(PG8_SA(1, 1), a1 + hstepA, voffA);
            PG8_WAIT_V(8); PG8_WAIT_L(0); PG8_BAR; PG8_MMA(0, 0, At, B0); PG8_MMA(0, 1, At, B1); PG8_BAR; PG8_SCHED;
            PG8_LDA(At, 0, 1); PG8_STAGE(PG8_SB(0, 0), b2, voffB); PG8_STAGE(PG8_SB(0, 1), b2 + hstepB, voffB); PG8_STAGE(PG8_SA(0, 0), a2, voffA);
            PG8_WAIT_V(8); PG8_WAIT_L(0); PG8_BAR; PG8_MMA(1, 0, At, B0); PG8_MMA(1, 1, At, B1); PG8_BAR; PG8_SCHED;
            PG8_LDB(B0, 1, 0); PG8_LDB(B1, 1, 1); PG8_SCHED; PG8_LDA(At, 1, 0); PG8_STAGE(PG8_SA(0, 1), a2 + hstepA, voffA);
            PG8_WAIT_V(8); PG8_WAIT_L(0); PG8_BAR; PG8_MMA(0, 0, At, B0); PG8_MMA(0, 1, At, B1); PG8_BAR; PG8_SCHED;
            PG8_LDA(At, 1, 1); PG8_STAGE(PG8_SB(1, 0), b3, voffB); PG8_STAGE(PG8_SB(1, 1), b3 + hstepB, voffB); PG8_STAGE(PG8_SA(1, 0), a3, voffA);
            PG8_WAIT_V(8); PG8_WAIT_L(0); PG8_BAR; PG8_MMA(1, 0, At, B0); PG8_MMA(1, 1, At, B1); PG8_BAR; PG8_SCHED;
        }
        if constexpr (ALIGN_EPI) { if (wr == 0) PG8_BAR; }
        if constexpr (!Epi::AFTER_DRAIN) E(acc, cur, wr, wc, fr, fq);
        if (!has_next) break;
#pragma unroll
        for (int a = 0; a < 2; ++a)
#pragma unroll
            for (int b = 0; b < 2; ++b)
#pragma unroll
                for (int m = 0; m < 4; ++m)
#pragma unroll
                    for (int n = 0; n < 2; ++n) acc[a][b][m][n] = (f32x4){0.f, 0.f, 0.f, 0.f};
        cur = nxt; cA = nA; cB = nB; ++ui; cur.ui = ui;
        if constexpr (Epi::HAS_PRE) E.pre(lds, cur, wid, lane);
        if constexpr (ALIGN_EPI) { if (wr == 1) PG8_BAR; }
    }
    PG8_WAIT_V(0);
    if constexpr (!ALIGN_EPI) { if (wr == 0) PG8_BAR; }
    PG8_BAR;
    if constexpr (Epi::AFTER_DRAIN) E.fused(acc, cur, wr, wc, fr, fq);
#undef PG8_SA
#undef PG8_SB
#undef PG8_STAGE
#undef PG8_LDA
#undef PG8_LDB
#undef PG8_MMA
#undef PG8_WAIT_V
#undef PG8_WAIT_L
#undef PG8_BAR
#undef PG8_SCHED
}
}
using pg8::Unit;
typedef f32x4 AccT[2][2][4][2];

constexpr size_t MiB = 1u << 20;
constexpr size_t WS_CTL = 0, CTL_ZERO_BYTES = 1 * MiB;
constexpr size_t WS_R1 = 1 * MiB, WS_LB = WS_R1 + 65536;
constexpr size_t WS_SSQ1 = 2 * MiB, WS_SSQ2 = 3 * MiB, WS_SSQ3 = 4 * MiB;
constexpr size_t WS_WAB = 6 * MiB, WS_WOUT = 14 * MiB, WS_WPG = 22 * MiB, WS_WPLE = 30 * MiB, WS_WDOWN = 31 * MiB, WS_WUP = 53 * MiB, WS_WIN = 96 * MiB;
constexpr size_t WS_XB = 132 * MiB;
constexpr size_t WS_UP = 164 * MiB, WS_Q = 180 * MiB, WS_KK = 196 * MiB, WS_V = 212 * MiB, WS_SG = 228 * MiB;
constexpr size_t WS_KP = 244 * MiB, WS_DL = 260 * MiB;
constexpr size_t WS_BC = 244 * MiB;
constexpr size_t WS_DOB = 276 * MiB;
constexpr size_t WS_PB = 308 * MiB;
constexpr size_t WS_ZB = 312 * MiB;
constexpr size_t WS_END = 344 * MiB;
constexpr size_t WS_LT = 96 * MiB;
constexpr size_t WS_TMP = 164 * MiB;
constexpr size_t WS_MG = 244 * MiB;
constexpr size_t WS_STB = 312 * MiB;
constexpr size_t WS_E = 96 * MiB;
constexpr size_t WS_ACT = 164 * MiB;
static_assert(WS_WUP + (size_t)DFF2 * DM * 2 <= WS_WIN && WS_WIN + (size_t)DIN * DM * 2 <= WS_XB && WS_LT + (size_t)256 * 16384 * 4 <= WS_XB, "ws map");
static_assert(WS_ACT + (size_t)S * DFF * 2 <= WS_DOB && WS_ZB + (size_t)128 * 4 * DFF2 * 4 <= WS_END, "ws map 2");

constexpr int CW_BAR = 4096;
constexpr int RING_BYTES = 131072, LDSCTL_OFF = RING_BYTES, MISC_OFF = LDSCTL_OFF + 320, LDS_BYTES = 147456;
constexpr int NWAVES = 8;

typedef GAS unsigned gu32;
#define RLX_AGENT __ATOMIC_RELAXED, __HIP_MEMORY_SCOPE_AGENT
#define LDS_WAIT() asm volatile("s_waitcnt lgkmcnt(0)" ::: "memory")

#define XB_TMO      128
#define XB_XCNT(j)  (256  + 64 * (j))
#define XB_XSUB(j)  (1280 + 64 * (j))
#define XB_XGEN(j)  (2304 + 64 * (j))
#define XB_TOP      3328
#define XB_TOPGEN   3392
#define XCD_BAR_WORDS 3456
#define XB_SPIN_CAP (1u << 22)
DI unsigned xb_ld(unsigned* p)              { return __hip_atomic_load(p, __ATOMIC_RELAXED, __HIP_MEMORY_SCOPE_AGENT); }
DI unsigned xb_add(unsigned* p, unsigned v) { return __hip_atomic_fetch_add(p, v, __ATOMIC_RELAXED, __HIP_MEMORY_SCOPE_AGENT); }
DI unsigned xb_xcc_id() { return (unsigned)__builtin_amdgcn_s_getreg((3 << 11) | 20) & 0xFu; }
#define XB_SPIN(cond, bar) do { unsigned _sp = 0; while (cond) { __builtin_amdgcn_s_sleep(1); \
    if ((++_sp & 255u) == 0u) { if (xb_ld(&(bar)[XB_TMO])) break; if (_sp > XB_SPIN_CAP) { atomicAdd(&(bar)[XB_TMO], 1u); break; } } } } while (0)
struct XcdBarrier { unsigned* bar; unsigned x; volatile LAS unsigned* st; };
DI XcdBarrier xcd_barrier_post(unsigned* bar, volatile LAS unsigned* st) {
    XcdBarrier b; b.bar = bar; b.x = xb_xcc_id(); b.st = st;
    if (threadIdx.x == 0) (void)xb_add(&bar[XB_XCNT(b.x)], 1u);
    return b;
}
DI void xcd_barrier_complete(unsigned* bar, unsigned x, unsigned& nloc, unsigned& nx) {
    const unsigned G = gridDim.x * gridDim.y * gridDim.z;
    unsigned sum, cnt, mine, sp = 0u;
    for (;;) {
        sum = 0u; cnt = 0u; mine = 0u;
#pragma unroll
        for (unsigned j = 0; j < 16; ++j) { const unsigned c = xb_ld(&bar[XB_XCNT(j)]); sum += c; cnt += (c > 0u) ? 1u : 0u; mine = (j == x) ? c : mine; }
        if (sum == G) break;
        __builtin_amdgcn_s_sleep(1);
        if ((++sp & 255u) == 0u) { if (xb_ld(&bar[XB_TMO])) break; if (sp > XB_SPIN_CAP) { atomicAdd(&bar[XB_TMO], 1u); break; } }
    }
    nloc = mine > 0u ? mine : 1u; nx = cnt > 0u ? cnt : 1u;
}
DI void xcd_barrier(const XcdBarrier& b) {
    asm volatile("s_waitcnt vmcnt(0)" ::: "memory");
    __syncthreads();
    if (threadIdx.x == 0) {
        unsigned* bar = b.bar;
        __builtin_amdgcn_s_waitcnt(0);
        unsigned nloc = b.st[0], nx = b.st[1];
        if (nloc == 0u) { xcd_barrier_complete(bar, b.x, nloc, nx); b.st[0] = nloc; b.st[1] = nx; }
        const unsigned old = xb_add(&bar[XB_XSUB(b.x)], 1u);
        const unsigned gen = old / nloc;
        if (old + 1u == (gen + 1u) * nloc) {
            __builtin_amdgcn_fence(__ATOMIC_RELEASE, "agent");
            asm volatile("s_waitcnt vmcnt(0)" ::: "memory");
            const unsigned og = xb_add(&bar[XB_TOP], 1u);
            const unsigned tg = og / nx;
            if (og + 1u == (tg + 1u) * nx) xb_add(&bar[XB_TOPGEN], 1u);
            else XB_SPIN(xb_ld(&bar[XB_TOPGEN]) == tg, bar);
            __builtin_amdgcn_fence(__ATOMIC_ACQUIRE, "agent");
            xb_add(&bar[XB_XGEN(b.x)], 1u);
            asm volatile("s_waitcnt vmcnt(0)" ::: "memory");
        } else {
            XB_SPIN(xb_ld(&bar[XB_XGEN(b.x)]) == gen, bar);
            __builtin_amdgcn_fence(__ATOMIC_ACQUIRE, "agent");
            asm volatile("s_waitcnt vmcnt(0)" ::: "memory");
        }
    }
    __syncthreads();
}

struct Frame {
    LAS unsigned char* lds;
    int tid, lane, wave, vcu, G;
    unsigned char* ws;
    const float* const* in;
    float* out;
};

struct TJob { const float* W; const float* ks; bf16_t* out; int K, N, ldo, coff, upmap, ntile; };
constexpr int TRS = 260;
DI void tr_load(const TJob& J, int tile, int wave, int lane, f32x4 (&v)[8]) {
    const int nb = J.N >> 8, kb = tile / nb, n0 = (tile - kb * nb) << 8, k0 = kb << 6;
    const float* src = J.W + (size_t)(k0 + 8 * wave) * J.N + n0 + 4 * lane;
#pragma unroll
    for (int i = 0; i < 8; ++i) v[i] = *(const f32x4*)(src + (size_t)i * J.N);
    if (J.ks) {
#pragma unroll
        for (int i = 0; i < 8; ++i) v[i] = v[i] * J.ks[k0 + 8 * wave + i];
    }
}
DI void tr_to_lds(LAS unsigned* P, int wave, int lane, const f32x4 (&v)[8]) {
#pragma unroll
    for (int i = 0; i < 4; ++i) {
        u32x4 w; w.x = pk2(v[2 * i].x, v[2 * i + 1].x); w.y = pk2(v[2 * i].y, v[2 * i + 1].y); w.z = pk2(v[2 * i].z, v[2 * i + 1].z); w.w = pk2(v[2 * i].w, v[2 * i + 1].w);
        *(LAS u32x4*)(P + (4 * wave + i) * TRS + 4 * lane) = w;
    }
}
DI void tr_store(const TJob& J, int tile, LAS const unsigned* P, int wave, int lane) {
    const int nb = J.N >> 8, kb = tile / nb, n0 = (tile - kb * nb) << 8, k0 = kb << 6;
    const int c = lane & 7;
#pragma unroll
    for (int jj = 0; jj < 4; ++jj) {
        const int nl = 32 * wave + 8 * jj + (lane >> 3), n = n0 + nl;
        u32x4 w; w.x = P[(4 * c + 0) * TRS + nl]; w.y = P[(4 * c + 1) * TRS + nl]; w.z = P[(4 * c + 2) * TRS + nl]; w.w = P[(4 * c + 3) * TRS + nl];
        int orow = n;
        if (J.upmap == 1) { const int b128 = n >> 7, half = b128 >= 43 ? 1 : 0; orow = 256 * (b128 - 43 * half) + 128 * half + (n & 127); }
        if (J.upmap == 2 && n >= DP && n < DP + 4 * DH) {
            const int sec = (n - DP) >> 10, c = (n - DP) & 1023, t = c >> 6, cc = c & 63;
            orow = DP + 256 * t + 128 * (sec >> 1) + 8 * (cc >> 2) + 4 * (sec & 1) + (cc & 3); }
        if (J.upmap == 2 && n >= DP + 4 * DH) {
            const int g = n - (DP + 4 * DH), half = g >= DM ? 1 : 0, ch = g - half * DM; orow = DP + 4 * DH + 256 * (ch >> 7) + 128 * half + (ch & 127); }
        *(u32x4*)(J.out + (size_t)orow * J.ldo + J.coff + k0 + 8 * c) = w;
    }
}
constexpr int TJ_NT[7] = {(DM / 64) * (DIN / 256), (DM / 64) * (DFF2 / 256), (DFF / 64) * (DM / 256), (DH / 64) * (DM / 256), (DM / 64) * (DM / 256), (DM / 64) * (DM / 256), (PLE / 64) * (DM / 256)};
constexpr int TJ_B1 = TJ_NT[0], TJ_B2 = TJ_B1 + TJ_NT[1], TJ_B3 = TJ_B2 + TJ_NT[2], TJ_B4 = TJ_B3 + TJ_NT[3], TJ_B5 = TJ_B4 + TJ_NT[4], TJ_B6 = TJ_B5 + TJ_NT[5], TJ_TOTAL = TJ_B6 + TJ_NT[6];
DI TJob tr_job(const Frame& F, int g, int& tile) {
    unsigned char* ws = F.ws; TJob J;
    if (g < TJ_B1)      { J = TJob{F.in[3],  F.in[2],  (bf16_t*)(ws + WS_WIN),   DM,  DIN,  DM,  0,  2, 0}; tile = g; }
    else if (g < TJ_B2) { J = TJob{F.in[12], F.in[11], (bf16_t*)(ws + WS_WUP),   DM,  DFF2, DM,  0,  1, 0}; tile = g - TJ_B1; }
    else if (g < TJ_B3) { J = TJob{F.in[15], nullptr,  (bf16_t*)(ws + WS_WDOWN), DFF, DM,   DFF, 0,  0, 0}; tile = g - TJ_B2; }
    else if (g < TJ_B4) { J = TJob{F.in[9],  nullptr,  (bf16_t*)(ws + WS_WAB),   DH,  DM,   DM,  DP, 0, 0}; tile = g - TJ_B3; }
    else if (g < TJ_B5) { J = TJob{F.in[10], nullptr,  (bf16_t*)(ws + WS_WOUT),  DM,  DM,   DM,  0,  0, 0}; tile = g - TJ_B4; }
    else if (g < TJ_B6) { J = TJob{F.in[17], F.in[16], (bf16_t*)(ws + WS_WPG),   DM,  DM,   DM,  0,  0, 0}; tile = g - TJ_B5; }
    else                { J = TJob{F.in[18], nullptr,  (bf16_t*)(ws + WS_WPLE),  PLE, DM,   PLE, 0,  0, 0}; tile = g - TJ_B6; }
    return J;
}
DI void p0_transpose_win(Frame& F) {
    LAS unsigned* P = (LAS unsigned*)F.lds;
    f32x4 v[8];
    int g = F.vcu, tile = 0;
    bool have = g < TJ_B1;
    TJob Jc{}, Jn{}; int tc = 0;
    if (have) { Jn = tr_job(F, g, tile); tr_load(Jn, tile, F.wave, F.lane, v); }
    while (have) {
        tr_to_lds(P, F.wave, F.lane, v);
        __syncthreads();
        Jc = Jn; tc = tile;
        g += F.G; have = g < TJ_B1;
        if (have) { Jn = tr_job(F, g, tile); tr_load(Jn, tile, F.wave, F.lane, v); }
        tr_store(Jc, tc, P, F.wave, F.lane);
        __syncthreads();
    }
}
DI void p0_fold_wa(Frame& F, const float* wmix, const float* scale, const float* wa, bf16_t* WAB, int tile) {
    const int g = tile >> 6, c0 = 64 * ((tile >> 4) & 3), n0 = 128 * (tile & 15);
    const int ci = F.wave & 1, ni = F.wave >> 1, r = F.lane & 31, kh = F.lane >> 5;
    const float* arow = wmix + ((size_t)g * 256 + c0 + 32 * ci + r) * 256;
    const float* bcol = wa + (size_t)(g * 256) * DM + n0 + 32 * ni + r;
    const float* sc = scale + g * 256;
    f32x16 acc;
#pragma unroll
    for (int i = 0; i < 16; ++i) acc[i] = 0.f;
#pragma unroll 1
    for (int q0 = 0; q0 < 64; q0 += 8) {
        f32x4 av[8]; float bv[16];
#pragma unroll
        for (int i = 0; i < 8; ++i) av[i] = *(const f32x4*)(arow + 4 * (q0 + i));
#pragma unroll
        for (int j = 0; j < 16; ++j) { const int d = 4 * q0 + 2 * j + kh; bv[j] = sc[d] * bcol[(size_t)d * DM]; }
#pragma unroll
        for (int i = 0; i < 8; ++i) {
            acc = __builtin_amdgcn_mfma_f32_32x32x2f32(kh ? av[i].y : av[i].x, bv[2 * i], acc, 0, 0, 0);
            acc = __builtin_amdgcn_mfma_f32_32x32x2f32(kh ? av[i].w : av[i].z, bv[2 * i + 1], acc, 0, 0, 0);
        }
    }
    bf16_t* orow = WAB + (size_t)(n0 + 32 * ni + r) * DM + g * 256 + c0 + 32 * ci + 4 * kh;
#pragma unroll
    for (int i4 = 0; i4 < 4; ++i4) { u32x2 w; w.x = pk2(acc[4 * i4], acc[4 * i4 + 1]); w.y = pk2(acc[4 * i4 + 2], acc[4 * i4 + 3]); *(u32x2*)(orow + 8 * i4) = w; }
}

DI void p0_prologue(Frame& F) {
    unsigned char* ws = F.ws;
    const int gw = F.vcu * NWAVES + F.wave, NGW = F.G * NWAVES;
    {
        const float* x = F.in[0]; bf16_t* XB = (bf16_t*)(ws + WS_XB); float* R1 = (float*)(ws + WS_R1);
        for (int m = gw; m < S; m += NGW) {
            const f32x4* xr = (const f32x4*)(x + (size_t)m * DM) + F.lane;
            f32x4 v[8]; float s = 0.f;
#pragma unroll
            for (int j = 0; j < 8; ++j) { v[j] = xr[64 * j]; s += (v[j].x * v[j].x + v[j].y * v[j].y) + (v[j].z * v[j].z + v[j].w * v[j].w); }
            s = wave_sum(s);
            if (F.lane == 0) R1[m] = rsqrtf(s * (1.f / DM) + EPS);
            u32x2* o = (u32x2*)(XB + (size_t)m * DM) + F.lane;
#pragma unroll
            for (int j = 0; j < 8; ++j) { u32x2 w; w.x = pk2(v[j].x, v[j].y); w.y = pk2(v[j].z, v[j].w); o[64 * j] = w; }
        }
    }
    {
        const f32x4* p = (const f32x4*)F.in[1]; u32x2* PB = (u32x2*)(ws + WS_PB);
        const int gt = F.vcu * 512 + F.tid, NGT = F.G * 512;
        for (int i = gt; i < S * PLE / 4; i += NGT) { const f32x4 v = p[i]; u32x2 w; w.x = pk2(v.x, v.y); w.y = pk2(v.z, v.w); PB[i] = w; }
        float* LB = (float*)(ws + WS_LB); const float* lbl = F.in[6];
        if (gt < DH) { const float l0 = lbl[gt], l1 = lbl[DH + gt], mx = fmaxf(l0, l1), e0 = __expf(l0 - mx), e1 = __expf(l1 - mx); LB[gt] = e0 / (e0 + e1); }
    }
    p0_transpose_win(F);
}
constexpr int CW_QUEUE = 20480;
DI void convert_rest(Frame& F) {
    unsigned* head = (unsigned*)(F.ws + WS_CTL) + CW_QUEUE;
    volatile LAS unsigned* slot = (volatile LAS unsigned*)(F.lds + MISC_OFF) + 20;
    LAS unsigned* P = (LAS unsigned*)F.lds;
    constexpr int NFOLD = 256, NITEM = NFOLD + (TJ_TOTAL - TJ_B1);
    for (;;) {
        __syncthreads();
        if (F.tid == 0) slot[0] = __hip_atomic_fetch_add(head, 1u, __ATOMIC_RELAXED, __HIP_MEMORY_SCOPE_AGENT);
        __syncthreads();
        const int item = (int)__builtin_amdgcn_readfirstlane(slot[0]);
        if (item >= NITEM) break;
        if (item < NFOLD) { p0_fold_wa(F, F.in[4], F.in[5], F.in[8], (bf16_t*)(F.ws + WS_WAB), item); }
        else {
            int tile = 0; const TJob J = tr_job(F, TJ_B1 + item - NFOLD, tile);
            f32x4 v[8];
            tr_load(J, tile, F.wave, F.lane, v);
            tr_to_lds(P, F.wave, F.lane, v);
            __syncthreads();
            tr_store(J, tile, P, F.wave, F.lane);
        }
    }
}


DI float row_rstd(const float* ssq, int row, int fq) {
    const f32x4* p = (const f32x4*)(ssq + (size_t)row * 32 + fq * 8);
    const f32x4 a = p[0], b = p[1];
    float s = ((a.x + a.y) + (a.z + a.w)) + ((b.x + b.y) + (b.z + b.w));
    s += __shfl_xor(s, 16); s += __shfl_xor(s, 32);
    return rsqrtf(s * (1.f / DM) + EPS);
}

DI void row_rstd8(const float* ssq, int row0, int fq, float (&r)[2][4]) {
    f32x4 a[2][4], b[2][4];
#pragma unroll
    for (int ai = 0; ai < 2; ++ai)
#pragma unroll
        for (int m = 0; m < 4; ++m) { const f32x4* p = (const f32x4*)(ssq + (size_t)(row0 + ai * 128 + m * 16) * 32 + fq * 8); a[ai][m] = p[0]; b[ai][m] = p[1]; }
#pragma unroll
    for (int ai = 0; ai < 2; ++ai)
#pragma unroll
        for (int m = 0; m < 4; ++m) {
            float s = ((a[ai][m].x + a[ai][m].y) + (a[ai][m].z + a[ai][m].w)) + ((b[ai][m].x + b[ai][m].y) + (b[ai][m].z + b[ai][m].w));
            s += __shfl_xor(s, 16); s += __shfl_xor(s, 32);
            r[ai][m] = rsqrtf(s * (1.f / DM) + EPS);
        }
}
DI void lds_read4x16(unsigned addr, f32x4& a, f32x4& b, f32x4& c, f32x4& d) {
    asm volatile("ds_read_b128 %0, %4\n\tds_read_b128 %1, %4 offset:1024\n\tds_read_b128 %2, %4 offset:2048\n\tds_read_b128 %3, %4 offset:3072\n\ts_waitcnt lgkmcnt(0)"
                 : "=&v"(a), "=&v"(b), "=&v"(c), "=&v"(d) : "v"(addr) : "memory");
}

struct EpiProj {
    static constexpr int MIDK = 0; static constexpr bool AFTER_DRAIN = false; static constexpr bool HAS_PRE = false;
    unsigned char* ws; float* dout;
    DI void operator()(const AccT& acc, const Unit& u, int wr, int wc, int fr, int fq) const {
        asm volatile("" : "+v"(fr), "+v"(fq));
        const float* R1 = (const float*)(ws + WS_R1);
        const int pn = u.pn, row0 = u.pm * 256 + wr * 64 + fr, cl = wc * 32 + 8 * fq;
        float rs[2][4];
#pragma unroll
        for (int ai = 0; ai < 2; ++ai)
#pragma unroll
            for (int m = 0; m < 4; ++m) rs[ai][m] = R1[row0 + ai * 128 + m * 16];
        if (pn >= 4 && pn < 20) {
            const float* LB = (const float*)(ws + WS_LB); bf16_t* Qp = (bf16_t*)(ws + WS_Q); bf16_t* K2 = (bf16_t*)(ws + WS_KK);
            bf16_t* Vo = (bf16_t*)(ws + WS_V); bf16_t* SGo = (bf16_t*)(ws + WS_SG); float* DL = (float*)(ws + WS_DL);
            const int t = pn - 4, hd = t >> 1, k4 = 64 * (t & 1) + 16 * wc + 4 * fq;
            const int lane = fq * 16 + fr, bsel = ((lane & ~15) | 15) << 2;
            const f32x4 lb = *(const f32x4*)(LB + hd * 128 + k4);
#pragma unroll
            for (int ai = 0; ai < 2; ++ai) {
                f32x4 lf[4], kk[4];
#pragma unroll
                for (int m = 0; m < 4; ++m)
#pragma unroll
                    for (int c = 0; c < 4; ++c) { const float v = acc[ai][0][m][1][c] * rs[ai][m]; const float sg = sigm(v); const float f = lb[c] + (1.f - lb[c]) * sg;
                        lf[m][c] = __logf(f); kk[m][c] = (1.f - lb[c]) * (1.f - sg); }
                f32x4 b63;
#pragma unroll
                for (int c = 0; c < 4; ++c) {
                    float carry = 0.f;
#pragma unroll
                    for (int m = 0; m < 4; ++m) {
                        float x = lf[m][c];
                        x += dppf<0x111>(x); x += dppf<0x112>(x); x += dppf<0x114>(x); x += dppf<0x118>(x);
                        const float tot = __builtin_bit_cast(float, __builtin_amdgcn_ds_bpermute(bsel, __builtin_bit_cast(int, x)));
                        lf[m][c] = x + carry; carry += tot;
                    }
                    b63[c] = carry;
                }
                const int chunk = 4 * u.pm + 2 * ai + wr;
                if (fr == 0) { f32x4 e63; e63.x = __expf(b63.x); e63.y = __expf(b63.y); e63.z = __expf(b63.z); e63.w = __expf(b63.w); *(f32x4*)(DL + (size_t)chunk * DH + hd * 128 + k4) = e63; }
#pragma unroll
                for (int m = 0; m < 4; ++m) {
                    const size_t of = (size_t)(chunk * 8 + hd) * 8192 + fq_off(m >> 1, 4 * (t & 1) + wc, 16 * (m & 1) + fr + 32 * (fq >> 1)) + 4 * (fq & 1);
                    const size_t orow = (size_t)(row0 + ai * 128 + m * 16) * DH + hd * 128 + k4;
                    f32x4 qp, k2, vv, sgv;
#pragma unroll
                    for (int c = 0; c < 4; ++c) {
                        const float ex = __expf(lf[m][c]);
                        qp[c] = acc[ai][0][m][0][c] * rs[ai][m] * ex; k2[c] = kk[m][c] * __builtin_amdgcn_rcpf(ex);
                        vv[c] = acc[ai][1][m][0][c] * rs[ai][m]; const float g = acc[ai][1][m][1][c] * rs[ai][m]; sgv[c] = g * sigm(g);
                    }
                    u32x2 w;
                    w.x = pk2(qp.x, qp.y); w.y = pk2(qp.z, qp.w); *(u32x2*)(Qp + of) = w;
                    w.x = pk2(k2.x, k2.y); w.y = pk2(k2.z, k2.w); *(u32x2*)(K2 + of) = w;
                    w.x = pk2(vv.x, vv.y); w.y = pk2(vv.z, vv.w); *(u32x2*)(Vo + orow) = w;
                    w.x = pk2(sgv.x, sgv.y); w.y = pk2(sgv.z, sgv.w); *(u32x2*)(SGo + orow) = w;
                }
            }
        } else if (pn >= 20) {
            bf16_t* RT = (bf16_t*)dout; bf16_t* GBo = (bf16_t*)dout + (size_t)S * DM;
            const int ch0 = 128 * (pn - 20) + cl;
#pragma unroll
            for (int ai = 0; ai < 2; ++ai)
#pragma unroll
                for (int m = 0; m < 4; ++m) {
                    const size_t o = (size_t)(row0 + ai * 128 + m * 16) * DM + ch0;
                    f32x4 r0, r1, g0, g1;
#pragma unroll
                    for (int c = 0; c < 4; ++c) {
                        const float ea0 = __expf(-__builtin_amdgcn_fmed3f(acc[ai][0][m][0][c] * rs[ai][m], -60.f, 60.f)), eb0 = __expf(-__builtin_amdgcn_fmed3f(acc[ai][1][m][0][c] * rs[ai][m], -60.f, 60.f));
                        const float ea1 = __expf(-__builtin_amdgcn_fmed3f(acc[ai][0][m][1][c] * rs[ai][m], -60.f, 60.f)), eb1 = __expf(-__builtin_amdgcn_fmed3f(acc[ai][1][m][1][c] * rs[ai][m], -60.f, 60.f));
                        r0[c] = (1.0f + eb0) * __builtin_amdgcn_rcpf(1.0f + ea0); g0[c] = __builtin_amdgcn_rcpf(1.0f + eb0);
                        r1[c] = (1.0f + eb1) * __builtin_amdgcn_rcpf(1.0f + ea1); g1[c] = __builtin_amdgcn_rcpf(1.0f + eb1);
                    }
                    *(u32x4*)(RT + o) = pack8(r0, r1); *(u32x4*)(GBo + o) = pack8(g0, g1);
                }
        } else {
        bf16_t* O = (bf16_t*)(ws + WS_UP);
#pragma unroll
        for (int ai = 0; ai < 2; ++ai)
#pragma unroll
            for (int m = 0; m < 4; ++m) {
                bf16_t* rowp = O + (size_t)(row0 + ai * 128 + m * 16) * DP + pn * 256 + cl;
#pragma unroll
                for (int bj = 0; bj < 2; ++bj) *(u32x4*)(rowp + bj * 128) = pack8(acc[ai][bj][m][0] * rs[ai][m], acc[ai][bj][m][1] * rs[ai][m]);
            }
        }
        asm volatile("" :: "v"(rs[0][0]), "v"(rs[0][1]), "v"(rs[0][2]), "v"(rs[0][3]), "v"(rs[1][0]), "v"(rs[1][1]), "v"(rs[1][2]), "v"(rs[1][3]));
    }
};

struct EpiBf {
    static constexpr int MIDK = 0; static constexpr bool AFTER_DRAIN = false; static constexpr bool HAS_PRE = false;
    bf16_t* O; int ld;
    DI void operator()(const AccT& acc, const Unit& u, int wr, int wc, int fr, int fq) const {
        asm volatile("" : "+v"(fr), "+v"(fq));
        const int row0 = u.pm * 256 + wr * 64 + fr, col0 = u.pn * 256 + wc * 32 + 8 * fq;
#pragma unroll
        for (int ai = 0; ai < 2; ++ai)
#pragma unroll
            for (int m = 0; m < 4; ++m)
#pragma unroll
                for (int bj = 0; bj < 2; ++bj) *(u32x4*)(O + (size_t)(row0 + ai * 128 + m * 16) * ld + col0 + bj * 128) = pack8(acc[ai][bj][m][0], acc[ai][bj][m][1]);
    }
};
template <int MODE> struct EpiGate {
    static constexpr int MIDK = 0; static constexpr bool AFTER_DRAIN = false; static constexpr bool HAS_PRE = false;
    const bf16_t* G; float* TMP; bf16_t* MG;
    DI void operator()(const AccT& acc, const Unit& u, int wr, int wc, int fr, int fq) const {
        asm volatile("" : "+v"(fr), "+v"(fq));
        const int row0 = u.pm * 256 + wr * 64 + fr, col0 = u.pn * 256 + wc * 32 + 8 * fq;
#pragma unroll
        for (int ai = 0; ai < 2; ++ai)
#pragma unroll
            for (int m = 0; m < 4; ++m)
#pragma unroll
                for (int bj = 0; bj < 2; ++bj) {
                    const size_t o = (size_t)(row0 + ai * 128 + m * 16) * DM + col0 + bj * 128;
                    f32x4 g0, g1; unpack8(*(const u32x4*)(G + o), g0, g1);
                    f32x4 v0 = acc[ai][bj][m][0] * g0, v1 = acc[ai][bj][m][1] * g1;
                    if (MODE == 0) { *(f32x4*)(TMP + o) = v0; *(f32x4*)(TMP + o + 4) = v1; }
                    else { v0 += *(const f32x4*)(TMP + o); v1 += *(const f32x4*)(TMP + o + 4); *(u32x4*)(MG + o) = pack8(v0, v1); }
                }
    }
};
struct EpiMerge {
    static constexpr int MIDK = 16; static constexpr bool AFTER_DRAIN = false; static constexpr bool HAS_PRE = false;
    const bf16_t* GA; const bf16_t* GB; bf16_t* MG;
    DI void mid(AccT& acc, const Unit& u, int wr, int wc, int fr, int fq) const {
        asm volatile("" : "+v"(fr), "+v"(fq));
        const int row0 = u.pm * 256 + wr * 64 + fr, col0 = u.pn * 256 + wc * 32 + 8 * fq;
#pragma unroll
        for (int ai = 0; ai < 2; ++ai)
#pragma unroll
            for (int m = 0; m < 4; ++m)
#pragma unroll
                for (int bj = 0; bj < 2; ++bj) {
                    const size_t o = (size_t)(row0 + ai * 128 + m * 16) * DM + col0 + bj * 128;
                    f32x4 a0, a1; unpack8(*(const u32x4*)(GA + o), a0, a1);
                    acc[ai][bj][m][0] = acc[ai][bj][m][0] * a0; acc[ai][bj][m][1] = acc[ai][bj][m][1] * a1;
                }
    }
    DI void operator()(const AccT& acc, const Unit& u, int wr, int wc, int fr, int fq) const {
        asm volatile("" : "+v"(fr), "+v"(fq));
        const int row0 = u.pm * 256 + wr * 64 + fr, col0 = u.pn * 256 + wc * 32 + 8 * fq;
#pragma unroll
        for (int ai = 0; ai < 2; ++ai)
#pragma unroll
            for (int m = 0; m < 4; ++m)
#pragma unroll
                for (int bj = 0; bj < 2; ++bj) {
                    const size_t o = (size_t)(row0 + ai * 128 + m * 16) * DM + col0 + bj * 128;
                    f32x4 b0, b1; unpack8(*(const u32x4*)(GB + o), b0, b1);
                    *(u32x4*)(MG + o) = pack8(acc[ai][bj][m][0] * b0, acc[ai][bj][m][1] * b1);
                }
    }
};
template <bool BF> struct EpiResB {
    static constexpr int MIDK = 0; static constexpr bool AFTER_DRAIN = false; static constexpr bool HAS_PRE = false;
    const void* base; bf16_t* xb; float* ssq;
    DI void operator()(const AccT& acc, const Unit& u, int wr, int wc, int fr, int fq) const {
        asm volatile("" : "+v"(fr), "+v"(fq));
        const int row0 = u.pm * 256 + wr * 64 + fr, col0 = u.pn * 256 + wc * 32 + 8 * fq;
#pragma unroll
        for (int ai = 0; ai < 2; ++ai)
#pragma unroll
            for (int m = 0; m < 4; ++m) {
                const int row = row0 + ai * 128 + m * 16; float s = 0.f;
#pragma unroll
                for (int bj = 0; bj < 2; ++bj) {
                    const size_t o = (size_t)row * DM + col0 + bj * 128;
                    f32x4 x0, x1;
                    if (BF) unpack8(*(const u32x4*)((const bf16_t*)base + o), x0, x1);
                    else { x0 = *(const f32x4*)((const float*)base + o); x1 = *(const f32x4*)((const float*)base + o + 4); }
                    const f32x4 v0 = acc[ai][bj][m][0] + x0, v1 = acc[ai][bj][m][1] + x1;
                    *(u32x4*)(xb + o) = pack8(v0, v1);
                    s += ((v0.x * v0.x + v0.y * v0.y) + (v0.z * v0.z + v0.w * v0.w)) + ((v1.x * v1.x + v1.y * v1.y) + (v1.z * v1.z + v1.w * v1.w));
                }
                s += __shfl_xor(s, 16); s += __shfl_xor(s, 32);
                if (fq == 0) ssq[(size_t)row * 32 + u.pn * 4 + wc] = s;
            }
    }
};
struct EpiRes {
    static constexpr int MIDK = 0; static constexpr bool AFTER_DRAIN = false; static constexpr bool HAS_PRE = false;
    const float* base; float* xo; bf16_t* xb; float* ssq;
    DI void operator()(const AccT& acc, const Unit& u, int wr, int wc, int fr, int fq) const {
        asm volatile("" : "+v"(fr), "+v"(fq));
        const int row0 = u.pm * 256 + wr * 64 + fr, col0 = u.pn * 256 + wc * 32 + 8 * fq;
#pragma unroll
        for (int ai = 0; ai < 2; ++ai)
#pragma unroll
            for (int m = 0; m < 4; ++m) {
                const int row = row0 + ai * 128 + m * 16; float s = 0.f;
#pragma unroll
                for (int bj = 0; bj < 2; ++bj) {
                    const size_t o = (size_t)row * DM + col0 + bj * 128;
                    const f32x4 v0 = acc[ai][bj][m][0] + *(const f32x4*)(base + o), v1 = acc[ai][bj][m][1] + *(const f32x4*)(base + o + 4);
                    *(f32x4*)(xo + o) = v0; *(f32x4*)(xo + o + 4) = v1; *(u32x4*)(xb + o) = pack8(v0, v1);
                    s += ((v0.x * v0.x + v0.y * v0.y) + (v0.z * v0.z + v0.w * v0.w)) + ((v1.x * v1.x + v1.y * v1.y) + (v1.z * v1.z + v1.w * v1.w));
                }
                s += __shfl_xor(s, 16); s += __shfl_xor(s, 32);
                if (fq == 0) ssq[(size_t)row * 32 + u.pn * 4 + wc] = s;
            }
    }
};
constexpr int CONV_LDS = 131584;
struct EpiUp {
    static constexpr int MIDK = 0; static constexpr bool AFTER_DRAIN = false; static constexpr bool HAS_PRE = true;
    unsigned char* ws; const float* cw; const float* cb; LAS unsigned char* lds;
    DI void pre(LAS unsigned char* l, const Unit& u, int wid, int lane) const {
        if (wid < 4) {
            const int col = (lane < 32) ? 128 * u.pn + 4 * lane : DFF + 128 * u.pn + 4 * (lane - 32);
            const float* src = (wid < 3 ? cw + (size_t)wid * DFF2 : cb) + col;
            __builtin_amdgcn_global_load_lds((const unsigned*)src, (LAS unsigned*)(l + CONV_LDS + (u.ui & 1) * 4096 + wid * 1024), 16, 0, 0);
        }
    }
    DI void operator()(const AccT& acc, const Unit& u, int wr, int wc, int fr, int fq) const {
        asm volatile("" : "+v"(fr), "+v"(fq));
        const float* SSQ = (const float*)(ws + WS_SSQ1); bf16_t* ACT = (bf16_t*)(ws + WS_ACT); float* ZB = (float*)(ws + WS_ZB);
        const int row0 = u.pm * 256 + wr * 64 + fr, j = u.pn;
#pragma unroll
        for (int ai = 0; ai < 2; ++ai) {
            float r2[4];
#pragma unroll
            for (int m = 0; m < 4; ++m) r2[m] = row_rstd(SSQ, row0 + ai * 128 + m * 16, fq);
            const int blk = 4 * u.pm + 2 * ai + wr;
#pragma unroll
            for (int n = 0; n < 2; ++n) {
                int fq2 = fq; asm volatile("" : "+v"(fq2));
                const int ch = 128 * j + 32 * wc + 8 * fq2 + 4 * n;
                const int pc = 256 * j + 32 * wc + 8 * fq2 + 4 * n;
                const unsigned cbase = (unsigned)(size_t)(lds + CONV_LDS + (u.ui & 1) * 4096) + (unsigned)(32 * wc + 8 * fq2) * 4u;
                float* zb = ZB + (size_t)blk * 4 * DFF2 + pc;
                if (fr < 2) { *(f32x4*)(zb + (size_t)fr * DFF2) = acc[ai][0][0][n] * r2[0]; *(f32x4*)(zb + (size_t)fr * DFF2 + 128) = acc[ai][1][0][n] * r2[0]; }
                if (fr >= 14) { *(f32x4*)(zb + (size_t)(fr - 12) * DFF2) = acc[ai][0][3][n] * r2[3]; *(f32x4*)(zb + (size_t)(fr - 12) * DFF2 + 128) = acc[ai][1][3][n] * r2[3]; }
                f32x4 uv[4];
                {
                    f32x4 w0, w1, w2, bb; lds_read4x16(cbase + (128 + 4 * n) * 4u, w0, w1, w2, bb);
#pragma unroll
                    for (int m = 0; m < 4; ++m) {
                        const f32x4 zc = acc[ai][1][m][n] * r2[m], zp = acc[ai][1][m > 0 ? m - 1 : 0][n] * r2[m > 0 ? m - 1 : 0];
#pragma unroll
                        for (int c = 0; c < 4; ++c) {
                            const float s1 = (m > 0 && fr == 15) ? zp[c] : zc[c], s2 = (m > 0 && fr >= 14) ? zp[c] : zc[c];
                            uv[m][c] = bb[c] + w2[c] * zc[c] + w1[c] * dppf<0x121>(s1) + w0[c] * dppf<0x122>(s2);
                        }
                    }
                }
                {
                    f32x4 w0, w1, w2, bb; lds_read4x16(cbase + (4 * n) * 4u, w0, w1, w2, bb);
#pragma unroll
                    for (int m = 0; m < 4; ++m) {
                        const f32x4 zc = acc[ai][0][m][n] * r2[m], zp = acc[ai][0][m > 0 ? m - 1 : 0][n] * r2[m > 0 ? m - 1 : 0];
                        f32x4 ug;
#pragma unroll
                        for (int c = 0; c < 4; ++c) {
                            const float s1 = (m > 0 && fr == 15) ? zp[c] : zc[c], s2 = (m > 0 && fr >= 14) ? zp[c] : zc[c];
                            ug[c] = bb[c] + w2[c] * zc[c] + w1[c] * dppf<0x121>(s1) + w0[c] * dppf<0x122>(s2);
                        }
                        if (m > 0 || fr >= 2) {
                            u32x2 w; w.x = pk2(ug.x * sigm(ug.x) * uv[m].x, ug.y * sigm(ug.y) * uv[m].y); w.y = pk2(ug.z * sigm(ug.z) * uv[m].z, ug.w * sigm(ug.w) * uv[m].w);
                            *(u32x2*)(ACT + (size_t)(row0 + ai * 128 + m * 16) * DFF + ch) = w;
                        }
                    }
                }
                __builtin_amdgcn_sched_barrier(0);
            }
        }
    }
};
constexpr int CW_PANEL = 16384;
struct EpiPle {
    static constexpr int MIDK = 0; static constexpr bool AFTER_DRAIN = true; static constexpr bool HAS_PRE = false;
    unsigned char* ws; float* xo; const float* wf;
    DI void fused(AccT& acc, const Unit& u, int wr, int wc, int fr, int fq) const {
        asm volatile("" : "+v"(fr), "+v"(fq));
        const float* SSQ = (const float*)(ws + WS_SSQ2); float* ssq = (float*)(ws + WS_SSQ3); const bf16_t* Eb = (const bf16_t*)(ws + WS_E); const bf16_t* X2 = (const bf16_t*)(ws + WS_XB);
        unsigned* cnt = (unsigned*)(ws + WS_CTL) + CW_PANEL + 64 * u.pm;
        const int row0 = u.pm * 256 + wr * 64 + fr, col0 = u.pn * 256 + wc * 32 + 8 * fq;
#pragma unroll
        for (int ai = 0; ai < 2; ++ai)
#pragma unroll
            for (int m = 0; m < 4; ++m) {
                const int row = row0 + ai * 128 + m * 16; float s = 0.f;
                const float r3 = row_rstd(SSQ, row, fq);
#pragma unroll
                for (int bj = 0; bj < 2; ++bj) {
                    const size_t o = (size_t)row * DM + col0 + bj * 128;
                    f32x4 e0, e1, v0, v1; unpack8(*(const u32x4*)(Eb + o), e0, e1); unpack8(*(const u32x4*)(X2 + o), v0, v1);
#pragma unroll
                    for (int c = 0; c < 4; ++c) { v0[c] += sigm(acc[ai][bj][m][0][c] * r3) * e0[c]; v1[c] += sigm(acc[ai][bj][m][1][c] * r3) * e1[c]; }
                    acc[ai][bj][m][0] = v0; acc[ai][bj][m][1] = v1;
                    s += ((v0.x * v0.x + v0.y * v0.y) + (v0.z * v0.z + v0.w * v0.w)) + ((v1.x * v1.x + v1.y * v1.y) + (v1.z * v1.z + v1.w * v1.w));
                }
                s += __shfl_xor(s, 16); s += __shfl_xor(s, 32);
                if (fq == 0) __hip_atomic_store((unsigned*)ssq + (size_t)row * 32 + u.pn * 4 + wc, __builtin_bit_cast(unsigned, s), __ATOMIC_RELAXED, __HIP_MEMORY_SCOPE_AGENT);
            }
        asm volatile("s_waitcnt vmcnt(0)" ::: "memory");
        if ((fr | fq) == 0) __hip_atomic_fetch_add(cnt, 1u, __ATOMIC_RELAXED, __HIP_MEMORY_SCOPE_AGENT);
        if (wr == 0 && wc == 0) {
            unsigned spins = 0;
            while ((unsigned)__builtin_amdgcn_readfirstlane(__hip_atomic_load(cnt, __ATOMIC_RELAXED, __HIP_MEMORY_SCOPE_AGENT)) < 64u) {
                __builtin_amdgcn_s_sleep(2);
                if (++spins > (1u << 22)) break;
            }
            __builtin_amdgcn_fence(__ATOMIC_ACQUIRE, "agent");
            asm volatile("s_waitcnt vmcnt(0)" ::: "memory");
        }
        __syncthreads();
        const f32x4 w00 = *(const f32x4*)(wf + col0), w01 = *(const f32x4*)(wf + col0 + 4), w10 = *(const f32x4*)(wf + col0 + 128), w11 = *(const f32x4*)(wf + col0 + 132);
#pragma unroll
        for (int ai = 0; ai < 2; ++ai)
#pragma unroll
            for (int m = 0; m < 4; ++m) {
                const int row = row0 + ai * 128 + m * 16;
                const float r4 = row_rstd(ssq, row, fq);
                const size_t o = (size_t)row * DM + col0;
                *(f32x4*)(xo + o) = acc[ai][0][m][0] * r4 * w00; *(f32x4*)(xo + o + 4) = acc[ai][0][m][1] * r4 * w01;
                *(f32x4*)(xo + o + 128) = acc[ai][1][m][0] * r4 * w10; *(f32x4*)(xo + o + 132) = acc[ai][1][m][1] * r4 * w11;
            }
    }
};

template <int W> DI void pool_item(const bf16_t* UP, bf16_t* DOB, int t0, int c0) {
    f32x4 ra[W + 7], rb[W + 7];
#pragma unroll
    for (int i = 0; i < W + 7; ++i) { const int t = t0 - (W - 1) + i; if (t >= 0) unpack8(*(const u32x4*)(UP + (size_t)t * DP + c0), ra[i], rb[i]); else { ra[i] = (f32x4){0.f, 0.f, 0.f, 0.f}; rb[i] = ra[i]; } }
    f32x4 sa = {0.f, 0.f, 0.f, 0.f}, sb = sa;
#pragma unroll
    for (int i = 0; i < W - 1; ++i) { sa += ra[i]; sb += rb[i]; }
#pragma unroll
    for (int j = 0; j < 8; ++j) {
        sa += ra[W - 1 + j]; sb += rb[W - 1 + j];
        const int t = t0 + j; const float inv = 1.f / (float)((t + 1 < W) ? t + 1 : W);
        *(u32x4*)(DOB + (size_t)t * DM + c0) = pack8(sa * inv - ra[W - 1 + j], sb * inv - rb[W - 1 + j]);
        sa -= ra[j]; sb -= rb[j];
    }
}
DI void pool_phase(Frame& F) {
    const bf16_t* UP = (const bf16_t*)(F.ws + WS_UP); bf16_t* DOB = (bf16_t*)(F.ws + WS_DOB);
    const int gt = F.vcu * 512 + F.tid, NGT = F.G * 512;
    for (int idx = gt; idx < (S / 8) * 128; idx += NGT) {
        const int t0 = (idx >> 7) * 8, c0 = (idx & 127) * 8, g = c0 >> 8;
        if (g == 0) pool_item<2>(UP, DOB, t0, c0); else if (g == 1) pool_item<4>(UP, DOB, t0, c0); else if (g == 2) pool_item<8>(UP, DOB, t0, c0); else pool_item<16>(UP, DOB, t0, c0);
    }
}

constexpr int TROW = 72;
constexpr int SROW = 136;
constexpr int H_VT = 0, H_KT = 18432, H_ST = 36864, H_QF = 71680, H_KF = 88064, H_NRM = 104448;
DI int ctile_off(int vt, int kt, int i, int lane) { return ((vt * 4 + kt) * 16 + i) * 64 + lane; }
DI int b63_off(int k) { return fq_off(1, k >> 4, 31 + 32 * ((k >> 3) & 1)) + (k & 7); }

struct HRegs { u32x4 v0, v1, q[2], k2[2]; f32x4 ea[2], eb[2]; float d0, d1; };
struct HCur { float d0, d1; };
template <bool WITH_Q>
DI void h_load_chunk(Frame& F, int uidx, HRegs& R) {
    const bf16_t* V = (const bf16_t*)(F.ws + WS_V); const bf16_t* K2 = (const bf16_t*)(F.ws + WS_KK); const bf16_t* Q = (const bf16_t*)(F.ws + WS_Q);
    const float* DL = (const float*)(F.ws + WS_DL);
    const int tid = F.tid, s = tid & 63, cg = F.wave;
    const int n = uidx >> 3, h = uidx & 7, t = 64 * n + s, col = h * 128 + 16 * cg;
    R.v0 = *(const u32x4*)(V + (size_t)t * DH + col); R.v1 = *(const u32x4*)(V + (size_t)t * DH + col + 8);
#pragma unroll
    for (int i = 0; i < 2; ++i) {
        const int f = tid + 512 * i, k0 = 16 * ((f >> 6) & 7) + 8 * ((f & 63) >> 5);
        R.k2[i] = *(const u32x4*)(K2 + (size_t)uidx * 8192 + f * 8);
        if (WITH_Q) R.q[i] = *(const u32x4*)(Q + (size_t)uidx * 8192 + f * 8);
        R.ea[i] = *(const f32x4*)(DL + (size_t)n * DH + h * 128 + k0); R.eb[i] = *(const f32x4*)(DL + (size_t)n * DH + h * 128 + k0 + 4);
    }
    { const int kt0 = 2 * (F.wave & 1), r = F.lane & 31; R.d0 = DL[(size_t)n * DH + h * 128 + 32 * kt0 + r]; R.d1 = DL[(size_t)n * DH + h * 128 + 32 * kt0 + 32 + r]; }
}
template <bool WITH_Q>
DI void h_stage_chunk(Frame& F, const HRegs& R, HCur& C) {
    C.d0 = R.d0; C.d1 = R.d1;
    LAS short* VT = (LAS short*)(F.lds + H_VT); LAS short* KT = (LAS short*)(F.lds + H_KT);
    const int tid = F.tid, s = tid & 63, cg = F.wave;
    const unsigned vw[8] = {R.v0.x, R.v0.y, R.v0.z, R.v0.w, R.v1.x, R.v1.y, R.v1.z, R.v1.w};
#pragma unroll
    for (int i = 0; i < 8; ++i) { VT[(16 * cg + 2 * i) * TROW + s] = (short)(vw[i] & 0xffffu); VT[(16 * cg + 2 * i + 1) * TROW + s] = (short)(vw[i] >> 16); }
#pragma unroll
    for (int i = 0; i < 2; ++i) {
        const int f = tid + 512 * i, ti = f >> 9, st = (f >> 6) & 7, lp = f & 63, ss = 32 * ti + (lp & 31), k0 = 16 * st + 8 * (lp >> 5);
        if (WITH_Q) { *(LAS u32x4*)(F.lds + H_QF + f * 16) = R.q[i]; *(LAS u32x4*)(F.lds + H_KF + f * 16) = R.k2[i]; }
        f32x4 ka, kb; unpack8(R.k2[i], ka, kb);
        const u32x4 kp = pack8(ka * R.ea[i], kb * R.eb[i]);
        const unsigned kw[4] = {kp.x, kp.y, kp.z, kp.w};
#pragma unroll
        for (int c = 0; c < 4; ++c) { KT[(k0 + 2 * c) * TROW + ss] = (short)(kw[c] & 0xffffu); KT[(k0 + 2 * c + 1) * TROW + ss] = (short)(kw[c] >> 16); }
    }
}
DI void h_state_update(Frame& F, const HCur& C, f32x16& s0, f32x16& s1) {
    const LAS short* VT = (const LAS short*)(F.lds + H_VT); const LAS short* KT = (const LAS short*)(F.lds + H_KT);
    const int vt = F.wave >> 1, kt0 = 2 * (F.wave & 1), r = F.lane & 31, hh = F.lane >> 5;
    const float d0 = C.d0, d1 = C.d1;
#pragma unroll
    for (int i = 0; i < 16; ++i) { s0[i] *= d0; s1[i] *= d1; }
#pragma unroll
    for (int st = 0; st < 4; ++st) {
        const int sx = 16 * st + 8 * hh;
        const bf16x8 af = *(const LAS bf16x8*)(VT + (32 * vt + r) * TROW + sx);
        const bf16x8 b0 = *(const LAS bf16x8*)(KT + (32 * kt0 + r) * TROW + sx), b1 = *(const LAS bf16x8*)(KT + (32 * (kt0 + 1) + r) * TROW + sx);
        s0 = __builtin_amdgcn_mfma_f32_32x32x16_bf16(af, b0, s0, 0, 0, 0);
        s1 = __builtin_amdgcn_mfma_f32_32x32x16_bf16(af, b1, s1, 0, 0, 0);
    }
}
DI void h1_phase(Frame& F) {
    float* LT = (float*)(F.ws + WS_LT);
    for (int ub = F.vcu; ub < (NCHUNK / 4) * 8; ub += F.G) {
        const int blk = ub >> 3, h = ub & 7;
        f32x16 s0, s1;
#pragma unroll
        for (int i = 0; i < 16; ++i) { s0[i] = 0.f; s1[i] = 0.f; }
        HRegs R; h_load_chunk<false>(F, (4 * blk) * 8 + h, R);
#pragma unroll 1
        for (int c = 0; c < 4; ++c) {
            const int uidx = (4 * blk + c) * 8 + h;
            __syncthreads();
            HCur C; h_stage_chunk<false>(F, R, C);
            if (c < 3) h_load_chunk<false>(F, uidx + 8, R);
            __syncthreads();
            h_state_update(F, C, s0, s1);
        }
        float* lt = LT + (size_t)ub * 16384; const int vt = F.wave >> 1, kt0 = 2 * (F.wave & 1);
#pragma unroll
        for (int i = 0; i < 16; ++i) { lt[ctile_off(vt, kt0, i, F.lane)] = s0[i]; lt[ctile_off(vt, kt0 + 1, i, F.lane)] = s1[i]; }
    }
    __syncthreads();
}
DI void h2_phase(Frame& F) {
    float* LT = (float*)(F.ws + WS_LT); const float* DL = (const float*)(F.ws + WS_DL);
    const int gt = F.vcu * 512 + F.tid, NGT = F.G * 512;
    for (int idx = gt; idx < 8 * 16384; idx += NGT) {
        const int h = idx >> 14, e = idx & 16383, k = 32 * ((e >> 10) & 3) + (e & 31);
        float st = 0.f;
        for (int b0 = 0; b0 < NCHUNK / 4; b0 += 4) {
            float L[4], d[4];
#pragma unroll
            for (int j = 0; j < 4; ++j) {
                L[j] = LT[(size_t)((b0 + j) * 8 + h) * 16384 + e];
                const float* dl = DL + (size_t)(4 * (b0 + j)) * DH + h * 128 + k;
                d[j] = (dl[0] * dl[DH]) * (dl[2 * DH] * dl[3 * DH]);
            }
#pragma unroll
            for (int j = 0; j < 4; ++j) { LT[(size_t)((b0 + j) * 8 + h) * 16384 + e] = st; st = d[j] * st + L[j]; }
        }
    }
}
DI void h3_phase(Frame& F) {
    const float* LT = (const float*)(F.ws + WS_LT); const bf16_t* SG = (const bf16_t*)(F.ws + WS_SG); bf16_t* DOB = (bf16_t*)(F.ws + WS_DOB); const float* NW = F.in[7];
    const int lane = F.lane, r = lane & 31, hh = lane >> 5;
    const LAS short* VT = (const LAS short*)(F.lds + H_VT); LAS short* ST = (LAS short*)(F.lds + H_ST); LAS float* NRM = (LAS float*)(F.lds + H_NRM);
    for (int ub = F.vcu; ub < (NCHUNK / 4) * 8; ub += F.G) {
        const int blk = ub >> 3, h = ub & 7, hc = h * 128;
        const int vts = F.wave >> 1, kt0 = 2 * (F.wave & 1);
        const int vto = F.wave & 3, ti = F.wave >> 2;
        f32x16 s0, s1;
        { const float* lt = LT + (size_t)ub * 16384;
#pragma unroll
          for (int i = 0; i < 16; ++i) { s0[i] = lt[ctile_off(vts, kt0, i, lane)]; s1[i] = lt[ctile_off(vts, kt0 + 1, i, lane)]; } }
        HRegs R; h_load_chunk<true>(F, (4 * blk) * 8 + h, R);
#pragma unroll 1
        for (int c = 0; c < 4; ++c) {
            const int uidx = (4 * blk + c) * 8 + h, t0 = 64 * (4 * blk + c);
            __syncthreads();
            HCur C; h_stage_chunk<true>(F, R, C);
            if (c < 3) h_load_chunk<true>(F, uidx + 8, R);
#pragma unroll
            for (int i = 0; i < 16; ++i) { const int v = 32 * vts + 8 * (i >> 2) + 4 * hh + (i & 3);
                ST[v * SROW + 32 * kt0 + r] = (short)(pk2(s0[i], 0.f) & 0xffffu); ST[v * SROW + 32 * kt0 + 32 + r] = (short)(pk2(s1[i], 0.f) & 0xffffu); }
            __syncthreads();
            f32x16 O;
            {
                bf16x8 qf[8];
#pragma unroll
                for (int st = 0; st < 8; ++st) qf[st] = *(const LAS bf16x8*)(F.lds + H_QF + ((ti * 8 + st) * 64 + lane) * 16);
                f32x16 X[2];
#pragma unroll
                for (int i = 0; i < 16; ++i) { X[0][i] = 0.f; X[1][i] = 0.f; O[i] = 0.f; }
#pragma unroll
                for (int sb = 0; sb < 2; ++sb) {
                    if (sb <= ti) {
#pragma unroll
                        for (int st = 0; st < 8; ++st)
                            X[sb] = __builtin_amdgcn_mfma_f32_32x32x16_bf16(*(const LAS bf16x8*)(F.lds + H_KF + ((sb * 8 + st) * 64 + lane) * 16), qf[st], X[sb], 0, 0, 0);
                    }
                }
#pragma unroll
                for (int i = 0; i < 16; ++i) { const int sl = 8 * (i >> 2) + 4 * hh + (i & 3); const bool keep = sl <= r;
                    if (ti == 0) X[0][i] = keep ? X[0][i] : 0.f; else X[1][i] = keep ? X[1][i] : 0.f; }
#pragma unroll
                for (int sb = 0; sb < 2; ++sb) {
                    if (sb <= ti) {
#pragma unroll
                        for (int sp = 0; sp < 2; ++sp) {
                            u32x4 xb; xb.x = pk2(X[sb][8 * sp + 0], X[sb][8 * sp + 1]); xb.y = pk2(X[sb][8 * sp + 2], X[sb][8 * sp + 3]); xb.z = pk2(X[sb][8 * sp + 4], X[sb][8 * sp + 5]); xb.w = pk2(X[sb][8 * sp + 6], X[sb][8 * sp + 7]);
                            const int sbase = 32 * sb + 16 * sp + 4 * hh;
                            const s16x4 lo = *(const LAS s16x4*)(VT + (32 * vto + r) * TROW + sbase), hi = *(const LAS s16x4*)(VT + (32 * vto + r) * TROW + sbase + 8);
                            O = __builtin_amdgcn_mfma_f32_32x32x16_bf16(__builtin_shufflevector(lo, hi, 0, 1, 2, 3, 4, 5, 6, 7), __builtin_bit_cast(bf16x8, xb), O, 0, 0, 0);
                        }
                    }
                }
#pragma unroll
                for (int st = 0; st < 8; ++st)
                    O = __builtin_amdgcn_mfma_f32_32x32x16_bf16(*(const LAS bf16x8*)(ST + (32 * vto + r) * SROW + 16 * st + 8 * hh), qf[st], O, 0, 0, 0);
            }
            { float ss = 0.f;
#pragma unroll
              for (int i = 0; i < 16; ++i) ss += O[i] * O[i];
              ss += __shfl_xor(ss, 32);
              if (hh == 0) NRM[(ti * 4 + vto) * 32 + r] = ss; }
            h_state_update(F, C, s0, s1);
            __syncthreads();
            {
                const float ssum = (NRM[(ti * 4 + 0) * 32 + r] + NRM[(ti * 4 + 1) * 32 + r]) + (NRM[(ti * 4 + 2) * 32 + r] + NRM[(ti * 4 + 3) * 32 + r]);
                const float rn = rsqrtf(ssum * (1.f / 128.f) + EPS);
                const int tq = t0 + 32 * ti + r;
#pragma unroll
                for (int g4 = 0; g4 < 4; ++g4) {
                    const int v0 = 32 * vto + 8 * g4 + 4 * hh;
                    const f32x4 nw = *(const f32x4*)(NW + hc + v0);
                    const u32x2 sg = *(const u32x2*)(SG + (size_t)tq * DH + hc + v0);
                    u32x2 w;
                    w.x = pk2(O[4 * g4 + 0] * rn * nw.x * bf_lo(sg.x), O[4 * g4 + 1] * rn * nw.y * bf_hi(sg.x));
                    w.y = pk2(O[4 * g4 + 2] * rn * nw.z * bf_lo(sg.y), O[4 * g4 + 3] * rn * nw.w * bf_hi(sg.y));
                    *(u32x2*)(DOB + (size_t)tq * DM + DP + hc + v0) = w;
                }
            }
        }
    }
    __syncthreads();
}
DI void fixup_panel(Frame& F, int pm) {
    const float* ZB = (const float*)(F.ws + WS_ZB); bf16_t* ACT = (bf16_t*)(F.ws + WS_ACT); const float* cw = F.in[13]; const float* cb = F.in[14];
    const f32x4 zero = {0.f, 0.f, 0.f, 0.f};
    for (int cg = F.tid; cg < DFF / 4; cg += NWAVES * 64) {
        const int c = 4 * cg, pg = 256 * (c >> 7) + (c & 127);
        f32x4 w0[2], w1[2], w2[2], bb[2];
#pragma unroll
        for (int hv = 0; hv < 2; ++hv) { const int oc = c + DFF * hv; w0[hv] = *(const f32x4*)(cw + oc); w1[hv] = *(const f32x4*)(cw + DFF2 + oc); w2[hv] = *(const f32x4*)(cw + 2 * DFF2 + oc); bb[hv] = *(const f32x4*)(cb + oc); }
#pragma unroll
        for (int bi = 0; bi < 4; ++bi) {
            const int b = 4 * pm + bi;
            f32x4 u0[2], u1[2];
#pragma unroll
            for (int hv = 0; hv < 2; ++hv) {
                const float* zb = ZB + (size_t)b * 4 * DFF2 + pg + 128 * hv;
                const f32x4 r0 = *(const f32x4*)zb, r1 = *(const f32x4*)(zb + DFF2);
                const f32x4 p2 = b > 0 ? *(const f32x4*)(zb - 2 * DFF2) : zero, p3 = b > 0 ? *(const f32x4*)(zb - DFF2) : zero;
                u0[hv] = bb[hv] + w2[hv] * r0 + w1[hv] * p3 + w0[hv] * p2;
                u1[hv] = bb[hv] + w2[hv] * r1 + w1[hv] * r0 + w0[hv] * p3;
            }
            u32x2 a, d;
            a.x = pk2(u0[0].x * sigm(u0[0].x) * u0[1].x, u0[0].y * sigm(u0[0].y) * u0[1].y); a.y = pk2(u0[0].z * sigm(u0[0].z) * u0[1].z, u0[0].w * sigm(u0[0].w) * u0[1].w);
            d.x = pk2(u1[0].x * sigm(u1[0].x) * u1[1].x, u1[0].y * sigm(u1[0].y) * u1[1].y); d.y = pk2(u1[0].z * sigm(u1[0].z) * u1[1].z, u1[0].w * sigm(u1[0].w) * u1[1].w);
            *(u32x2*)(ACT + (size_t)(64 * b) * DFF + c) = a;
            *(u32x2*)(ACT + (size_t)(64 * b + 1) * DFF + c) = d;
        }
    }
    asm volatile("s_waitcnt vmcnt(0)" ::: "memory");
    __syncthreads();
}
DI void final_phase(Frame& F) {
    const float* SSQ = (const float*)(F.ws + WS_SSQ3); const float* wf = F.in[19]; float* out = F.out;
    const int gw = F.vcu * NWAVES + F.wave, NGW = F.G * NWAVES;
    for (int m = gw; m < S; m += NGW) {
        float s = F.lane < 32 ? SSQ[(size_t)m * 32 + F.lane] : 0.f;
        s = wave_sum(s);
        const float rr = rsqrtf(s * (1.f / DM) + EPS);
        f32x4* xr = (f32x4*)(out + (size_t)m * DM) + F.lane; const f32x4* wr_ = (const f32x4*)wf + F.lane;
#pragma unroll
        for (int j = 0; j < 8; ++j) { const f32x4 v = xr[64 * j], w = wr_[64 * j]; xr[64 * j] = v * rr * w; }
    }
}

struct Args { const float* in[20]; float* out; unsigned char* ws; int ph_lo, ph_hi, li, pad; };
constexpr int NPHASE = 10;
#define WGM_G1 2
#define WGM_G5 2
#define WGM_SQ 2

#define REP_P0 1
#define REP_P1 1
#define REP_P2 1
#define REP_P4 1
#define REP_P5 1
#define REP_P6 1
#define REP_P7 1
#define REP_BAR 1
#define TS_PHASE 99

__global__ void __launch_bounds__(NWAVES * 64, 2) mk_fwd(Args args) {
    extern __shared__ __attribute__((aligned(16))) unsigned char lds[];
    Frame F;
    F.lds = (LAS unsigned char*)lds;
    F.tid = threadIdx.x; F.lane = F.tid & 63; F.wave = __builtin_amdgcn_readfirstlane(F.tid >> 6);
    F.G = gridDim.x; { const int bx = blockIdx.x; F.vcu = (F.G % 8 == 0) ? (bx % 8) * (F.G / 8) + bx / 8 : bx; }
    F.ws = args.ws; F.out = args.out; F.in = args.in;
    volatile LAS unsigned* MISC = (volatile LAS unsigned*)(F.lds + MISC_OFF);
    for (int u = F.tid; u < (LDS_BYTES - LDSCTL_OFF) / 4; u += NWAVES * 64) ((LAS unsigned*)(F.lds + LDSCTL_OFF))[u] = 0u;
    __syncthreads();
    const bool multi = (args.ph_hi - args.ph_lo) > 1;
    XcdBarrier bar; bar.bar = (unsigned*)(args.ws + WS_CTL) + CW_BAR + args.li * XCD_BAR_WORDS; bar.x = 0; bar.st = nullptr;
    if (multi) bar = xcd_barrier_post(bar.bar, MISC + 8);
    const int lo = args.ph_lo, hi = args.ph_hi;
    if (TS_PHASE == 0 && blockIdx.x == 0 && F.tid == 0) MISC[16] = (unsigned)__builtin_amdgcn_s_memrealtime();
#define IN(k) (lo <= (k) && (k) < hi)
#define SEAM(k) do { if (IN(k) && IN((k) + 1)) xcd_barrier(bar); if (TS_PHASE != 99 && blockIdx.x == 0 && F.tid == 0) { const unsigned long long _t = __builtin_amdgcn_s_memrealtime(); if ((k) + 1 == TS_PHASE) MISC[16] = (unsigned)_t; if ((k) == TS_PHASE) MISC[17] = (unsigned)_t; } } while (0)
    unsigned char* ws = args.ws;
    const int bid = (int)blockIdx.x;

#define BODY_P1 {     \
        pg8::Gemm g{(const bf16_t*)(ws + WS_XB), (const bf16_t*)(ws + WS_WIN), DM, DM, DM}; pg8::StaticOrder So; So.init(S, DIN, F.G, bid, WGM_G1); \
        EpiProj E{ws, F.out}; \
        pg8::gemm_phase<EpiProj, true>(F.lds, g, So, E); \
        convert_rest(F); }
#define BODY_P5 {     \
        pg8::Gemm g{(const bf16_t*)(ws + WS_DOB), (const bf16_t*)(ws + WS_WAB), DM, DM, DM}; pg8::StaticOrder So; So.init(S, DM, F.G, bid, WGM_SQ); \
        EpiMerge E{(const bf16_t*)F.out, (const bf16_t*)F.out + (size_t)S * DM, (bf16_t*)(ws + WS_MG)}; \
        pg8::gemm_phase<EpiMerge, true>(F.lds, g, So, E); }
#define BODY_P6 {     \
        pg8::Gemm g{(const bf16_t*)(ws + WS_MG), (const bf16_t*)(ws + WS_WOUT), DM, DM, DM}; pg8::StaticOrder So; So.init(S, DM, F.G, bid, WGM_SQ); \
        EpiResB<true> E{(const void*)(ws + WS_XB), (bf16_t*)(ws + WS_XB), (float*)(ws + WS_SSQ1)}; \
        pg8::gemm_phase<EpiResB<true>, true>(F.lds, g, So, E); }
#define BODY_P7 {     \
        pg8::Gemm g{(const bf16_t*)(ws + WS_XB), (const bf16_t*)(ws + WS_WUP), DM, DM, DM}; pg8::StaticOrder So; So.init(S, DFF2, F.G, bid, WGM_G5); \
        EpiUp E{ws, F.in[13], F.in[14], F.lds}; \
        pg8::gemm_phase<EpiUp, true>(F.lds, g, So, E); \
        {   \
          pg8::Gemm g2{(const bf16_t*)(ws + WS_PB), (const bf16_t*)(ws + WS_WPLE), PLE, PLE, PLE}; pg8::TailOrder St; St.init(S, DM, F.G, bid, (S / 256) * (DFF2 / 256) - 5 * F.G); \
          EpiBf E2{(bf16_t*)(ws + WS_E), DM}; \
          pg8::gemm_phase<EpiBf, false, pg8::TailOrder>(F.lds, g2, St, E2); } }

    if (IN(0)) { for (int rp = 0; rp <= args.pad; ++rp) p0_prologue(F); } SEAM(0);
    if (multi) for (int rb = 1; rb < REP_BAR; ++rb) xcd_barrier(bar);
    if (IN(1)) { BODY_P1 if (REP_P1 > 1) BODY_P1 } SEAM(1);
    if (IN(2)) { h1_phase(F); pool_phase(F); if (REP_P2 > 1) { h1_phase(F); pool_phase(F); } if (REP_P2 > 2) { h1_phase(F); pool_phase(F); } } SEAM(2);
    if (IN(3)) { h2_phase(F); } SEAM(3);
    if (IN(4)) { h3_phase(F); if (REP_P4 > 1) h3_phase(F); if (REP_P4 > 2) h3_phase(F); } SEAM(4);
    if (IN(5)) { BODY_P5 if (REP_P5 > 1) BODY_P5 } SEAM(5);
    if (IN(6)) { BODY_P6 if (REP_P6 > 1) BODY_P6 } SEAM(6);
    if (IN(7)) { BODY_P7 if (REP_P7 > 1) BODY_P7 } SEAM(7);
    if (IN(8)) {
        pg8::Gemm g{(const bf16_t*)(ws + WS_ACT), (const bf16_t*)(ws + WS_WDOWN), DFF, DFF, DFF}; pg8::StaticOrder So; So.init(S, DM, F.G, bid, WGM_SQ);
        { Unit u0; if (So.next(0, u0)) fixup_panel(F, u0.pm); }
        EpiResB<true> E{(const void*)(ws + WS_XB), (bf16_t*)(ws + WS_XB), (float*)(ws + WS_SSQ2)};
        pg8::gemm_phase<EpiResB<true>, true>(F.lds, g, So, E);
    } SEAM(8);
    if (IN(9)) {
        pg8::Gemm g{(const bf16_t*)(ws + WS_XB), (const bf16_t*)(ws + WS_WPG), DM, DM, DM}; pg8::StaticOrder So; So.init(S, DM, F.G, bid, WGM_SQ);
        EpiPle E{ws, F.out, F.in[19]};
        pg8::gemm_phase<EpiPle, true>(F.lds, g, So, E);
    }
    if (TS_PHASE != 99 && blockIdx.x == 0 && F.tid == 0) { const unsigned long long t1 = __builtin_amdgcn_s_memrealtime(); if (TS_PHASE == 9) MISC[17] = (unsigned)t1; unsigned span = MISC[17] - MISC[16]; if (span > 100000u) span = 100000u;
        while ((unsigned)(__builtin_amdgcn_s_memrealtime() - t1) < 2u * span) __builtin_amdgcn_s_sleep(8); }
#undef IN
#undef SEAM
}

#ifndef MK_N_LAUNCHES
#define MK_N_LAUNCHES 1
#endif
extern "C" void kernel_launch(void* const* d_in, const int* in_sizes, int n_in, void* d_out, int out_size, void* d_ws, size_t ws_size, hipStream_t stream) {
    static int grid = 0;
    if (grid == 0) {
        if (n_in != 20 || in_sizes[0] != S * DM || out_size != S * DM || ws_size < WS_END) { fprintf(stderr, "kernel_launch: unexpected shapes / workspace (%zu < %zu)\n", ws_size, (size_t)WS_END); grid = -1; return; }
        int dev = 0, cus = 0, per_cu = 0;
        if (hipGetDevice(&dev) != hipSuccess || hipDeviceGetAttribute(&cus, hipDeviceAttributeMultiprocessorCount, dev) != hipSuccess) { grid = -1; return; }
        if (hipFuncSetAttribute((const void*)mk_fwd, hipFuncAttributeMaxDynamicSharedMemorySize, LDS_BYTES) != hipSuccess) { fprintf(stderr, "kernel_launch: hipFuncSetAttribute failed\n"); grid = -1; return; }
        if (hipOccupancyMaxActiveBlocksPerMultiprocessor(&per_cu, (const void*)mk_fwd, NWAVES * 64, LDS_BYTES) != hipSuccess || per_cu < 1) { fprintf(stderr, "kernel_launch: occupancy query says %d\n", per_cu); per_cu = 1; }
        (void)hipGetLastError();
        grid = cus;
    }
    if (grid < 0) return;
    (void)hipMemsetAsync((char*)d_ws + WS_CTL, 0, CTL_ZERO_BYTES, stream);
    Args a{};
    for (int i = 0; i < 20; ++i) a.in[i] = (const float*)d_in[i];
    a.out = (float*)d_out; a.ws = (unsigned char*)d_ws; a.pad = REP_P0 - 1;
    if (MK_N_LAUNCHES == 1) {
        a.ph_lo = 0; a.ph_hi = NPHASE; a.li = 0;
        hipLaunchKernelGGL(mk_fwd, dim3(grid), dim3(NWAVES * 64), LDS_BYTES, stream, a);
    } else {
        for (int ph = 0; ph < NPHASE; ++ph) { a.ph_lo = ph; a.ph_hi = ph + 1; a.li = 0; hipLaunchKernelGGL(mk_fwd, dim3(grid), dim3(NWAVES * 64), LDS_BYTES, stream, a); }
    }
}
```

```cpp
#include <hip/hip_runtime.h>
#include <cstdio>
#include <cstdint>

#define LAS __attribute__((address_space(3)))
#define GAS __attribute__((address_space(1)))
typedef unsigned short bf16_t;
typedef short bf16x8 __attribute__((ext_vector_type(8)));
typedef short s16x4 __attribute__((ext_vector_type(4)));
typedef float f32x4 __attribute__((ext_vector_type(4)));
typedef float f32x2 __attribute__((ext_vector_type(2)));
typedef float f32x16 __attribute__((ext_vector_type(16)));
typedef unsigned u32x4 __attribute__((ext_vector_type(4)));
typedef unsigned u32x2 __attribute__((ext_vector_type(2)));
typedef __bf16 bf16v2 __attribute__((ext_vector_type(2)));
#define DI __device__ __forceinline__

constexpr int S = 8192, DM = 2048, DP = 1024, DH = 1024, DIN = 9216, DFF = 5504, DFF2 = 11008, PLE = 256, NCHUNK = 128;
constexpr float EPS = 1e-6f;

DI unsigned pk2(float lo, float hi) { f32x2 v = {lo, hi}; bf16v2 r = __builtin_convertvector(v, bf16v2); return __builtin_bit_cast(unsigned, r); }
DI float bf_lo(unsigned w) { return __builtin_bit_cast(float, w << 16); }
DI float bf_hi(unsigned w) { return __builtin_bit_cast(float, w & 0xffff0000u); }
DI float sigm(float v) { return __builtin_amdgcn_rcpf(1.0f + __expf(-v)); }
DI float wave_sum(float v) {
#pragma unroll
    for (int o = 1; o < 64; o <<= 1) v += __shfl_xor(v, o);
    return v;
}
template <int CTRL> DI float dppf(float v) { return __builtin_bit_cast(float, __builtin_amdgcn_update_dpp(0, __builtin_bit_cast(int, v), CTRL, 0xf, 0xf, true)); }
DI u32x4 pack8(f32x4 a, f32x4 b) { u32x4 w; w.x = pk2(a.x, a.y); w.y = pk2(a.z, a.w); w.z = pk2(b.x, b.y); w.w = pk2(b.z, b.w); return w; }
DI void unpack8(u32x4 w, f32x4& a, f32x4& b) { a.x = bf_lo(w.x); a.y = bf_hi(w.x); a.z = bf_lo(w.y); a.w = bf_hi(w.y); b.x = bf_lo(w.z); b.y = bf_hi(w.z); b.z = bf_lo(w.w); b.w = bf_hi(w.w); }

DI int fq_off(int ti, int st, int lanep) { return ((ti * 8 + st) * 64 + lanep) * 8; }

namespace pg8 {
constexpr int BM = 256, BK = 64, HALF = 128, HTB = HALF * BK * 2, STAGE_BYTES = 8 * HTB, NXCD = 8, WGM = 8;
__host__ __device__ __forceinline__ int lds_byte(int r, int c) { const int st = (r >> 4) * 2 + (c >> 5), rr = r & 15, cc = c & 31, ob = rr * 64 + cc * 2; return st * 1024 + (ob ^ (((ob >> 9) & 1) << 5)); }
__host__ __device__ __forceinline__ void stage_rc(int b, int& R, int& C) { const int st = b / 1024, sb = b % 1024, swz = sb ^ (((sb >> 9) & 1) << 5); R = (st >> 1) * 16 + swz / 64; C = (st & 1) * 32 + (swz % 64) / 2; }
__host__ __device__ __forceinline__ int perm32(int rho) { const int n = rho >> 4, i = rho & 15; return 8 * (i >> 2) + 4 * n + (i & 3); }

struct Unit { int pm, pn, ui, k0, ntu, kind, sl; };
struct Gemm { const bf16_t* A; const bf16_t* Bt; int lda, ldb, K; };

struct StaticOrder {
    static constexpr bool KSPLIT = false;
    int nM, nN, nwg, G, c, wgm, lim;
    DI void init(int M, int N, int G_, int c_, int wgm_ = WGM) { nM = M / BM; nN = N / BM; nwg = nM * nN; G = G_; c = c_; wgm = wgm_; lim = nwg; }
    DI bool next(int i, Unit& u) const { return at((long)i * G + c, u); }
    DI bool at(long L, Unit& u) const {
        if (L >= lim) return false;
        int wgid = (int)L; { const int q = nwg / NXCD, r = nwg % NXCD, xcd = wgid % NXCD, off = wgid / NXCD; wgid = (xcd < r ? xcd * (q + 1) : r * (q + 1) + (xcd - r) * q) + off; }
        const int nig = wgm * nN, gid = wgid / nig, fm = gid * wgm, gsz = (nM - fm) < wgm ? (nM - fm) : wgm;
        u.pm = fm + ((wgid % nig) % gsz); u.pn = (wgid % nig) / gsz; return true;
    }
};

struct SplitTail {
    static constexpr bool KSPLIT = true;
    StaticOrder so; int full, rem, nt, ntp; bool split;
    DI void init(int M, int N, int G_, int c_, int wgm_, int nt_, int ntp_) { so.init(M, N, G_, c_, wgm_); full = so.nwg / G_; rem = so.nwg % G_; split = rem > 0 && 2 * rem <= G_; nt = nt_; ntp = ntp_; }
    DI bool next(int i, Unit& u) const {
        if (!split || i != 0) return false;
        int c = so.c; u.k0 = 0; u.ntu = ntp; u.kind = 1;
        if (c >= rem) { if (c >= 2 * rem) return false; c -= rem; u.k0 = ntp; u.ntu = nt - ntp; u.kind = 2; }
        u.sl = c;
        return so.at((long)full * so.G + c, u);
    }
};
struct TailOrder2 {
    static constexpr bool KSPLIT = false;
    int nN, nE, c, idle0, I, a, sec0, nsec;
    DI void init(int M, int N, int G, int c_, int rem, bool split) { nN = N / BM; nE = (M / BM) * nN; c = c_; sec0 = rem; nsec = split ? rem : 0; idle0 = rem + nsec; I = G - idle0;
        a = I > 0 ? (nE + I - 1) / I : 0; if (split && a > 3) a = 3; }
    DI bool next(int i, Unit& u) const {
        int L;
        if (c >= idle0) { if (i >= a) return false; L = (c - idle0) + i * I; }
        else if (c >= sec0 && nsec > 0) { L = a * I + (c - sec0) + i * nsec; }
        else return false;
        if (L >= nE) return false;
        u.pm = L / nN; u.pn = L - u.pm * nN; return true;
    }
};
struct TailOrder {
    static constexpr bool KSPLIT = false;
    int nM, nN, nwg, G, c, c0;
    DI void init(int M, int N, int G_, int c_, int c0_) { nM = M / BM; nN = N / BM; nwg = nM * nN; G = G_; c = c_; c0 = c0_; }
    DI bool next(int i, Unit& u) const {
        if (c < c0) return false;
        const int L = (c - c0) + i * (G - c0); if (L >= nwg) return false;
        u.pm = L / nN; u.pn = L - u.pm * nN; return true;
    }
};
template <class Epi, bool ALIGN_EPI, class Sched = StaticOrder>
DI void gemm_phase(LAS unsigned char* lds, const Gemm g, const Sched& S, const Epi& E) {
    int tid_o = threadIdx.x; asm volatile("" : "+v"(tid_o));
    const int tid = tid_o, wid = __builtin_amdgcn_readfirstlane(tid >> 6), lane = tid & 63, wr = wid >> 2, wc = wid & 3, fr = lane & 15, fq = lane >> 4;
    const int K = g.K, nt = K / BK;
    unsigned voffA[2], voffB[2];
#pragma unroll
    for (int i = 0; i < 2; ++i) { int R, C; stage_rc(tid * 16 + i * 8192, R, C); const int Rb = (R & ~31) + perm32(R & 31);
        voffA[i] = (unsigned)(R * g.lda + C) * 2u; voffB[i] = (unsigned)(Rb * g.ldb + C) * 2u; }
    const size_t kstep = (size_t)(BK * 2);
    const size_t hstepA = (size_t)HALF * g.lda * 2, hstepB = (size_t)HALF * g.ldb * 2;
    const size_t tstepA = 2 * hstepA, tstepB = 2 * hstepB;
    const unsigned ldsw = (unsigned)wid * 1024u;
    const int aoff = lds_byte(wr * 64 + fr, fq * 8), boff = lds_byte(wc * 32 + fr, fq * 8);
#define PG8_SA(b, h) (((b) * 2 + (h)) * HTB)
#define PG8_SB(b, h) ((4 + (b) * 2 + (h)) * HTB)
#define PG8_STAGE(bufoff, gbase, voff) do { _Pragma("unroll") for (int _i = 0; _i < 2; ++_i) \
        __builtin_amdgcn_global_load_lds((const unsigned*)((const char*)(gbase) + (voff)[_i]), (LAS unsigned*)(lds + (bufoff) + ldsw + _i * 8192), 16, 0, 0); } while (0)
#define PG8_LDA(dst, b, h) do { _Pragma("unroll") for (int m = 0; m < 4; ++m) _Pragma("unroll") for (int k = 0; k < 2; ++k) dst[m][k] = *(const LAS bf16x8*)(lds + PG8_SA(b, h) + aoff + m * 2048 + k * 1024); } while (0)
#define PG8_LDB(dst, b, h) do { _Pragma("unroll") for (int n = 0; n < 2; ++n) _Pragma("unroll") for (int k = 0; k < 2; ++k) dst[n][k] = *(const LAS bf16x8*)(lds + PG8_SB(b, h) + boff + n * 2048 + k * 1024); } while (0)
#define PG8_MMA(ai, bj, At, Bt) do { __builtin_amdgcn_s_setprio(1); _Pragma("unroll") for (int m = 0; m < 4; ++m) _Pragma("unroll") for (int n = 0; n < 2; ++n) _Pragma("unroll") for (int k = 0; k < 2; ++k) \
        acc[ai][bj][m][n] = __builtin_amdgcn_mfma_f32_16x16x32_bf16(Bt[n][k], At[m][k], acc[ai][bj][m][n], 0, 0, 0); __builtin_amdgcn_s_setprio(0); } while (0)
#define PG8_WAIT_V(n) asm volatile("s_waitcnt vmcnt(" #n ")" ::: "memory")
#define PG8_WAIT_L(n) asm volatile("s_waitcnt lgkmcnt(" #n ")" ::: "memory")
#define PG8_BAR __builtin_amdgcn_s_barrier()
#define PG8_SCHED __builtin_amdgcn_sched_barrier(0)
    Unit cur, nxt; int ui = 0;
    if (!S.next(0, cur)) return;
    cur.ui = 0;
    if constexpr (Epi::HAS_PRE) E.pre(lds, cur, wid, lane);
    f32x4 acc[2][2][4][2];
#pragma unroll
    for (int a = 0; a < 2; ++a)
#pragma unroll
        for (int b = 0; b < 2; ++b)
#pragma unroll
            for (int m = 0; m < 4; ++m)
#pragma unroll
                for (int n = 0; n < 2; ++n) acc[a][b][m][n] = (f32x4){0.f, 0.f, 0.f, 0.f};
    bf16x8 At[4][2], B0[2][2], B1[2][2];
    const char* cA = (const char*)g.A + (size_t)cur.pm * tstepA; const char* cB = (const char*)g.Bt + (size_t)cur.pn * tstepB;
    if constexpr (Sched::KSPLIT) { cA += (size_t)cur.k0 * kstep; cB += (size_t)cur.k0 * kstep; }
    PG8_STAGE(PG8_SB(0, 0), cB, voffB); PG8_STAGE(PG8_SB(0, 1), cB + hstepB, voffB); PG8_STAGE(PG8_SA(0, 0), cA, voffA); PG8_STAGE(PG8_SA(0, 1), cA + hstepA, voffA);
    if (wr == 1) PG8_BAR;
    PG8_WAIT_V(2); PG8_BAR;
    PG8_STAGE(PG8_SB(1, 0), cB + kstep, voffB); PG8_STAGE(PG8_SA(1, 0), cA + kstep, voffA); PG8_STAGE(PG8_SB(1, 1), cB + hstepB + kstep, voffB);
    PG8_WAIT_V(6); PG8_BAR;
    for (;;) {
        const bool has_next = S.next(ui + 1, nxt);
        const char* nA = has_next ? (const char*)g.A + (size_t)nxt.pm * tstepA : cA; const char* nB = has_next ? (const char*)g.Bt + (size_t)nxt.pn * tstepB : cB;
        if constexpr (Sched::KSPLIT) { if (has_next) { nA += (size_t)nxt.k0 * kstep; nB += (size_t)nxt.k0 * kstep; } }
        const int ntc = Sched::KSPLIT ? cur.ntu : nt;
        for (int t = 0; t < ntc; t += 2) {
            const bool last = (t == ntc - 2);
            const char* a1 = cA + (size_t)(t + 1) * kstep;
            const char* a2 = last ? nA : cA + (size_t)(t + 2) * kstep; const char* b2 = last ? nB : cB + (size_t)(t + 2) * kstep;
            const char* a3 = a2 + kstep; const char* b3 = b2 + kstep;
            if constexpr (Epi::MIDK != 0) { if (t == Epi::MIDK) E.mid(acc, cur, wr, wc, fr, fq); }
            PG8_LDB(B0, 0, 0); PG8_LDB(B1, 0, 1); PG8_SCHED; PG8_LDA(At, 0, 0); PG8_STAGE(PG8_SA(1, 1), a1 + hstepA, voffA);
            PG8_WAIT_V(8); PG8_WAIT_L(0); PG8_BAR; PG8_MMA(0, 0, At, B0); PG8_MMA(0, 1, At, B1); PG8_BAR; PG8_SCHED;
            PG8_LDA(At, 0, 1); PG8_STAGE(PG8_SB(0, 0), b2, voffB); PG8_STAGE(PG8_SB(0, 1), b2 + hstepB, voffB); PG8_STAGE(PG8_SA(0, 0), a2, voffA);
            PG8_WAIT_V(8); PG8_WAIT_L(0); PG8_BAR; PG8_MMA(1, 0, At, B0); PG8_MMA(1, 1, At, B1); PG8_BAR; PG8_SCHED;
            PG8_LDB(B0, 1, 0); PG8_LDB(B1, 1, 1); PG8_SCHED; PG8_LDA(At, 1, 0); PG8_STAGE(PG8_SA(0, 1), a2 + hstepA, voffA);
            PG8_WAIT_V(8); PG8_WAIT_L(0); PG8_BAR; PG8_MMA(0, 0, At, B0); PG8_MMA(0, 1, At, B1); PG8_BAR; PG8_SCHED;
            PG8_LDA(At, 1, 1); PG8_STAGE(PG8_SB(1, 0), b3, voffB); PG8_STAGE(PG8_SB(1, 1), b3 + hstepB, voffB); PG8_STAGE(PG8_SA(1, 0), a3, voffA);
            PG8_WAIT_V(8); PG8_WAIT_L(0); PG8_BAR; PG8_MMA(1, 0, At, B0); PG8_MMA(1, 1, At, B1); PG8_BAR; PG8_SCHED;
        }
        if constexpr (ALIGN_EPI) { if (wr == 0) PG8_BAR; }
        if constexpr (!Epi::AFTER_DRAIN) E(acc, cur, wr, wc, fr, fq);
        if (!has_next) break;
#pragma unroll
        for (int a = 0; a < 2; ++a)
#pragma unroll
            for (int b = 0; b < 2; ++b)
#pragma unroll
                for (int m = 0; m < 4; ++m)
#pragma unroll
                    for (int n = 0; n < 2; ++n) acc[a][b][m][n] = (f32x4){0.f, 0.f, 0.f, 0.f};
        cur = nxt; cA = nA; cB = nB; ++ui; cur.ui = ui;
        if constexpr (Epi::HAS_PRE) E.pre(lds, cur, wid, lane);
        if constexpr (ALIGN_EPI) { if (wr == 1) PG8_BAR; }
    }
    PG8_WAIT_V(0);
    if constexpr (!ALIGN_EPI) { if (wr == 0) PG8_BAR; }
    PG8_BAR;
    if constexpr (Epi::AFTER_DRAIN) E.fused(acc, cur, wr, wc, fr, fq);
#undef PG8_SA
#undef PG8_SB
#undef PG8_STAGE
#undef PG8_LDA
#undef PG8_LDB
#undef PG8_MMA
#undef PG8_WAIT_V
#undef PG8_WAIT_L
#undef PG8_BAR
#undef PG8_SCHED
}
}
using pg8::Unit;
typedef f32x4 AccT[2][2][4][2];

constexpr size_t MiB = 1u << 20;
constexpr size_t WS_CTL = 0, CTL_ZERO_BYTES = 1 * MiB;
constexpr size_t WS_R1 = 1 * MiB, WS_LB = WS_R1 + 65536;
constexpr size_t WS_SSQ1 = 2 * MiB, WS_SSQ2 = 3 * MiB, WS_SSQ3 = 4 * MiB;
constexpr size_t WS_WAB = 6 * MiB, WS_WOUT = 14 * MiB, WS_WPG = 22 * MiB, WS_WPLE = 30 * MiB, WS_WDOWN = 31 * MiB, WS_WUP = 53 * MiB, WS_WIN = 96 * MiB;
constexpr size_t WS_XB = 132 * MiB;
constexpr size_t WS_UP = 164 * MiB, WS_Q = 180 * MiB, WS_KK = 196 * MiB, WS_V = 212 * MiB, WS_SG = 228 * MiB;
constexpr size_t WS_KP = 244 * MiB, WS_DL = 260 * MiB;
constexpr size_t WS_BC = 244 * MiB;
constexpr size_t WS_DOB = 276 * MiB;
constexpr size_t WS_PB = 308 * MiB;
constexpr size_t WS_ZB = 312 * MiB;
constexpr size_t WS_END = 344 * MiB;
constexpr size_t WS_LT = 96 * MiB;
constexpr size_t WS_TMP = 164 * MiB;
constexpr size_t WS_MG = 244 * MiB;
constexpr size_t WS_STB = 312 * MiB;
constexpr size_t WS_E = 96 * MiB;
constexpr size_t WS_ACT = 164 * MiB;
static_assert(WS_WUP + (size_t)DFF2 * DM * 2 <= WS_WIN && WS_WIN + (size_t)DIN * DM * 2 <= WS_XB && WS_LT + (size_t)256 * 16384 * 4 <= WS_XB, "ws map");
static_assert(WS_ACT + (size_t)S * DFF * 2 <= WS_DOB && WS_ZB + (size_t)128 * 4 * DFF2 * 4 <= WS_END, "ws map 2");

constexpr int CW_BAR = 4096;
constexpr int CW_KS = 24576;
constexpr size_t WS_SLAB = WS_DOB;
constexpr int RING_BYTES = 131072, LDSCTL_OFF = RING_BYTES, MISC_OFF = LDSCTL_OFF + 320, LDS_BYTES = 147456;
constexpr int NWAVES = 8;

typedef GAS unsigned gu32;
#define RLX_AGENT __ATOMIC_RELAXED, __HIP_MEMORY_SCOPE_AGENT
#define LDS_WAIT() asm volatile("s_waitcnt lgkmcnt(0)" ::: "memory")

#define XB_TMO      128
#define XB_XCNT(j)  (256  + 64 * (j))
#define XB_XSUB(j)  (1280 + 64 * (j))
#define XB_XGEN(j)  (2304 + 64 * (j))
#define XB_TOP      3328
#define XB_TOPGEN   3392
#define XCD_BAR_WORDS 3456
#define XB_SPIN_CAP (1u << 22)
DI unsigned xb_ld(unsigned* p)              { return __hip_atomic_load(p, __ATOMIC_RELAXED, __HIP_MEMORY_SCOPE_AGENT); }
DI unsigned xb_add(unsigned* p, unsigned v) { return __hip_atomic_fetch_add(p, v, __ATOMIC_RELAXED, __HIP_MEMORY_SCOPE_AGENT); }
DI unsigned xb_xcc_id() { return (unsigned)__builtin_amdgcn_s_getreg((3 << 11) | 20) & 0xFu; }
#define XB_SPIN(cond, bar) do { unsigned _sp = 0; while (cond) { __builtin_amdgcn_s_sleep(1); \
    if ((++_sp & 255u) == 0u) { if (xb_ld(&(bar)[XB_TMO])) break; if (_sp > XB_SPIN_CAP) { atomicAdd(&(bar)[XB_TMO], 1u); break; } } } } while (0)
struct XcdBarrier { unsigned* bar; unsigned x; volatile LAS unsigned* st; };
DI XcdBarrier xcd_barrier_post(unsigned* bar, volatile LAS unsigned* st) {
    XcdBarrier b; b.bar = bar; b.x = xb_xcc_id(); b.st = st;
    if (threadIdx.x == 0) (void)xb_add(&bar[XB_XCNT(b.x)], 1u);
    return b;
}
DI void xcd_barrier_complete(unsigned* bar, unsigned x, unsigned& nloc, unsigned& nx) {
    const unsigned G = gridDim.x * gridDim.y * gridDim.z;
    unsigned sum, cnt, mine, sp = 0u;
    for (;;) {
        sum = 0u; cnt = 0u; mine = 0u;
#pragma unroll
        for (unsigned j = 0; j < 16; ++j) { const unsigned c = xb_ld(&bar[XB_XCNT(j)]); sum += c; cnt += (c > 0u) ? 1u : 0u; mine = (j == x) ? c : mine; }
        if (sum == G) break;
        __builtin_amdgcn_s_sleep(1);
        if ((++sp & 255u) == 0u) { if (xb_ld(&bar[XB_TMO])) break; if (sp > XB_SPIN_CAP) { atomicAdd(&bar[XB_TMO], 1u); break; } }
    }
    nloc = mine > 0u ? mine : 1u; nx = cnt > 0u ? cnt : 1u;
}
DI void xcd_barrier(const XcdBarrier& b) {
    asm volatile("s_waitcnt vmcnt(0)" ::: "memory");
    __syncthreads();
    if (threadIdx.x == 0) {
        unsigned* bar = b.bar;
        __builtin_amdgcn_s_waitcnt(0);
        unsigned nloc = b.st[0], nx = b.st[1];
        if (nloc == 0u) { xcd_barrier_complete(bar, b.x, nloc, nx); b.st[0] = nloc; b.st[1] = nx; }
        const unsigned old = xb_add(&bar[XB_XSUB(b.x)], 1u);
        const unsigned gen = old / nloc;
        if (old + 1u == (gen + 1u) * nloc) {
            __builtin_amdgcn_fence(__ATOMIC_RELEASE, "agent");
            asm volatile("s_waitcnt vmcnt(0)" ::: "memory");
            const unsigned og = xb_add(&bar[XB_TOP], 1u);
            const unsigned tg = og / nx;
            if (og + 1u == (tg + 1u) * nx) xb_add(&bar[XB_TOPGEN], 1u);
            else XB_SPIN(xb_ld(&bar[XB_TOPGEN]) == tg, bar);
            __builtin_amdgcn_fence(__ATOMIC_ACQUIRE, "agent");
            xb_add(&bar[XB_XGEN(b.x)], 1u);
            asm volatile("s_waitcnt vmcnt(0)" ::: "memory");
        } else {
            XB_SPIN(xb_ld(&bar[XB_XGEN(b.x)]) == gen, bar);
            __builtin_amdgcn_fence(__ATOMIC_ACQUIRE, "agent");
            asm volatile("s_waitcnt vmcnt(0)" ::: "memory");
        }
    }
    __syncthreads();
}

struct Frame {
    LAS unsigned char* lds;
    int tid, lane, wave, vcu, G;
    unsigned char* ws;
    const float* const* in;
    float* out;
};

struct TJob { const float* W; const float* ks; bf16_t* out; int K, N, ldo, coff, upmap, ntile; };
constexpr int TRS = 260;
DI void tr_load(const TJob& J, int tile, int wave, int lane, f32x4 (&v)[8]) {
    const int nb = J.N >> 8, kb = tile / nb, n0 = (tile - kb * nb) << 8, k0 = kb << 6;
    const float* src = J.W + (size_t)(k0 + 8 * wave) * J.N + n0 + 4 * lane;
#pragma unroll
    for (int i = 0; i < 8; ++i) v[i] = *(const f32x4*)(src + (size_t)i * J.N);
    if (J.ks) {
#pragma unroll
        for (int i = 0; i < 8; ++i) v[i] = v[i] * J.ks[k0 + 8 * wave + i];
    }
}
DI void tr_to_lds(LAS unsigned* P, int wave, int lane, const f32x4 (&v)[8]) {
#pragma unroll
    for (int i = 0; i < 4; ++i) {
        u32x4 w; w.x = pk2(v[2 * i].x, v[2 * i + 1].x); w.y = pk2(v[2 * i].y, v[2 * i + 1].y); w.z = pk2(v[2 * i].z, v[2 * i + 1].z); w.w = pk2(v[2 * i].w, v[2 * i + 1].w);
        *(LAS u32x4*)(P + (4 * wave + i) * TRS + 4 * lane) = w;
    }
}
DI void tr_store(const TJob& J, int tile, LAS const unsigned* P, int wave, int lane) {
    const int nb = J.N >> 8, kb = tile / nb, n0 = (tile - kb * nb) << 8, k0 = kb << 6;
    const int c = lane & 7;
#pragma unroll
    for (int jj = 0; jj < 4; ++jj) {
        const int nl = 32 * wave + 8 * jj + (lane >> 3), n = n0 + nl;
        u32x4 w; w.x = P[(4 * c + 0) * TRS + nl]; w.y = P[(4 * c + 1) * TRS + nl]; w.z = P[(4 * c + 2) * TRS + nl]; w.w = P[(4 * c + 3) * TRS + nl];
        int orow = n;
        if (J.upmap == 1) { const int b128 = n >> 7, half = b128 >= 43 ? 1 : 0; orow = 256 * (b128 - 43 * half) + 128 * half + (n & 127); }
        if (J.upmap == 2 && n >= DP && n < DP + 4 * DH) {
            const int sec = (n - DP) >> 10, c = (n - DP) & 1023, t = c >> 6, cc = c & 63;
            orow = DP + 256 * t + 128 * (sec >> 1) + 8 * (cc >> 2) + 4 * (sec & 1) + (cc & 3); }
        if (J.upmap == 2 && n >= DP + 4 * DH) {
            const int g = n - (DP + 4 * DH), half = g >= DM ? 1 : 0, ch = g - half * DM; orow = DP + 4 * DH + 256 * (ch >> 7) + 128 * half + (ch & 127); }
        *(u32x4*)(J.out + (size_t)orow * J.ldo + J.coff + k0 + 8 * c) = w;
    }
}
constexpr int TJ_NT[7] = {(DM / 64) * (DIN / 256), (DM / 64) * (DFF2 / 256), (DFF / 64) * (DM / 256), (DH / 64) * (DM / 256), (DM / 64) * (DM / 256), (DM / 64) * (DM / 256), (PLE / 64) * (DM / 256)};
constexpr int TJ_B1 = TJ_NT[0], TJ_B2 = TJ_B1 + TJ_NT[1], TJ_B3 = TJ_B2 + TJ_NT[2], TJ_B4 = TJ_B3 + TJ_NT[3], TJ_B5 = TJ_B4 + TJ_NT[4], TJ_B6 = TJ_B5 + TJ_NT[5], TJ_TOTAL = TJ_B6 + TJ_NT[6];
DI TJob tr_job(const Frame& F, int g, int& tile) {
    unsigned char* ws = F.ws; TJob J;
    if (g < TJ_B1)      { J = TJob{F.in[3],  F.in[2],  (bf16_t*)(ws + WS_WIN),   DM,  DIN,  DM,  0,  2, 0}; tile = g; }
    else if (g < TJ_B2) { J = TJob{F.in[12], F.in[11], (bf16_t*)(ws + WS_WUP),   DM,  DFF2, DM,  0,  1, 0}; tile = g - TJ_B1; }
    else if (g < TJ_B3) { J = TJob{F.in[15], nullptr,  (bf16_t*)(ws + WS_WDOWN), DFF, DM,   DFF, 0,  0, 0}; tile = g - TJ_B2; }
    else if (g < TJ_B4) { J = TJob{F.in[9],  nullptr,  (bf16_t*)(ws + WS_WAB),   DH,  DM,   DM,  DP, 0, 0}; tile = g - TJ_B3; }
    else if (g < TJ_B5) { J = TJob{F.in[10], nullptr,  (bf16_t*)(ws + WS_WOUT),  DM,  DM,   DM,  0,  0, 0}; tile = g - TJ_B4; }
    else if (g < TJ_B6) { J = TJob{F.in[17], F.in[16], (bf16_t*)(ws + WS_WPG),   DM,  DM,   DM,  0,  0, 0}; tile = g - TJ_B5; }
    else                { J = TJob{F.in[18], nullptr,  (bf16_t*)(ws + WS_WPLE),  PLE, DM,   PLE, 0,  0, 0}; tile = g - TJ_B6; }
    return J;
}
DI void p0_transpose_win(Frame& F) {
    LAS unsigned* P = (LAS unsigned*)F.lds;
    f32x4 v[8];
    int g = F.vcu, tile = 0;
    bool have = g < TJ_B1;
    TJob Jc{}, Jn{}; int tc = 0;
    if (have) { Jn = tr_job(F, g, tile); tr_load(Jn, tile, F.wave, F.lane, v); }
    while (have) {
        tr_to_lds(P, F.wave, F.lane, v);
        __syncthreads();
        Jc = Jn; tc = tile;
        g += F.G; have = g < TJ_B1;
        if (have) { Jn = tr_job(F, g, tile); tr_load(Jn, tile, F.wave, F.lane, v); }
        tr_store(Jc, tc, P, F.wave, F.lane);
        __syncthreads();
    }
}
DI void p0_fold_wa(Frame& F, const float* wmix, const float* scale, const float* wa, bf16_t* WAB, int tile) {
    const int g = tile >> 6, c0 = 64 * ((tile >> 4) & 3), n0 = 128 * (tile & 15);
    const int ci = F.wave & 1, ni = F.wave >> 1, r = F.lane & 31, kh = F.lane >> 5;
    const float* arow = wmix + ((size_t)g * 256 + c0 + 32 * ci + r) * 256;
    const float* bcol = wa + (size_t)(g * 256) * DM + n0 + 32 * ni + r;
    const float* sc = scale + g * 256;
    f32x16 acc;
#pragma unroll
    for (int i = 0; i < 16; ++i) acc[i] = 0.f;
#pragma unroll 1
    for (int q0 = 0; q0 < 64; q0 += 8) {
        f32x4 av[8]; float bv[16];
#pragma unroll
        for (int i = 0; i < 8; ++i) av[i] = *(const f32x4*)(arow + 4 * (q0 + i));
#pragma unroll
        for (int j = 0; j < 16; ++j) { const int d = 4 * q0 + 2 * j + kh; bv[j] = sc[d] * bcol[(size_t)d * DM]; }
#pragma unroll
        for (int i = 0; i < 8; ++i) {
            acc = __builtin_amdgcn_mfma_f32_32x32x2f32(kh ? av[i].y : av[i].x, bv[2 * i], acc, 0, 0, 0);
            acc = __builtin_amdgcn_mfma_f32_32x32x2f32(kh ? av[i].w : av[i].z, bv[2 * i + 1], acc, 0, 0, 0);
        }
    }
    bf16_t* orow = WAB + (size_t)(n0 + 32 * ni + r) * DM + g * 256 + c0 + 32 * ci + 4 * kh;
#pragma unroll
    for (int i4 = 0; i4 < 4; ++i4) { u32x2 w; w.x = pk2(acc[4 * i4], acc[4 * i4 + 1]); w.y = pk2(acc[4 * i4 + 2], acc[4 * i4 + 3]); *(u32x2*)(orow + 8 * i4) = w; }
}

DI void p0_prologue(Frame& F) {
    unsigned char* ws = F.ws;
    const int gw = F.vcu * NWAVES + F.wave, NGW = F.G * NWAVES;
    {
        const float* x = F.in[0]; bf16_t* XB = (bf16_t*)(ws + WS_XB); float* R1 = (float*)(ws + WS_R1);
        for (int m = gw; m < S; m += NGW) {
            const f32x4* xr = (const f32x4*)(x + (size_t)m * DM) + F.lane;
            f32x4 v[8]; float s = 0.f;
#pragma unroll
            for (int j = 0; j < 8; ++j) { v[j] = xr[64 * j]; s += (v[j].x * v[j].x + v[j].y * v[j].y) + (v[j].z * v[j].z + v[j].w * v[j].w); }
            s = wave_sum(s);
            if (F.lane == 0) R1[m] = rsqrtf(s * (1.f / DM) + EPS);
            u32x2* o = (u32x2*)(XB + (size_t)m * DM) + F.lane;
#pragma unroll
            for (int j = 0; j < 8; ++j) { u32x2 w; w.x = pk2(v[j].x, v[j].y); w.y = pk2(v[j].z, v[j].w); o[64 * j] = w; }
        }
    }
    {
        const f32x4* p = (const f32x4*)F.in[1]; u32x2* PB = (u32x2*)(ws + WS_PB);
        const int gt = F.vcu * 512 + F.tid, NGT = F.G * 512;
        for (int i = gt; i < S * PLE / 4; i += NGT) { const f32x4 v = p[i]; u32x2 w; w.x = pk2(v.x, v.y); w.y = pk2(v.z, v.w); PB[i] = w; }
        float* LB = (float*)(ws + WS_LB); const float* lbl = F.in[6];
        if (gt < DH) { const float l0 = lbl[gt], l1 = lbl[DH + gt], mx = fmaxf(l0, l1), e0 = __expf(l0 - mx), e1 = __expf(l1 - mx); LB[gt] = e0 / (e0 + e1); }
    }
    p0_transpose_win(F);
}
constexpr int CW_QUEUE = 20480;
DI void convert_rest(Frame& F) {
    unsigned* head = (unsigned*)(F.ws + WS_CTL) + CW_QUEUE;
    volatile LAS unsigned* slot = (volatile LAS unsigned*)(F.lds + MISC_OFF) + 20;
    LAS unsigned* P = (LAS unsigned*)F.lds;
    constexpr int NFOLD = 256, NITEM = NFOLD + (TJ_TOTAL - TJ_B1);
    for (;;) {
        __syncthreads();
        if (F.tid == 0) slot[0] = __hip_atomic_fetch_add(head, 1u, __ATOMIC_RELAXED, __HIP_MEMORY_SCOPE_AGENT);
        __syncthreads();
        const int item = (int)__builtin_amdgcn_readfirstlane(slot[0]);
        if (item >= NITEM) break;
        if (item < NFOLD) { p0_fold_wa(F, F.in[4], F.in[5], F.in[8], (bf16_t*)(F.ws + WS_WAB), item); }
        else {
            int tile = 0; const TJob J = tr_job(F, TJ_B1 + item - NFOLD, tile);
            f32x4 v[8];
            tr_load(J, tile, F.wave, F.lane, v);
            tr_to_lds(P, F.wave, F.lane, v);
            __syncthreads();
            tr_store(J, tile, P, F.wave, F.lane);
        }
    }
}


DI float row_rstd(const float* ssq, int row, int fq) {
    const f32x4* p = (const f32x4*)(ssq + (size_t)row * 32 + fq * 8);
    const f32x4 a = p[0], b = p[1];
    float s = ((a.x + a.y) + (a.z + a.w)) + ((b.x + b.y) + (b.z + b.w));
    s += __shfl_xor(s, 16); s += __shfl_xor(s, 32);
    return rsqrtf(s * (1.f / DM) + EPS);
}

DI void row_rstd8(const float* ssq, int row0, int fq, float (&r)[2][4]) {
    f32x4 a[2][4], b[2][4];
#pragma unroll
    for (int ai = 0; ai < 2; ++ai)
#pragma unroll
        for (int m = 0; m < 4; ++m) { const f32x4* p = (const f32x4*)(ssq + (size_t)(row0 + ai * 128 + m * 16) * 32 + fq * 8); a[ai][m] = p[0]; b[ai][m] = p[1]; }
#pragma unroll
    for (int ai = 0; ai < 2; ++ai)
#pragma unroll
        for (int m = 0; m < 4; ++m) {
            float s = ((a[ai][m].x + a[ai][m].y) + (a[ai][m].z + a[ai][m].w)) + ((b[ai][m].x + b[ai][m].y) + (b[ai][m].z + b[ai][m].w));
            s += __shfl_xor(s, 16); s += __shfl_xor(s, 32);
            r[ai][m] = rsqrtf(s * (1.f / DM) + EPS);
        }
}
DI void lds_read4x16(unsigned addr, f32x4& a, f32x4& b, f32x4& c, f32x4& d) {
    asm volatile("ds_read_b128 %0, %4\n\tds_read_b128 %1, %4 offset:1024\n\tds_read_b128 %2, %4 offset:2048\n\tds_read_b128 %3, %4 offset:3072\n\ts_waitcnt lgkmcnt(0)"
                 : "=&v"(a), "=&v"(b), "=&v"(c), "=&v"(d) : "v"(addr) : "memory");
}

struct EpiProj {
    static constexpr int MIDK = 0; static constexpr bool AFTER_DRAIN = false; static constexpr bool HAS_PRE = false;
    unsigned char* ws; float* dout;
    DI void operator()(const AccT& acc, const Unit& u, int wr, int wc, int fr, int fq) const {
        asm volatile("" : "+v"(fr), "+v"(fq));
        const float* R1 = (const float*)(ws + WS_R1);
        const int pn = u.pn, row0 = u.pm * 256 + wr * 64 + fr, cl = wc * 32 + 8 * fq;
        float rs[2][4];
#pragma unroll
        for (int ai = 0; ai < 2; ++ai)
#pragma unroll
            for (int m = 0; m < 4; ++m) rs[ai][m] = R1[row0 + ai * 128 + m * 16];
        if (pn >= 4 && pn < 20) {
            const float* LB = (const float*)(ws + WS_LB); bf16_t* Qp = (bf16_t*)(ws + WS_Q); bf16_t* K2 = (bf16_t*)(ws + WS_KK);
            bf16_t* Vo = (bf16_t*)(ws + WS_V); bf16_t* SGo = (bf16_t*)(ws + WS_SG); float* DL = (float*)(ws + WS_DL);
            const int t = pn - 4, hd = t >> 1, k4 = 64 * (t & 1) + 16 * wc + 4 * fq;
            const int lane = fq * 16 + fr, bsel = ((lane & ~15) | 15) << 2;
            const f32x4 lb = *(const f32x4*)(LB + hd * 128 + k4);
#pragma unroll
            for (int ai = 0; ai < 2; ++ai) {
                f32x4 lf[4], kk[4];
#pragma unroll
                for (int m = 0; m < 4; ++m)
#pragma unroll
                    for (int c = 0; c < 4; ++c) { const float v = acc[ai][0][m][1][c] * rs[ai][m]; const float sg = sigm(v); const float f = lb[c] + (1.f - lb[c]) * sg;
                        lf[m][c] = __logf(f); kk[m][c] = (1.f - lb[c]) * (1.f - sg); }
                f32x4 b63;
#pragma unroll
                for (int c = 0; c < 4; ++c) {
                    float carry = 0.f;
#pragma unroll
                    for (int m = 0; m < 4; ++m) {
                        float x = lf[m][c];
                        x += dppf<0x111>(x); x += dppf<0x112>(x); x += dppf<0x114>(x); x += dppf<0x118>(x);
                        const float tot = __builtin_bit_cast(float, __builtin_amdgcn_ds_bpermute(bsel, __builtin_bit_cast(int, x)));
                        lf[m][c] = x + carry; carry += tot;
                    }
                    b63[c] = carry;
                }
                const int chunk = 4 * u.pm + 2 * ai + wr;
                if (fr == 0) { f32x4 e63; e63.x = __expf(b63.x); e63.y = __expf(b63.y); e63.z = __expf(b63.z); e63.w = __expf(b63.w); *(f32x4*)(DL + (size_t)chunk * DH + hd * 128 + k4) = e63; }
#pragma unroll
                for (int m = 0; m < 4; ++m) {
                    const size_t of = (size_t)(chunk * 8 + hd) * 8192 + fq_off(m >> 1, 4 * (t & 1) + wc, 16 * (m & 1) + fr + 32 * (fq >> 1)) + 4 * (fq & 1);
                    const size_t orow = (size_t)(row0 + ai * 128 + m * 16) * DH + hd * 128 + k4;
                    f32x4 qp, k2, vv, sgv;
#pragma unroll
                    for (int c = 0; c < 4; ++c) {
                        const float ex = __expf(lf[m][c]);
                        qp[c] = acc[ai][0][m][0][c] * rs[ai][m] * ex; k2[c] = kk[m][c] * __builtin_amdgcn_rcpf(ex);
                        vv[c] = acc[ai][1][m][0][c] * rs[ai][m]; const float g = acc[ai][1][m][1][c] * rs[ai][m]; sgv[c] = g * sigm(g);
                    }
                    u32x2 w;
                    w.x = pk2(qp.x, qp.y); w.y = pk2(qp.z, qp.w); *(u32x2*)(Qp + of) = w;
                    w.x = pk2(k2.x, k2.y); w.y = pk2(k2.z, k2.w); *(u32x2*)(K2 + of) = w;
                    w.x = pk2(vv.x, vv.y); w.y = pk2(vv.z, vv.w); *(u32x2*)(Vo + orow) = w;
                    w.x = pk2(sgv.x, sgv.y); w.y = pk2(sgv.z, sgv.w); *(u32x2*)(SGo + orow) = w;
                }
            }
        } else if (pn >= 20) {
            bf16_t* RT = (bf16_t*)dout; bf16_t* GBo = (bf16_t*)dout + (size_t)S * DM;
            const int ch0 = 128 * (pn - 20) + cl;
#pragma unroll
            for (int ai = 0; ai < 2; ++ai)
#pragma unroll
                for (int m = 0; m < 4; ++m) {
                    const size_t o = (size_t)(row0 + ai * 128 + m * 16) * DM + ch0;
                    f32x4 r0, r1, g0, g1;
#pragma unroll
                    for (int c = 0; c < 4; ++c) {
                        const float ea0 = __expf(-__builtin_amdgcn_fmed3f(acc[ai][0][m][0][c] * rs[ai][m], -60.f, 60.f)), eb0 = __expf(-__builtin_amdgcn_fmed3f(acc[ai][1][m][0][c] * rs[ai][m], -60.f, 60.f));
                        const float ea1 = __expf(-__builtin_amdgcn_fmed3f(acc[ai][0][m][1][c] * rs[ai][m], -60.f, 60.f)), eb1 = __expf(-__builtin_amdgcn_fmed3f(acc[ai][1][m][1][c] * rs[ai][m], -60.f, 60.f));
                        r0[c] = (1.0f + eb0) * __builtin_amdgcn_rcpf(1.0f + ea0); g0[c] = __builtin_amdgcn_rcpf(1.0f + eb0);
                        r1[c] = (1.0f + eb1) * __builtin_amdgcn_rcpf(1.0f + ea1); g1[c] = __builtin_amdgcn_rcpf(1.0f + eb1);
                    }
                    *(u32x4*)(RT + o) = pack8(r0, r1); *(u32x4*)(GBo + o) = pack8(g0, g1);
                }
        } else {
        bf16_t* O = (bf16_t*)(ws + WS_UP);
#pragma unroll
        for (int ai = 0; ai < 2; ++ai)
#pragma unroll
            for (int m = 0; m < 4; ++m) {
                bf16_t* rowp = O + (size_t)(row0 + ai * 128 + m * 16) * DP + pn * 256 + cl;
#pragma unroll
                for (int bj = 0; bj < 2; ++bj) *(u32x4*)(rowp + bj * 128) = pack8(acc[ai][bj][m][0] * rs[ai][m], acc[ai][bj][m][1] * rs[ai][m]);
            }
        }
        asm volatile("" :: "v"(rs[0][0]), "v"(rs[0][1]), "v"(rs[0][2]), "v"(rs[0][3]), "v"(rs[1][0]), "v"(rs[1][1]), "v"(rs[1][2]), "v"(rs[1][3]));
    }
};

struct EpiBf {
    static constexpr int MIDK = 0; static constexpr bool AFTER_DRAIN = false; static constexpr bool HAS_PRE = false;
    bf16_t* O; int ld;
    DI void operator()(const AccT& acc, const Unit& u, int wr, int wc, int fr, int fq) const {
        asm volatile("" : "+v"(fr), "+v"(fq));
        const int row0 = u.pm * 256 + wr * 64 + fr, col0 = u.pn * 256 + wc * 32 + 8 * fq;
#pragma unroll
        for (int ai = 0; ai < 2; ++ai)
#pragma unroll
            for (int m = 0; m < 4; ++m)
#pragma unroll
                for (int bj = 0; bj < 2; ++bj) *(u32x4*)(O + (size_t)(row0 + ai * 128 + m * 16) * ld + col0 + bj * 128) = pack8(acc[ai][bj][m][0], acc[ai][bj][m][1]);
    }
};
template <int MODE> struct EpiGate {
    static constexpr int MIDK = 0; static constexpr bool AFTER_DRAIN = false; static constexpr bool HAS_PRE = false;
    const bf16_t* G; float* TMP; bf16_t* MG;
    DI void operator()(const AccT& acc, const Unit& u, int wr, int wc, int fr, int fq) const {
        asm volatile("" : "+v"(fr), "+v"(fq));
        const int row0 = u.pm * 256 + wr * 64 + fr, col0 = u.pn * 256 + wc * 32 + 8 * fq;
#pragma unroll
        for (int ai = 0; ai < 2; ++ai)
#pragma unroll
            for (int m = 0; m < 4; ++m)
#pragma unroll
                for (int bj = 0; bj < 2; ++bj) {
                    const size_t o = (size_t)(row0 + ai * 128 + m * 16) * DM + col0 + bj * 128;
                    f32x4 g0, g1; unpack8(*(const u32x4*)(G + o), g0, g1);
                    f32x4 v0 = acc[ai][bj][m][0] * g0, v1 = acc[ai][bj][m][1] * g1;
                    if (MODE == 0) { *(f32x4*)(TMP + o) = v0; *(f32x4*)(TMP + o + 4) = v1; }
                    else { v0 += *(const f32x4*)(TMP + o); v1 += *(const f32x4*)(TMP + o + 4); *(u32x4*)(MG + o) = pack8(v0, v1); }
                }
    }
};
struct EpiMerge {
    static constexpr int MIDK = 16; static constexpr bool AFTER_DRAIN = false; static constexpr bool HAS_PRE = false;
    const bf16_t* GA; const bf16_t* GB; bf16_t* MG;
    DI void mid(AccT& acc, const Unit& u, int wr, int wc, int fr, int fq) const {
        asm volatile("" : "+v"(fr), "+v"(fq));
        const int row0 = u.pm * 256 + wr * 64 + fr, col0 = u.pn * 256 + wc * 32 + 8 * fq;
#pragma unroll
        for (int ai = 0; ai < 2; ++ai)
#pragma unroll
            for (int m = 0; m < 4; ++m)
#pragma unroll
                for (int bj = 0; bj < 2; ++bj) {
                    const size_t o = (size_t)(row0 + ai * 128 + m * 16) * DM + col0 + bj * 128;
                    f32x4 a0, a1; unpack8(*(const u32x4*)(GA + o), a0, a1);
                    acc[ai][bj][m][0] = acc[ai][bj][m][0] * a0; acc[ai][bj][m][1] = acc[ai][bj][m][1] * a1;
                }
    }
    DI void operator()(const AccT& acc, const Unit& u, int wr, int wc, int fr, int fq) const {
        asm volatile("" : "+v"(fr), "+v"(fq));
        const int row0 = u.pm * 256 + wr * 64 + fr, col0 = u.pn * 256 + wc * 32 + 8 * fq;
#pragma unroll
        for (int ai = 0; ai < 2; ++ai)
#pragma unroll
            for (int m = 0; m < 4; ++m)
#pragma unroll
                for (int bj = 0; bj < 2; ++bj) {
                    const size_t o = (size_t)(row0 + ai * 128 + m * 16) * DM + col0 + bj * 128;
                    f32x4 b0, b1; unpack8(*(const u32x4*)(GB + o), b0, b1);
                    *(u32x4*)(MG + o) = pack8(acc[ai][bj][m][0] * b0, acc[ai][bj][m][1] * b1);
                }
    }
};
template <bool BF> struct EpiResB {
    static constexpr int MIDK = 0; static constexpr bool AFTER_DRAIN = false; static constexpr bool HAS_PRE = false;
    const void* base; bf16_t* xb; float* ssq;
    DI void operator()(const AccT& acc, const Unit& u, int wr, int wc, int fr, int fq) const {
        asm volatile("" : "+v"(fr), "+v"(fq));
        const int row0 = u.pm * 256 + wr * 64 + fr, col0 = u.pn * 256 + wc * 32 + 8 * fq;
#pragma unroll
        for (int ai = 0; ai < 2; ++ai)
#pragma unroll
            for (int m = 0; m < 4; ++m) {
                const int row = row0 + ai * 128 + m * 16; float s = 0.f;
#pragma unroll
                for (int bj = 0; bj < 2; ++bj) {
                    const size_t o = (size_t)row * DM + col0 + bj * 128;
                    f32x4 x0, x1;
                    if (BF) unpack8(*(const u32x4*)((const bf16_t*)base + o), x0, x1);
                    else { x0 = *(const f32x4*)((const float*)base + o); x1 = *(const f32x4*)((const float*)base + o + 4); }
                    const f32x4 v0 = acc[ai][bj][m][0] + x0, v1 = acc[ai][bj][m][1] + x1;
                    *(u32x4*)(xb + o) = pack8(v0, v1);
                    s += ((v0.x * v0.x + v0.y * v0.y) + (v0.z * v0.z + v0.w * v0.w)) + ((v1.x * v1.x + v1.y * v1.y) + (v1.z * v1.z + v1.w * v1.w));
                }
                s += __shfl_xor(s, 16); s += __shfl_xor(s, 32);
                if (fq == 0) ssq[(size_t)row * 32 + u.pn * 4 + wc] = s;
            }
    }
};
struct EpiRes {
    static constexpr int MIDK = 0; static constexpr bool AFTER_DRAIN = false; static constexpr bool HAS_PRE = false;
    const float* base; float* xo; bf16_t* xb; float* ssq;
    DI void operator()(const AccT& acc, const Unit& u, int wr, int wc, int fr, int fq) const {
        asm volatile("" : "+v"(fr), "+v"(fq));
        const int row0 = u.pm * 256 + wr * 64 + fr, col0 = u.pn * 256 + wc * 32 + 8 * fq;
#pragma unroll
        for (int ai = 0; ai < 2; ++ai)
#pragma unroll
            for (int m = 0; m < 4; ++m) {
                const int row = row0 + ai * 128 + m * 16; float s = 0.f;
#pragma unroll
                for (int bj = 0; bj < 2; ++bj) {
                    const size_t o = (size_t)row * DM + col0 + bj * 128;
                    const f32x4 v0 = acc[ai][bj][m][0] + *(const f32x4*)(base + o), v1 = acc[ai][bj][m][1] + *(const f32x4*)(base + o + 4);
                    *(f32x4*)(xo + o) = v0; *(f32x4*)(xo + o + 4) = v1; *(u32x4*)(xb + o) = pack8(v0, v1);
                    s += ((v0.x * v0.x + v0.y * v0.y) + (v0.z * v0.z + v0.w * v0.w)) + ((v1.x * v1.x + v1.y * v1.y) + (v1.z * v1.z + v1.w * v1.w));
                }
                s += __shfl_xor(s, 16); s += __shfl_xor(s, 32);
                if (fq == 0) ssq[(size_t)row * 32 + u.pn * 4 + wc] = s;
            }
    }
};
constexpr int CONV_LDS = 131584;
struct EpiUp {
    static constexpr int MIDK = 0; static constexpr bool AFTER_DRAIN = false; static constexpr bool HAS_PRE = true;
    unsigned char* ws; const float* cw; const float* cb; LAS unsigned char* lds;
    DI void pre(LAS unsigned char* l, const Unit& u, int wid, int lane) const {
        if (wid < 4) {
            const int col = (lane < 32) ? 128 * u.pn + 4 * lane : DFF + 128 * u.pn + 4 * (lane - 32);
            const float* src = (wid < 3 ? cw + (size_t)wid * DFF2 : cb) + col;
            __builtin_amdgcn_global_load_lds((const unsigned*)src, (LAS unsigned*)(l + CONV_LDS + (u.ui & 1) * 4096 + wid * 1024), 16, 0, 0);
        }
    }
    DI void operator()(const AccT& acc, const Unit& u, int wr, int wc, int fr, int fq) const {
        asm volatile("" : "+v"(fr), "+v"(fq));
        const float* SSQ = (const float*)(ws + WS_SSQ1); bf16_t* ACT = (bf16_t*)(ws + WS_ACT); float* ZB = (float*)(ws + WS_ZB);
        const int row0 = u.pm * 256 + wr * 64 + fr, j = u.pn;
#pragma unroll
        for (int ai = 0; ai < 2; ++ai) {
            float r2[4];
#pragma unroll
            for (int m = 0; m < 4; ++m) r2[m] = row_rstd(SSQ, row0 + ai * 128 + m * 16, fq);
            const int blk = 4 * u.pm + 2 * ai + wr;
#pragma unroll
            for (int n = 0; n < 2; ++n) {
                int fq2 = fq; asm volatile("" : "+v"(fq2));
                const int ch = 128 * j + 32 * wc + 8 * fq2 + 4 * n;
                const int pc = 256 * j + 32 * wc + 8 * fq2 + 4 * n;
                const unsigned cbase = (unsigned)(size_t)(lds + CONV_LDS + (u.ui & 1) * 4096) + (unsigned)(32 * wc + 8 * fq2) * 4u;
                float* zb = ZB + (size_t)blk * 4 * DFF2 + pc;
                if (fr < 2) { *(f32x4*)(zb + (size_t)fr * DFF2) = acc[ai][0][0][n] * r2[0]; *(f32x4*)(zb + (size_t)fr * DFF2 + 128) = acc[ai][1][0][n] * r2[0]; }
                if (fr >= 14) { *(f32x4*)(zb + (size_t)(fr - 12) * DFF2) = acc[ai][0][3][n] * r2[3]; *(f32x4*)(zb + (size_t)(fr - 12) * DFF2 + 128) = acc[ai][1][3][n] * r2[3]; }
                f32x4 uv[4];
                {
                    f32x4 w0, w1, w2, bb; lds_read4x16(cbase + (128 + 4 * n) * 4u, w0, w1, w2, bb);
#pragma unroll
                    for (int m = 0; m < 4; ++m) {
                        const f32x4 zc = acc[ai][1][m][n] * r2[m], zp = acc[ai][1][m > 0 ? m - 1 : 0][n] * r2[m > 0 ? m - 1 : 0];
#pragma unroll
                        for (int c = 0; c < 4; ++c) {
                            const float s1 = (m > 0 && fr == 15) ? zp[c] : zc[c], s2 = (m > 0 && fr >= 14) ? zp[c] : zc[c];
                            uv[m][c] = bb[c] + w2[c] * zc[c] + w1[c] * dppf<0x121>(s1) + w0[c] * dppf<0x122>(s2);
                        }
                    }
                }
                {
                    f32x4 w0, w1, w2, bb; lds_read4x16(cbase + (4 * n) * 4u, w0, w1, w2, bb);
#pragma unroll
                    for (int m = 0; m < 4; ++m) {
                        const f32x4 zc = acc[ai][0][m][n] * r2[m], zp = acc[ai][0][m > 0 ? m - 1 : 0][n] * r2[m > 0 ? m - 1 : 0];
                        f32x4 ug;
#pragma unroll
                        for (int c = 0; c < 4; ++c) {
                            const float s1 = (m > 0 && fr == 15) ? zp[c] : zc[c], s2 = (m > 0 && fr >= 14) ? zp[c] : zc[c];
                            ug[c] = bb[c] + w2[c] * zc[c] + w1[c] * dppf<0x121>(s1) + w0[c] * dppf<0x122>(s2);
                        }
                        if (m > 0 || fr >= 2) {
                            u32x2 w; w.x = pk2(ug.x * sigm(ug.x) * uv[m].x, ug.y * sigm(ug.y) * uv[m].y); w.y = pk2(ug.z * sigm(ug.z) * uv[m].z, ug.w * sigm(ug.w) * uv[m].w);
                            *(u32x2*)(ACT + (size_t)(row0 + ai * 128 + m * 16) * DFF + ch) = w;
                        }
                    }
                }
                __builtin_amdgcn_sched_barrier(0);
            }
        }
    }
};
struct EpiUpKS {
    static constexpr int MIDK = 0; static constexpr bool AFTER_DRAIN = true; static constexpr bool HAS_PRE = true;
    EpiUp base;
    DI void pre(LAS unsigned char* l, const Unit& u, int wid, int lane) const { base.pre(l, u, wid, lane); }
    DI void fused(AccT& acc, const Unit& u, int wr, int wc, int fr, int fq) const {
        int f0 = fr, f1 = fq; asm volatile("" : "+v"(f0), "+v"(f1));
        float* slab = (float*)(base.ws + WS_SLAB) + (size_t)u.sl * 65536 + (size_t)(((wr * 4 + wc) * 64 + f1 * 16 + f0) * 4);
        unsigned* flag = (unsigned*)(base.ws + WS_CTL) + CW_KS + 64 * u.sl;
        if (u.kind == 2) {
#pragma unroll
            for (int a = 0; a < 2; ++a)
#pragma unroll
                for (int b = 0; b < 2; ++b)
#pragma unroll
                    for (int m = 0; m < 4; ++m)
#pragma unroll
                        for (int n = 0; n < 2; ++n) *(f32x4*)(slab + (size_t)((((a * 2 + b) * 4 + m) * 2 + n) * 2048)) = acc[a][b][m][n];
            asm volatile("s_waitcnt vmcnt(0)" ::: "memory");
            __syncthreads();
            if (wr == 0 && wc == 0 && (f0 | f1) == 0) { __builtin_amdgcn_fence(__ATOMIC_RELEASE, "agent"); __hip_atomic_store(flag, 1u, __ATOMIC_RELAXED, __HIP_MEMORY_SCOPE_AGENT); }
            return;
        }
        if (wr == 0 && wc == 0) {
            unsigned spins = 0;
            while ((unsigned)__builtin_amdgcn_readfirstlane(__hip_atomic_load(flag, __ATOMIC_RELAXED, __HIP_MEMORY_SCOPE_AGENT)) == 0u) {
                __builtin_amdgcn_s_sleep(2);
                if (++spins > (1u << 22)) break;
            }
            __builtin_amdgcn_fence(__ATOMIC_ACQUIRE, "agent");
            asm volatile("s_waitcnt vmcnt(0)" ::: "memory");
        }
        __syncthreads();
#define KS_LOAD(t, g) _Pragma("unroll") for (int q = 0; q < 8; ++q) t[q] = *(const f32x4*)(sp + (size_t)(((g) * 8 + q) * 2048))
#define KS_ADD(t, g) do { _Pragma("unroll") for (int q = 0; q < 8; ++q) acc[(g) >> 1][(g) & 1][q >> 1][q & 1] += t[q]; \
            asm volatile("" : "+v"(sp), "+v"(acc[(g) >> 1][(g) & 1][0][0]), "+v"(acc[(g) >> 1][(g) & 1][0][1]), "+v"(acc[(g) >> 1][(g) & 1][1][0]), "+v"(acc[(g) >> 1][(g) & 1][1][1]), \
                         "+v"(acc[(g) >> 1][(g) & 1][2][0]), "+v"(acc[(g) >> 1][(g) & 1][2][1]), "+v"(acc[(g) >> 1][(g) & 1][3][0]), "+v"(acc[(g) >> 1][(g) & 1][3][1])); } while (0)
        {
            const float* sp = slab; asm volatile("" : "+v"(sp));
            f32x4 t0[8], t1[8];
            KS_LOAD(t0, 0); KS_LOAD(t1, 1);
            KS_ADD(t0, 0); KS_LOAD(t0, 2);
            KS_ADD(t1, 1); KS_LOAD(t1, 3);
            KS_ADD(t0, 2); KS_ADD(t1, 3);
        }
#undef KS_LOAD
#undef KS_ADD
        base(acc, u, wr, wc, fr, fq);
    }
};
constexpr int CW_PANEL = 16384;
struct EpiPle {
    static constexpr int MIDK = 0; static constexpr bool AFTER_DRAIN = true; static constexpr bool HAS_PRE = false;
    unsigned char* ws; float* xo; const float* wf;
    DI void fused(AccT& acc, const Unit& u, int wr, int wc, int fr, int fq) const {
        asm volatile("" : "+v"(fr), "+v"(fq));
        const float* SSQ = (const float*)(ws + WS_SSQ2); float* ssq = (float*)(ws + WS_SSQ3); const bf16_t* Eb = (const bf16_t*)(ws + WS_E); const bf16_t* X2 = (const bf16_t*)(ws + WS_XB);
        unsigned* cnt = (unsigned*)(ws + WS_CTL) + CW_PANEL + 64 * u.pm;
        const int row0 = u.pm * 256 + wr * 64 + fr, col0 = u.pn * 256 + wc * 32 + 8 * fq;
#pragma unroll
        for (int ai = 0; ai < 2; ++ai)
#pragma unroll
            for (int m = 0; m < 4; ++m) {
                const int row = row0 + ai * 128 + m * 16; float s = 0.f;
                const float r3 = row_rstd(SSQ, row, fq);
#pragma unroll
                for (int bj = 0; bj < 2; ++bj) {
                    const size_t o = (size_t)row * DM + col0 + bj * 128;
                    f32x4 e0, e1, v0, v1; unpack8(*(const u32x4*)(Eb + o), e0, e1); unpack8(*(const u32x4*)(X2 + o), v0, v1);
#pragma unroll
                    for (int c = 0; c < 4; ++c) { v0[c] += sigm(acc[ai][bj][m][0][c] * r3) * e0[c]; v1[c] += sigm(acc[ai][bj][m][1][c] * r3) * e1[c]; }
                    acc[ai][bj][m][0] = v0; acc[ai][bj][m][1] = v1;
                    s += ((v0.x * v0.x + v0.y * v0.y) + (v0.z * v0.z + v0.w * v0.w)) + ((v1.x * v1.x + v1.y * v1.y) + (v1.z * v1.z + v1.w * v1.w));
                }
                s += __shfl_xor(s, 16); s += __shfl_xor(s, 32);
                if (fq == 0) __hip_atomic_store((unsigned*)ssq + (size_t)row * 32 + u.pn * 4 + wc, __builtin_bit_cast(unsigned, s), __ATOMIC_RELAXED, __HIP_MEMORY_SCOPE_AGENT);
            }
        asm volatile("s_waitcnt vmcnt(0)" ::: "memory");
        if ((fr | fq) == 0) __hip_atomic_fetch_add(cnt, 1u, __ATOMIC_RELAXED, __HIP_MEMORY_SCOPE_AGENT);
        if (wr == 0 && wc == 0) {
            unsigned spins = 0;
            while ((unsigned)__builtin_amdgcn_readfirstlane(__hip_atomic_load(cnt, __ATOMIC_RELAXED, __HIP_MEMORY_SCOPE_AGENT)) < 64u) {
                __builtin_amdgcn_s_sleep(2);
                if (++spins > (1u << 22)) break;
            }
            __builtin_amdgcn_fence(__ATOMIC_ACQUIRE, "agent");
            asm volatile("s_waitcnt vmcnt(0)" ::: "memory");
        }
        __syncthreads();
        const f32x4 w00 = *(const f32x4*)(wf + col0), w01 = *(const f32x4*)(wf + col0 + 4), w10 = *(const f32x4*)(wf + col0 + 128), w11 = *(const f32x4*)(wf + col0 + 132);
#pragma unroll
        for (int ai = 0; ai < 2; ++ai)
#pragma unroll
            for (int m = 0; m < 4; ++m) {
                const int row = row0 + ai * 128 + m * 16;
                const float r4 = row_rstd(ssq, row, fq);
                const size_t o = (size_t)row * DM + col0;
                *(f32x4*)(xo + o) = acc[ai][0][m][0] * r4 * w00; *(f32x4*)(xo + o + 4) = acc[ai][0][m][1] * r4 * w01;
                *(f32x4*)(xo + o + 128) = acc[ai][1][m][0] * r4 * w10; *(f32x4*)(xo + o + 132) = acc[ai][1][m][1] * r4 * w11;
            }
    }
};

template <int W> DI void pool_item(const bf16_t* UP, bf16_t* DOB, int t0, int c0) {
    f32x4 ra[W + 7], rb[W + 7];
#pragma unroll
    for (int i = 0; i < W + 7; ++i) { const int t = t0 - (W - 1) + i; if (t >= 0) unpack8(*(const u32x4*)(UP + (size_t)t * DP + c0), ra[i], rb[i]); else { ra[i] = (f32x4){0.f, 0.f, 0.f, 0.f}; rb[i] = ra[i]; } }
    f32x4 sa = {0.f, 0.f, 0.f, 0.f}, sb = sa;
#pragma unroll
    for (int i = 0; i < W - 1; ++i) { sa += ra[i]; sb += rb[i]; }
#pragma unroll
    for (int j = 0; j < 8; ++j) {
        sa += ra[W - 1 + j]; sb += rb[W - 1 + j];
        const int t = t0 + j; const float inv = 1.f / (float)((t + 1 < W) ? t + 1 : W);
        *(u32x4*)(DOB + (size_t)t * DM + c0) = pack8(sa * inv - ra[W - 1 + j], sb * inv - rb[W - 1 + j]);
        sa -= ra[j]; sb -= rb[j];
    }
}
DI void pool_phase(Frame& F) {
    const bf16_t* UP = (const bf16_t*)(F.ws + WS_UP); bf16_t* DOB = (bf16_t*)(F.ws + WS_DOB);
    const int gt = F.vcu * 512 + F.tid, NGT = F.G * 512;
    for (int idx = gt; idx < (S / 8) * 128; idx += NGT) {
        const int t0 = (idx >> 7) * 8, c0 = (idx & 127) * 8, g = c0 >> 8;
        if (g == 0) pool_item<2>(UP, DOB, t0, c0); else if (g == 1) pool_item<4>(UP, DOB, t0, c0); else if (g == 2) pool_item<8>(UP, DOB, t0, c0); else pool_item<16>(UP, DOB, t0, c0);
    }
}

constexpr int TROW = 72;
constexpr int SROW = 136;
constexpr int H_VT = 0, H_KT = 18432, H_ST = 36864, H_QF = 71680, H_KF = 88064, H_NRM = 104448;
DI int ctile_off(int vt, int kt, int i, int lane) { return ((vt * 4 + kt) * 16 + i) * 64 + lane; }
DI int b63_off(int k) { return fq_off(1, k >> 4, 31 + 32 * ((k >> 3) & 1)) + (k & 7); }

struct HRegs { u32x4 v0, v1, q[2], k2[2]; f32x4 ea[2], eb[2]; float d0, d1; };
struct HCur { float d0, d1; };
template <bool WITH_Q>
DI void h_load_chunk(Frame& F, int uidx, HRegs& R) {
    const bf16_t* V = (const bf16_t*)(F.ws + WS_V); const bf16_t* K2 = (const bf16_t*)(F.ws + WS_KK); const bf16_t* Q = (const bf16_t*)(F.ws + WS_Q);
    const float* DL = (const float*)(F.ws + WS_DL);
    const int tid = F.tid, s = tid & 63, cg = F.wave;
    const int n = uidx >> 3, h = uidx & 7, t = 64 * n + s, col = h * 128 + 16 * cg;
    R.v0 = *(const u32x4*)(V + (size_t)t * DH + col); R.v1 = *(const u32x4*)(V + (size_t)t * DH + col + 8);
#pragma unroll
    for (int i = 0; i < 2; ++i) {
        const int f = tid + 512 * i, k0 = 16 * ((f >> 6) & 7) + 8 * ((f & 63) >> 5);
        R.k2[i] = *(const u32x4*)(K2 + (size_t)uidx * 8192 + f * 8);
        if (WITH_Q) R.q[i] = *(const u32x4*)(Q + (size_t)uidx * 8192 + f * 8);
        R.ea[i] = *(const f32x4*)(DL + (size_t)n * DH + h * 128 + k0); R.eb[i] = *(const f32x4*)(DL + (size_t)n * DH + h * 128 + k0 + 4);
    }
    { const int kt0 = 2 * (F.wave & 1), r = F.lane & 31; R.d0 = DL[(size_t)n * DH + h * 128 + 32 * kt0 + r]; R.d1 = DL[(size_t)n * DH + h * 128 + 32 * kt0 + 32 + r]; }
}
template <bool WITH_Q>
DI void h_stage_chunk(Frame& F, const HRegs& R, HCur& C) {
    C.d0 = R.d0; C.d1 = R.d1;
    LAS short* VT = (LAS short*)(F.lds + H_VT); LAS short* KT = (LAS short*)(F.lds + H_KT);
    const int tid = F.tid, s = tid & 63, cg = F.wave;
    const unsigned vw[8] = {R.v0.x, R.v0.y, R.v0.z, R.v0.w, R.v1.x, R.v1.y, R.v1.z, R.v1.w};
#pragma unroll
    for (int i = 0; i < 8; ++i) { VT[(16 * cg + 2 * i) * TROW + s] = (short)(vw[i] & 0xffffu); VT[(16 * cg + 2 * i + 1) * TROW + s] = (short)(vw[i] >> 16); }
#pragma unroll
    for (int i = 0; i < 2; ++i) {
        const int f = tid + 512 * i, ti = f >> 9, st = (f >> 6) & 7, lp = f & 63, ss = 32 * ti + (lp & 31), k0 = 16 * st + 8 * (lp >> 5);
        if (WITH_Q) { *(LAS u32x4*)(F.lds + H_QF + f * 16) = R.q[i]; *(LAS u32x4*)(F.lds + H_KF + f * 16) = R.k2[i]; }
        f32x4 ka, kb; unpack8(R.k2[i], ka, kb);
        const u32x4 kp = pack8(ka * R.ea[i], kb * R.eb[i]);
        const unsigned kw[4] = {kp.x, kp.y, kp.z, kp.w};
#pragma unroll
        for (int c = 0; c < 4; ++c) { KT[(k0 + 2 * c) * TROW + ss] = (short)(kw[c] & 0xffffu); KT[(k0 + 2 * c + 1) * TROW + ss] = (short)(kw[c] >> 16); }
    }
}
DI void h_state_update(Frame& F, const HCur& C, f32x16& s0, f32x16& s1) {
    const LAS short* VT = (const LAS short*)(F.lds + H_VT); const LAS short* KT = (const LAS short*)(F.lds + H_KT);
    const int vt = F.wave >> 1, kt0 = 2 * (F.wave & 1), r = F.lane & 31, hh = F.lane >> 5;
    const float d0 = C.d0, d1 = C.d1;
#pragma unroll
    for (int i = 0; i < 16; ++i) { s0[i] *= d0; s1[i] *= d1; }
#pragma unroll
    for (int st = 0; st < 4; ++st) {
        const int sx = 16 * st + 8 * hh;
        const bf16x8 af = *(const LAS bf16x8*)(VT + (32 * vt + r) * TROW + sx);
        const bf16x8 b0 = *(const LAS bf16x8*)(KT + (32 * kt0 + r) * TROW + sx), b1 = *(const LAS bf16x8*)(KT + (32 * (kt0 + 1) + r) * TROW + sx);
        s0 = __builtin_amdgcn_mfma_f32_32x32x16_bf16(af, b0, s0, 0, 0, 0);
        s1 = __builtin_amdgcn_mfma_f32_32x32x16_bf16(af, b1, s1, 0, 0, 0);
    }
}
DI void h1_phase(Frame& F) {
    float* LT = (float*)(F.ws + WS_LT);
    for (int ub = F.vcu; ub < (NCHUNK / 4) * 8; ub += F.G) {
        const int blk = ub >> 3, h = ub & 7;
        f32x16 s0, s1;
#pragma unroll
        for (int i = 0; i < 16; ++i) { s0[i] = 0.f; s1[i] = 0.f; }
        HRegs R; h_load_chunk<false>(F, (4 * blk) * 8 + h, R);
#pragma unroll 1
        for (int c = 0; c < 4; ++c) {
            const int uidx = (4 * blk + c) * 8 + h;
            __syncthreads();
            HCur C; h_stage_chunk<false>(F, R, C);
            if (c < 3) h_load_chunk<false>(F, uidx + 8, R);
            __syncthreads();
            h_state_update(F, C, s0, s1);
        }
        float* lt = LT + (size_t)ub * 16384; const int vt = F.wave >> 1, kt0 = 2 * (F.wave & 1);
#pragma unroll
        for (int i = 0; i < 16; ++i) { lt[ctile_off(vt, kt0, i, F.lane)] = s0[i]; lt[ctile_off(vt, kt0 + 1, i, F.lane)] = s1[i]; }
    }
    __syncthreads();
}
DI void h2_phase(Frame& F) {
    float* LT = (float*)(F.ws + WS_LT); const float* DL = (const float*)(F.ws + WS_DL);
    const int gt = F.vcu * 512 + F.tid, NGT = F.G * 512;
    for (int idx = gt; idx < 8 * 16384; idx += NGT) {
        const int h = idx >> 14, e = idx & 16383, k = 32 * ((e >> 10) & 3) + (e & 31);
        float st = 0.f;
        for (int b0 = 0; b0 < NCHUNK / 4; b0 += 4) {
            float L[4], d[4];
#pragma unroll
            for (int j = 0; j < 4; ++j) {
                L[j] = LT[(size_t)((b0 + j) * 8 + h) * 16384 + e];
                const float* dl = DL + (size_t)(4 * (b0 + j)) * DH + h * 128 + k;
                d[j] = (dl[0] * dl[DH]) * (dl[2 * DH] * dl[3 * DH]);
            }
#pragma unroll
            for (int j = 0; j < 4; ++j) { LT[(size_t)((b0 + j) * 8 + h) * 16384 + e] = st; st = d[j] * st + L[j]; }
        }
    }
}
DI void h3_phase(Frame& F) {
    const float* LT = (const float*)(F.ws + WS_LT); const bf16_t* SG = (const bf16_t*)(F.ws + WS_SG); bf16_t* DOB = (bf16_t*)(F.ws + WS_DOB); const float* NW = F.in[7];
    const int lane = F.lane, r = lane & 31, hh = lane >> 5;
    const LAS short* VT = (const LAS short*)(F.lds + H_VT); LAS short* ST = (LAS short*)(F.lds + H_ST); LAS float* NRM = (LAS float*)(F.lds + H_NRM);
    for (int ub = F.vcu; ub < (NCHUNK / 4) * 8; ub += F.G) {
        const int blk = ub >> 3, h = ub & 7, hc = h * 128;
        const int vts = F.wave >> 1, kt0 = 2 * (F.wave & 1);
        const int vto = F.wave & 3, ti = F.wave >> 2;
        f32x16 s0, s1;
        { const float* lt = LT + (size_t)ub * 16384;
#pragma unroll
          for (int i = 0; i < 16; ++i) { s0[i] = lt[ctile_off(vts, kt0, i, lane)]; s1[i] = lt[ctile_off(vts, kt0 + 1, i, lane)]; } }
        HRegs R; h_load_chunk<true>(F, (4 * blk) * 8 + h, R);
#pragma unroll 1
        for (int c = 0; c < 4; ++c) {
            const int uidx = (4 * blk + c) * 8 + h, t0 = 64 * (4 * blk + c);
            __syncthreads();
            HCur C; h_stage_chunk<true>(F, R, C);
            if (c < 3) h_load_chunk<true>(F, uidx + 8, R);
#pragma unroll
            for (int i = 0; i < 16; ++i) { const int v = 32 * vts + 8 * (i >> 2) + 4 * hh + (i & 3);
                ST[v * SROW + 32 * kt0 + r] = (short)(pk2(s0[i], 0.f) & 0xffffu); ST[v * SROW + 32 * kt0 + 32 + r] = (short)(pk2(s1[i], 0.f) & 0xffffu); }
            __syncthreads();
            f32x16 O;
            {
                bf16x8 qf[8];
#pragma unroll
                for (int st = 0; st < 8; ++st) qf[st] = *(const LAS bf16x8*)(F.lds + H_QF + ((ti * 8 + st) * 64 + lane) * 16);
                f32x16 X[2];
#pragma unroll
                for (int i = 0; i < 16; ++i) { X[0][i] = 0.f; X[1][i] = 0.f; O[i] = 0.f; }
#pragma unroll
                for (int sb = 0; sb < 2; ++sb) {
                    if (sb <= ti) {
#pragma unroll
                        for (int st = 0; st < 8; ++st)
                            X[sb] = __builtin_amdgcn_mfma_f32_32x32x16_bf16(*(const LAS bf16x8*)(F.lds + H_KF + ((sb * 8 + st) * 64 + lane) * 16), qf[st], X[sb], 0, 0, 0);
                    }
                }
#pragma unroll
                for (int i = 0; i < 16; ++i) { const int sl = 8 * (i >> 2) + 4 * hh + (i & 3); const bool keep = sl <= r;
                    if (ti == 0) X[0][i] = keep ? X[0][i] : 0.f; else X[1][i] = keep ? X[1][i] : 0.f; }
#pragma unroll
                for (int sb = 0; sb < 2; ++sb) {
                    if (sb <= ti) {
#pragma unroll
                        for (int sp = 0; sp < 2; ++sp) {
                            u32x4 xb; xb.x = pk2(X[sb][8 * sp + 0], X[sb][8 * sp + 1]); xb.y = pk2(X[sb][8 * sp + 2], X[sb][8 * sp + 3]); xb.z = pk2(X[sb][8 * sp + 4], X[sb][8 * sp + 5]); xb.w = pk2(X[sb][8 * sp + 6], X[sb][8 * sp + 7]);
                            const int sbase = 32 * sb + 16 * sp + 4 * hh;
                            const s16x4 lo = *(const LAS s16x4*)(VT + (32 * vto + r) * TROW + sbase), hi = *(const LAS s16x4*)(VT + (32 * vto + r) * TROW + sbase + 8);
                            O = __builtin_amdgcn_mfma_f32_32x32x16_bf16(__builtin_shufflevector(lo, hi, 0, 1, 2, 3, 4, 5, 6, 7), __builtin_bit_cast(bf16x8, xb), O, 0, 0, 0);
                        }
                    }
                }
#pragma unroll
                for (int st = 0; st < 8; ++st)
                    O = __builtin_amdgcn_mfma_f32_32x32x16_bf16(*(const LAS bf16x8*)(ST + (32 * vto + r) * SROW + 16 * st + 8 * hh), qf[st], O, 0, 0, 0);
            }
            { float ss = 0.f;
#pragma unroll
              for (int i = 0; i < 16; ++i) ss += O[i] * O[i];
              ss += __shfl_xor(ss, 32);
              if (hh == 0) NRM[(ti * 4 + vto) * 32 + r] = ss; }
            h_state_update(F, C, s0, s1);
            __syncthreads();
            {
                const float ssum = (NRM[(ti * 4 + 0) * 32 + r] + NRM[(ti * 4 + 1) * 32 + r]) + (NRM[(ti * 4 + 2) * 32 + r] + NRM[(ti * 4 + 3) * 32 + r]);
                const float rn = rsqrtf(ssum * (1.f / 128.f) + EPS);
                const int tq = t0 + 32 * ti + r;
#pragma unroll
                for (int g4 = 0; g4 < 4; ++g4) {
                    const int v0 = 32 * vto + 8 * g4 + 4 * hh;
                    const f32x4 nw = *(const f32x4*)(NW + hc + v0);
                    const u32x2 sg = *(const u32x2*)(SG + (size_t)tq * DH + hc + v0);
                    u32x2 w;
                    w.x = pk2(O[4 * g4 + 0] * rn * nw.x * bf_lo(sg.x), O[4 * g4 + 1] * rn * nw.y * bf_hi(sg.x));
                    w.y = pk2(O[4 * g4 + 2] * rn * nw.z * bf_lo(sg.y), O[4 * g4 + 3] * rn * nw.w * bf_hi(sg.y));
                    *(u32x2*)(DOB + (size_t)tq * DM + DP + hc + v0) = w;
                }
            }
        }
    }
    __syncthreads();
}
DI void fixup_panel(Frame& F, int pm) {
    const float* ZB = (const float*)(F.ws + WS_ZB); bf16_t* ACT = (bf16_t*)(F.ws + WS_ACT); const float* cw = F.in[13]; const float* cb = F.in[14];
    const f32x4 zero = {0.f, 0.f, 0.f, 0.f};
    for (int cg = F.tid; cg < DFF / 4; cg += NWAVES * 64) {
        const int c = 4 * cg, pg = 256 * (c >> 7) + (c & 127);
        f32x4 w0[2], w1[2], w2[2], bb[2];
#pragma unroll
        for (int hv = 0; hv < 2; ++hv) { const int oc = c + DFF * hv; w0[hv] = *(const f32x4*)(cw + oc); w1[hv] = *(const f32x4*)(cw + DFF2 + oc); w2[hv] = *(const f32x4*)(cw + 2 * DFF2 + oc); bb[hv] = *(const f32x4*)(cb + oc); }
#pragma unroll
        for (int bi = 0; bi < 4; ++bi) {
            const int b = 4 * pm + bi;
            f32x4 u0[2], u1[2];
#pragma unroll
            for (int hv = 0; hv < 2; ++hv) {
                const float* zb = ZB + (size_t)b * 4 * DFF2 + pg + 128 * hv;
                const f32x4 r0 = *(const f32x4*)zb, r1 = *(const f32x4*)(zb + DFF2);
                const f32x4 p2 = b > 0 ? *(const f32x4*)(zb - 2 * DFF2) : zero, p3 = b > 0 ? *(const f32x4*)(zb - DFF2) : zero;
                u0[hv] = bb[hv] + w2[hv] * r0 + w1[hv] * p3 + w0[hv] * p2;
                u1[hv] = bb[hv] + w2[hv] * r1 + w1[hv] * r0 + w0[hv] * p3;
            }
            u32x2 a, d;
            a.x = pk2(u0[0].x * sigm(u0[0].x) * u0[1].x, u0[0].y * sigm(u0[0].y) * u0[1].y); a.y = pk2(u0[0].z * sigm(u0[0].z) * u0[1].z, u0[0].w * sigm(u0[0].w) * u0[1].w);
            d.x = pk2(u1[0].x * sigm(u1[0].x) * u1[1].x, u1[0].y * sigm(u1[0].y) * u1[1].y); d.y = pk2(u1[0].z * sigm(u1[0].z) * u1[1].z, u1[0].w * sigm(u1[0].w) * u1[1].w);
            *(u32x2*)(ACT + (size_t)(64 * b) * DFF + c) = a;
            *(u32x2*)(ACT + (size_t)(64 * b + 1) * DFF + c) = d;
        }
    }
    asm volatile("s_waitcnt vmcnt(0)" ::: "memory");
    __syncthreads();
}
DI void final_phase(Frame& F) {
    const float* SSQ = (const float*)(F.ws + WS_SSQ3); const float* wf = F.in[19]; float* out = F.out;
    const int gw = F.vcu * NWAVES + F.wave, NGW = F.G * NWAVES;
    for (int m = gw; m < S; m += NGW) {
        float s = F.lane < 32 ? SSQ[(size_t)m * 32 + F.lane] : 0.f;
        s = wave_sum(s);
        const float rr = rsqrtf(s * (1.f / DM) + EPS);
        f32x4* xr = (f32x4*)(out + (size_t)m * DM) + F.lane; const f32x4* wr_ = (const f32x4*)wf + F.lane;
#pragma unroll
        for (int j = 0; j < 8; ++j) { const f32x4 v = xr[64 * j], w = wr_[64 * j]; xr[64 * j] = v * rr * w; }
    }
}

struct Args { const float* in[20]; float* out; unsigned char* ws; int ph_lo, ph_hi, li, pad; };
constexpr int NPHASE = 10;
#define WGM_G1 2
#define WGM_G5 2
#define WGM_SQ 2

#define REP_P0 1
#define REP_P1 1
#define REP_P2 1
#define REP_P4 1
#define REP_P5 1
#define REP_P6 1
#define REP_P7 1
#define REP_BAR 1
#define KS_NTP 18
#define TS_PHASE 99

__global__ void __launch_bounds__(NWAVES * 64, 2) mk_fwd(Args args) {
    extern __shared__ __attribute__((aligned(16))) unsigned char lds[];
    Frame F;
    F.lds = (LAS unsigned char*)lds;
    F.tid = threadIdx.x; F.lane = F.tid & 63; F.wave = __builtin_amdgcn_readfirstlane(F.tid >> 6);
    F.G = gridDim.x; { const int bx = blockIdx.x; F.vcu = (F.G % 8 == 0) ? (bx % 8) * (F.G / 8) + bx / 8 : bx; }
    F.ws = args.ws; F.out = args.out; F.in = args.in;
    volatile LAS unsigned* MISC = (volatile LAS unsigned*)(F.lds + MISC_OFF);
    for (int u = F.tid; u < (LDS_BYTES - LDSCTL_OFF) / 4; u += NWAVES * 64) ((LAS unsigned*)(F.lds + LDSCTL_OFF))[u] = 0u;
    __syncthreads();
    const bool multi = (args.ph_hi - args.ph_lo) > 1;
    XcdBarrier bar; bar.bar = (unsigned*)(args.ws + WS_CTL) + CW_BAR + args.li * XCD_BAR_WORDS; bar.x = 0; bar.st = nullptr;
    if (multi) bar = xcd_barrier_post(bar.bar, MISC + 8);
    const int lo = args.ph_lo, hi = args.ph_hi;
    if (TS_PHASE == 0 && blockIdx.x == 0 && F.tid == 0) MISC[16] = (unsigned)__builtin_amdgcn_s_memrealtime();
#define IN(k) (lo <= (k) && (k) < hi)
#define SEAM(k) do { if (IN(k) && IN((k) + 1)) xcd_barrier(bar); if (TS_PHASE != 99 && blockIdx.x == 0 && F.tid == 0) { const unsigned long long _t = __builtin_amdgcn_s_memrealtime(); if ((k) + 1 == TS_PHASE) MISC[16] = (unsigned)_t; if ((k) == TS_PHASE) MISC[17] = (unsigned)_t; } } while (0)
    unsigned char* ws = args.ws;
    const int bid = (int)blockIdx.x;

#define BODY_P1 {     \
        pg8::Gemm g{(const bf16_t*)(ws + WS_XB), (const bf16_t*)(ws + WS_WIN), DM, DM, DM}; pg8::StaticOrder So; So.init(S, DIN, F.G, bid, WGM_G1); \
        EpiProj E{ws, F.out}; \
        pg8::gemm_phase<EpiProj, true>(F.lds, g, So, E); \
        convert_rest(F); }
#define BODY_P5 {     \
        pg8::Gemm g{(const bf16_t*)(ws + WS_DOB), (const bf16_t*)(ws + WS_WAB), DM, DM, DM}; pg8::StaticOrder So; So.init(S, DM, F.G, bid, WGM_SQ); \
        EpiMerge E{(const bf16_t*)F.out, (const bf16_t*)F.out + (size_t)S * DM, (bf16_t*)(ws + WS_MG)}; \
        pg8::gemm_phase<EpiMerge, true>(F.lds, g, So, E); }
#define BODY_P6 {     \
        pg8::Gemm g{(const bf16_t*)(ws + WS_MG), (const bf16_t*)(ws + WS_WOUT), DM, DM, DM}; pg8::StaticOrder So; So.init(S, DM, F.G, bid, WGM_SQ); \
        EpiResB<true> E{(const void*)(ws + WS_XB), (bf16_t*)(ws + WS_XB), (float*)(ws + WS_SSQ1)}; \
        pg8::gemm_phase<EpiResB<true>, true>(F.lds, g, So, E); }
#define BODY_P7 {     \
        pg8::Gemm g{(const bf16_t*)(ws + WS_XB), (const bf16_t*)(ws + WS_WUP), DM, DM, DM}; pg8::StaticOrder So; So.init(S, DFF2, F.G, bid, WGM_G5); \
        pg8::SplitTail Ss; Ss.init(S, DFF2, F.G, bid, WGM_G5, DM / 64, KS_NTP); if (Ss.split) So.lim = Ss.full * F.G; \
        EpiUp E{ws, F.in[13], F.in[14], F.lds}; \
        pg8::gemm_phase<EpiUp, true>(F.lds, g, So, E); \
        { EpiUpKS Ek{E}; pg8::gemm_phase<EpiUpKS, true, pg8::SplitTail>(F.lds, g, Ss, Ek); } \
        {   \
          pg8::Gemm g2{(const bf16_t*)(ws + WS_PB), (const bf16_t*)(ws + WS_WPLE), PLE, PLE, PLE}; pg8::TailOrder2 St; St.init(S, DM, F.G, bid, Ss.rem, Ss.split); \
          EpiBf E2{(bf16_t*)(ws + WS_E), DM}; \
          pg8::gemm_phase<EpiBf, false, pg8::TailOrder2>(F.lds, g2, St, E2); } }

    if (IN(0)) { for (int rp = 0; rp <= args.pad; ++rp) p0_prologue(F); } SEAM(0);
    if (multi) for (int rb = 1; rb < REP_BAR; ++rb) xcd_barrier(bar);
    if (IN(1)) { BODY_P1 if (REP_P1 > 1) BODY_P1 } SEAM(1);
    if (IN(2)) { h1_phase(F); pool_phase(F); if (REP_P2 > 1) { h1_phase(F); pool_phase(F); } if (REP_P2 > 2) { h1_phase(F); pool_phase(F); } } SEAM(2);
    if (IN(3)) { h2_phase(F); } SEAM(3);
    if (IN(4)) { h3_phase(F); if (REP_P4 > 1) h3_phase(F); if (REP_P4 > 2) h3_phase(F); } SEAM(4);
    if (IN(5)) { BODY_P5 if (REP_P5 > 1) BODY_P5 } SEAM(5);
    if (IN(6)) { BODY_P6 if (REP_P6 > 1) BODY_P6 } SEAM(6);
    if (IN(7)) { BODY_P7 if (REP_P7 > 1) BODY_P7 } SEAM(7);
    if (IN(8)) {
        pg8::Gemm g{(const bf16_t*)(ws + WS_ACT), (const bf16_t*)(ws + WS_WDOWN), DFF, DFF, DFF}; pg8::StaticOrder So; So.init(S, DM, F.G, bid, WGM_SQ);
        { Unit u0; if (So.next(0, u0)) fixup_panel(F, u0.pm); }
        EpiResB<true> E{(const void*)(ws + WS_XB), (bf16_t*)(ws + WS_XB), (float*)(ws + WS_SSQ2)};
        pg8::gemm_phase<EpiResB<true>, true>(F.lds, g, So, E);
    } SEAM(8);
    if (IN(9)) {
        pg8::Gemm g{(const bf16_t*)(ws + WS_XB), (const bf16_t*)(ws + WS_WPG), DM, DM, DM}; pg8::StaticOrder So; So.init(S, DM, F.G, bid, WGM_SQ);
        EpiPle E{ws, F.out, F.in[19]};
        pg8::gemm_phase<EpiPle, true>(F.lds, g, So, E);
    }
    if (TS_PHASE != 99 && blockIdx.x == 0 && F.tid == 0) { const unsigned long long t1 = __builtin_amdgcn_s_memrealtime(); if (TS_PHASE == 9) MISC[17] = (unsigned)t1; unsigned span = MISC[17] - MISC[16]; if (span > 100000u) span = 100000u;
        while ((unsigned)(__builtin_amdgcn_s_memrealtime() - t1) < 2u * span) __builtin_amdgcn_s_sleep(8); }
#undef IN
#undef SEAM
}

#ifndef MK_N_LAUNCHES
#define MK_N_LAUNCHES 1
#endif
extern "C" void kernel_launch(void* const* d_in, const int* in_sizes, int n_in, void* d_out, int out_size, void* d_ws, size_t ws_size, hipStream_t stream) {
    static int grid = 0;
    if (grid == 0) {
        if (n_in != 20 || in_sizes[0] != S * DM || out_size != S * DM || ws_size < WS_END) { fprintf(stderr, "kernel_launch: unexpected shapes / workspace (%zu < %zu)\n", ws_size, (size_t)WS_END); grid = -1; return; }
        int dev = 0, cus = 0, per_cu = 0;
        if (hipGetDevice(&dev) != hipSuccess || hipDeviceGetAttribute(&cus, hipDeviceAttributeMultiprocessorCount, dev) != hipSuccess) { grid = -1; return; }
        if (hipFuncSetAttribute((const void*)mk_fwd, hipFuncAttributeMaxDynamicSharedMemorySize, LDS_BYTES) != hipSuccess) { fprintf(stderr, "kernel_launch: hipFuncSetAttribute failed\n"); grid = -1; return; }
        if (hipOccupancyMaxActiveBlocksPerMultiprocessor(&per_cu, (const void*)mk_fwd, NWAVES * 64, LDS_BYTES) != hipSuccess || per_cu < 1) { fprintf(stderr, "kernel_launch: occupancy query says %d\n", per_cu); per_cu = 1; }
        (void)hipGetLastError();
        grid = cus;
    }
    if (grid < 0) return;
    (void)hipMemsetAsync((char*)d_ws + WS_CTL, 0, CTL_ZERO_BYTES, stream);
    Args a{};
    for (int i = 0; i < 20; ++i) a.in[i] = (const float*)d_in[i];
    a.out = (float*)d_out; a.ws = (unsigned char*)d_ws; a.pad = REP_P0 - 1;
    if (MK_N_LAUNCHES == 1) {
        a.ph_lo = 0; a.ph_hi = NPHASE; a.li = 0;
        hipLaunchKernelGGL(mk_fwd, dim3(grid), dim3(NWAVES * 64), LDS_BYTES, stream, a);
    } else {
        for (int ph = 0; ph < NPHASE; ++ph) { a.ph_lo = ph; a.ph_hi = ph + 1; a.li = 0; hipLaunchKernelGGL(mk_fwd, dim3(grid), dim3(NWAVES * 64), LDS_BYTES, stream, a); }
    }
}
```

```cpp
#include <hip/hip_runtime.h>
#include <cstdio>
#include <cstdint>

#define LAS __attribute__((address_space(3)))
#define GAS __attribute__((address_space(1)))
typedef unsigned short bf16_t;
typedef short bf16x8 __attribute__((ext_vector_type(8)));
typedef short s16x4 __attribute__((ext_vector_type(4)));
typedef float f32x4 __attribute__((ext_vector_type(4)));
typedef float f32x2 __attribute__((ext_vector_type(2)));
typedef float f32x16 __attribute__((ext_vector_type(16)));
typedef unsigned u32x4 __attribute__((ext_vector_type(4)));
typedef unsigned u32x2 __attribute__((ext_vector_type(2)));
typedef __bf16 bf16v2 __attribute__((ext_vector_type(2)));
#define DI __device__ __forceinline__

constexpr int S = 8192, DM = 2048, DP = 1024, DH = 1024, DIN = 9216, DFF = 5504, DFF2 = 11008, PLE = 256, NCHUNK = 128;
constexpr float EPS = 1e-6f;

DI unsigned pk2(float lo, float hi) { f32x2 v = {lo, hi}; bf16v2 r = __builtin_convertvector(v, bf16v2); return __builtin_bit_cast(unsigned, r); }
DI float bf_lo(unsigned w) { return __builtin_bit_cast(float, w << 16); }
DI float bf_hi(unsigned w) { return __builtin_bit_cast(float, w & 0xffff0000u); }
DI float sigm(float v) { return __builtin_amdgcn_rcpf(1.0f + __expf(-v)); }
DI float wave_sum(float v) {
#pragma unroll
    for (int o = 1; o < 64; o <<= 1) v += __shfl_xor(v, o);
    return v;
}
template <int CTRL> DI float dppf(float v) { return __builtin_bit_cast(float, __builtin_amdgcn_update_dpp(0, __builtin_bit_cast(int, v), CTRL, 0xf, 0xf, true)); }
DI u32x4 pack8(f32x4 a, f32x4 b) { u32x4 w; w.x = pk2(a.x, a.y); w.y = pk2(a.z, a.w); w.z = pk2(b.x, b.y); w.w = pk2(b.z, b.w); return w; }
DI void unpack8(u32x4 w, f32x4& a, f32x4& b) { a.x = bf_lo(w.x); a.y = bf_hi(w.x); a.z = bf_lo(w.y); a.w = bf_hi(w.y); b.x = bf_lo(w.z); b.y = bf_hi(w.z); b.z = bf_lo(w.w); b.w = bf_hi(w.w); }

DI int fq_off(int ti, int st, int lanep) { return ((ti * 8 + st) * 64 + lanep) * 8; }

namespace pg8 {
constexpr int BM = 256, BK = 64, HALF = 128, HTB = HALF * BK * 2, STAGE_BYTES = 8 * HTB, NXCD = 8, WGM = 8;
__host__ __device__ __forceinline__ int lds_byte(int r, int c) { const int st = (r >> 4) * 2 + (c >> 5), rr = r & 15, cc = c & 31, ob = rr * 64 + cc * 2; return st * 1024 + (ob ^ (((ob >> 9) & 1) << 5)); }
__host__ __device__ __forceinline__ void stage_rc(int b, int& R, int& C) { const int st = b / 1024, sb = b % 1024, swz = sb ^ (((sb >> 9) & 1) << 5); R = (st >> 1) * 16 + swz / 64; C = (st & 1) * 32 + (swz % 64) / 2; }
__host__ __device__ __forceinline__ int perm32(int rho) { const int n = rho >> 4, i = rho & 15; return 8 * (i >> 2) + 4 * n + (i & 3); }

struct Unit { int pm, pn, ui, k0, ntu, kind, sl; };
struct Gemm { const bf16_t* A; const bf16_t* Bt; int lda, ldb, K; };

struct StaticOrder {
    static constexpr bool KSPLIT = false;
    int nM, nN, nwg, G, c, wgm, lim;
    DI void init(int M, int N, int G_, int c_, int wgm_ = WGM) { nM = M / BM; nN = N / BM; nwg = nM * nN; G = G_; c = c_; wgm = wgm_; lim = nwg; }
    DI bool next(int i, Unit& u) const { return at((long)i * G + c, u); }
    DI bool at(long L, Unit& u) const {
        if (L >= lim) return false;
        int wgid = (int)L; { const int q = nwg / NXCD, r = nwg % NXCD, xcd = wgid % NXCD, off = wgid / NXCD; wgid = (xcd < r ? xcd * (q + 1) : r * (q + 1) + (xcd - r) * q) + off; }
        const int nig = wgm * nN, gid = wgid / nig, fm = gid * wgm, gsz = (nM - fm) < wgm ? (nM - fm) : wgm;
        u.pm = fm + ((wgid % nig) % gsz); u.pn = (wgid % nig) / gsz; return true;
    }
};

struct SplitTail {
    static constexpr bool KSPLIT = true;
    StaticOrder so; int full, rem, nt, ntp; bool split;
    DI void init(int M, int N, int G_, int c_, int wgm_, int nt_, int ntp_) { so.init(M, N, G_, c_, wgm_); full = so.nwg / G_; rem = so.nwg % G_; split = rem > 0 && 2 * rem <= G_; nt = nt_; ntp = ntp_; }
    DI bool next(int i, Unit& u) const {
        if (!split || i != 0) return false;
        int c = so.c; u.k0 = 0; u.ntu = ntp; u.kind = 1;
        if (c >= rem) { if (c >= 2 * rem) return false; c -= rem; u.k0 = ntp; u.ntu = nt - ntp; u.kind = 2; }
        u.sl = c;
        return so.at((long)full * so.G + c, u);
    }
};
struct TailOrder2 {
    static constexpr bool KSPLIT = false;
    int nN, nE, c, idle0, I, a, sec0, nsec;
    DI void init(int M, int N, int G, int c_, int rem, bool split) { nN = N / BM; nE = (M / BM) * nN; c = c_; sec0 = rem; nsec = split ? rem : 0; idle0 = rem + nsec; I = G - idle0;
        a = I > 0 ? (nE + I - 1) / I : 0; if (split && a > 3) a = 3; }
    DI bool next(int i, Unit& u) const {
        int L;
        if (c >= idle0) { if (i >= a) return false; L = (c - idle0) + i * I; }
        else if (c >= sec0 && nsec > 0) { L = a * I + (c - sec0) + i * nsec; }
        else return false;
        if (L >= nE) return false;
        u.pm = L / nN; u.pn = L - u.pm * nN; return true;
    }
};
struct TailOrder {
    static constexpr bool KSPLIT = false;
    int nM, nN, nwg, G, c, c0;
    DI void init(int M, int N, int G_, int c_, int c0_) { nM = M / BM; nN = N / BM; nwg = nM * nN; G = G_; c = c_; c0 = c0_; }
    DI bool next(int i, Unit& u) const {
        if (c < c0) return false;
        const int L = (c - c0) + i * (G - c0); if (L >= nwg) return false;
        u.pm = L / nN; u.pn = L - u.pm * nN; return true;
    }
};
template <class Epi, bool ALIGN_EPI, class Sched = StaticOrder>
DI void gemm_phase(LAS unsigned char* lds, const Gemm g, const Sched& S, const Epi& E) {
    int tid_o = threadIdx.x; asm volatile("" : "+v"(tid_o));
    const int tid = tid_o, wid = __builtin_amdgcn_readfirstlane(tid >> 6), lane = tid & 63, wr = wid >> 2, wc = wid & 3, fr = lane & 15, fq = lane >> 4;
    const int K = g.K, nt = K / BK;
    unsigned voffA[2], voffB[2];
#pragma unroll
    for (int i = 0; i < 2; ++i) { int R, C; stage_rc(tid * 16 + i * 8192, R, C); const int Rb = (R & ~31) + perm32(R & 31);
        voffA[i] = (unsigned)(R * g.lda + C) * 2u; voffB[i] = (unsigned)(Rb * g.ldb + C) * 2u; }
    const size_t kstep = (size_t)(BK * 2);
    const size_t hstepA = (size_t)HALF * g.lda * 2, hstepB = (size_t)HALF * g.ldb * 2;
    const size_t tstepA = 2 * hstepA, tstepB = 2 * hstepB;
    const unsigned ldsw = (unsigned)wid * 1024u;
    const int aoff = lds_byte(wr * 64 + fr, fq * 8), boff = lds_byte(wc * 32 + fr, fq * 8);
#define PG8_SA(b, h) (((b) * 2 + (h)) * HTB)
#define PG8_SB(b, h) ((4 + (b) * 2 + (h)) * HTB)
#define PG8_STAGE(bufoff, gbase, voff) do { _Pragma("unroll") for (int _i = 0; _i < 2; ++_i) \
        __builtin_amdgcn_global_load_lds((const unsigned*)((const char*)(gbase) + (voff)[_i]), (LAS unsigned*)(lds + (bufoff) + ldsw + _i * 8192), 16, 0, 0); } while (0)
#define PG8_LDA(dst, b, h) do { _Pragma("unroll") for (int m = 0; m < 4; ++m) _Pragma("unroll") for (int k = 0; k < 2; ++k) dst[m][k] = *(const LAS bf16x8*)(lds + PG8_SA(b, h) + aoff + m * 2048 + k * 1024); } while (0)
#define PG8_LDB(dst, b, h) do { _Pragma("unroll") for (int n = 0; n < 2; ++n) _Pragma("unroll") for (int k = 0; k < 2; ++k) dst[n][k] = *(const LAS bf16x8*)(lds + PG8_SB(b, h) + boff + n * 2048 + k * 1024); } while (0)
#define PG8_MMA(ai, bj, At, Bt) do { __builtin_amdgcn_s_setprio(1); _Pragma("unroll") for (int m = 0; m < 4; ++m) _Pragma("unroll") for (int n = 0; n < 2; ++n) _Pragma("unroll") for (int k = 0; k < 2; ++k) \
        acc[ai][bj][m][n] = __builtin_amdgcn_mfma_f32_16x16x32_bf16(Bt[n][k], At[m][k], acc[ai][bj][m][n], 0, 0, 0); __builtin_amdgcn_s_setprio(0); } while (0)
#define PG8_WAIT_V(n) asm volatile("s_waitcnt vmcnt(" #n ")" ::: "memory")
#define PG8_WAIT_L(n) asm volatile("s_waitcnt lgkmcnt(" #n ")" ::: "memory")
#define PG8_BAR __builtin_amdgcn_s_barrier()
#define PG8_SCHED __builtin_amdgcn_sched_barrier(0)
    Unit cur, nxt; int ui = 0;
    if (!S.next(0, cur)) return;
    cur.ui = 0;
    if constexpr (Epi::HAS_PRE) E.pre(lds, cur, wid, lane);
    f32x4 acc[2][2][4][2];
#pragma unroll
    for (int a = 0; a < 2; ++a)
#pragma unroll
        for (int b = 0; b < 2; ++b)
#pragma unroll
            for (int m = 0; m < 4; ++m)
#pragma unroll
                for (int n = 0; n < 2; ++n) acc[a][b][m][n] = (f32x4){0.f, 0.f, 0.f, 0.f};
    bf16x8 At[4][2], B0[2][2], B1[2][2];
    const char* cA = (const char*)g.A + (size_t)cur.pm * tstepA; const char* cB = (const char*)g.Bt + (size_t)cur.pn * tstepB;
    if constexpr (Sched::KSPLIT) { cA += (size_t)cur.k0 * kstep; cB += (size_t)cur.k0 * kstep; }
    PG8_STAGE(PG8_SB(0, 0), cB, voffB); PG8_STAGE(PG8_SB(0, 1), cB + hstepB, voffB); PG8_STAGE(PG8_SA(0, 0), cA, voffA); PG8_STAGE(PG8_SA(0, 1), cA + hstepA, voffA);
    if (wr == 1) PG8_BAR;
    PG8_WAIT_V(2); PG8_BAR;
    PG8_STAGE(PG8_SB(1, 0), cB + kstep, voffB); PG8_STAGE(PG8_SA(1, 0), cA + kstep, voffA); PG8_STAGE(PG8_SB(1, 1), cB + hstepB + kstep, voffB);
    PG8_WAIT_V(6); PG8_BAR;
    for (;;) {
        const bool has_next = S.next(ui + 1, nxt);
        const char* nA = has_next ? (const char*)g.A + (size_t)nxt.pm * tstepA : cA; const char* nB = has_next ? (const char*)g.Bt + (size_t)nxt.pn * tstepB : cB;
        if constexpr (Sched::KSPLIT) { if (has_next) { nA += (size_t)nxt.k0 * kstep; nB += (size_t)nxt.k0 * kstep; } }
        const int ntc = Sched::KSPLIT ? cur.ntu : nt;
        for (int t = 0; t < ntc; t += 2) {
            const bool last = (t == ntc - 2);
            const char* a1 = cA + (size_t)(t + 1) * kstep;
            const char* a2 = last ? nA : cA + (size_t)(t + 2) * kstep; const char* b2 = last ? nB : cB + (size_t)(t + 2) * kstep;
            const char* a3 = a2 + kstep; const char* b3 = b2 + kstep;
            if constexpr (Epi::MIDK != 0) { if (t == Epi::MIDK) E.mid(acc, cur, wr, wc, fr, fq); }
            PG8_LDB(B0, 0, 0); PG8_LDB(B1, 0, 1); PG8_SCHED; PG8_LDA(At, 0, 0); PG8_STAGE(PG8_SA(1, 1), a1 + hstepA, voffA);
            PG8_WAIT_V(8); PG8_WAIT_L(0); PG8_BAR; PG8_MMA(0, 0, At, B0); PG8_MMA(0, 1, At, B1); PG8_BAR; PG8_SCHED;
            PG8_LDA(At, 0, 1); PG8_STAGE(PG8_SB(0, 0), b2, voffB); PG8_STAGE(PG8_SB(0, 1), b2 + hstepB, voffB); PG8_STAGE(PG8_SA(0, 0), a2, voffA);
            PG8_WAIT_V(8); PG8_WAIT_L(0); PG8_BAR; PG8_MMA(1, 0, At, B0); PG8_MMA(1, 1, At, B1); PG8_BAR; PG8_SCHED;
            PG8_LDB(B0, 1, 0); PG8_LDB(B1, 1, 1); PG8_SCHED; PG8_LDA(At, 1, 0); PG8_STAGE(PG8_SA(0, 1), a2 + hstepA, voffA);
            PG8_WAIT_V(8); PG8_WAIT_L(0); PG8_BAR; PG8_MMA(0, 0, At, B0); PG8_MMA(0, 1, At, B1); PG8_BAR; PG8_SCHED;
            PG8_LDA(At, 1, 1); PG8_STAGE(PG8_SB(1, 0), b3, voffB); PG8_STAGE(PG8_SB(1, 1), b3 + hstepB, voffB); PG8_STAGE(PG8_SA(1, 0), a3, voffA);
            PG8_WAIT_V(8); PG8_WAIT_L(0); PG8_BAR; PG8_MMA(1, 0, At, B0); PG8_MMA(1, 1, At, B1); PG8_BAR; PG8_SCHED;
        }
        if constexpr (ALIGN_EPI) { if (wr == 0) PG8_BAR; }
        if constexpr (!Epi::AFTER_DRAIN) E(acc, cur, wr, wc, fr, fq);
        if (!has_next) break;
#pragma unroll
        for (int a = 0; a < 2; ++a)
#pragma unroll
            for (int b = 0; b < 2; ++b)
#pragma unroll
                for (int m = 0; m < 4; ++m)
#pragma unroll
                    for (int n = 0; n < 2; ++n) acc[a][b][m][n] = (f32x4){0.f, 0.f, 0.f, 0.f};
        cur = nxt; cA = nA; cB = nB; ++ui; cur.ui = ui;
        if constexpr (Epi::HAS_PRE) E.pre(lds, cur, wid, lane);
        if constexpr (ALIGN_EPI) { if (wr == 1) PG8_BAR; }
    }
    PG8_WAIT_V(0);
    if constexpr (!ALIGN_EPI) { if (wr == 0) PG8_BAR; }
    PG8_BAR;
    if constexpr (Epi::AFTER_DRAIN) E.fused(acc, cur, wr, wc, fr, fq);
#undef PG8_SA
#undef PG8_SB
#undef PG8_STAGE
#undef PG8_LDA
#undef PG8_LDB
#undef PG8_MMA
#undef PG8_WAIT_V
#undef PG8_WAIT_L
#undef PG8_BAR
#undef PG8_SCHED
}
}
using pg8::Unit;
typedef f32x4 AccT[2][2][4][2];

constexpr size_t MiB = 1u << 20;
constexpr size_t WS_CTL = 0, CTL_ZERO_BYTES = 1 * MiB;
constexpr size_t WS_R1 = 1 * MiB, WS_LB = WS_R1 + 65536;
constexpr size_t WS_SSQ1 = 2 * MiB, WS_SSQ2 = 3 * MiB, WS_SSQ3 = 4 * MiB;
constexpr size_t WS_WAB = 6 * MiB, WS_WOUT = 14 * MiB, WS_WPG = 22 * MiB, WS_WPLE = 30 * MiB, WS_WDOWN = 31 * MiB, WS_WUP = 53 * MiB, WS_WIN = 96 * MiB;
constexpr size_t WS_XB = 132 * MiB;
constexpr size_t WS_UP = 164 * MiB, WS_Q = 180 * MiB, WS_KK = 196 * MiB, WS_V = 212 * MiB, WS_SG = 228 * MiB;
constexpr size_t WS_KP = 244 * MiB, WS_DL = 260 * MiB;
constexpr size_t WS_BC = 244 * MiB;
constexpr size_t WS_DOB = 276 * MiB;
constexpr size_t WS_PB = 308 * MiB;
constexpr size_t WS_ZB = 312 * MiB;
constexpr size_t WS_END = 344 * MiB;
constexpr size_t WS_LT = 96 * MiB;
constexpr size_t WS_TMP = 164 * MiB;
constexpr size_t WS_MG = 244 * MiB;
constexpr size_t WS_STB = 312 * MiB;
constexpr size_t WS_E = 96 * MiB;
constexpr size_t WS_ACT = 164 * MiB;
static_assert(WS_WUP + (size_t)DFF2 * DM * 2 <= WS_WIN && WS_WIN + (size_t)DIN * DM * 2 <= WS_XB && WS_LT + (size_t)256 * 16384 * 4 <= WS_XB, "ws map");
static_assert(WS_ACT + (size_t)S * DFF * 2 <= WS_DOB && WS_ZB + (size_t)128 * 4 * DFF2 * 4 <= WS_END, "ws map 2");

constexpr int CW_BAR = 4096;
constexpr int CW_KS = 24576;
constexpr size_t WS_SLAB = WS_DOB;
constexpr int RING_BYTES = 131072, LDSCTL_OFF = RING_BYTES, MISC_OFF = LDSCTL_OFF + 320, LDS_BYTES = 147456;
constexpr int NWAVES = 8;

typedef GAS unsigned gu32;
#define RLX_AGENT __ATOMIC_RELAXED, __HIP_MEMORY_SCOPE_AGENT
#define LDS_WAIT() asm volatile("s_waitcnt lgkmcnt(0)" ::: "memory")

#define XB_TMO      128
#define XB_XCNT(j)  (256  + 64 * (j))
#define XB_XSUB(j)  (1280 + 64 * (j))
#define XB_XGEN(j)  (2304 + 64 * (j))
#define XB_TOP      3328
#define XB_TOPGEN   3392
#define XCD_BAR_WORDS 3456
#define XB_SPIN_CAP (1u << 22)
DI unsigned xb_ld(unsigned* p)              { return __hip_atomic_load(p, __ATOMIC_RELAXED, __HIP_MEMORY_SCOPE_AGENT); }
DI unsigned xb_add(unsigned* p, unsigned v) { return __hip_atomic_fetch_add(p, v, __ATOMIC_RELAXED, __HIP_MEMORY_SCOPE_AGENT); }
DI unsigned xb_xcc_id() { return (unsigned)__builtin_amdgcn_s_getreg((3 << 11) | 20) & 0xFu; }
#define XB_SPIN(cond, bar) do { unsigned _sp = 0; while (cond) { __builtin_amdgcn_s_sleep(1); \
    if ((++_sp & 255u) == 0u) { if (xb_ld(&(bar)[XB_TMO])) break; if (_sp > XB_SPIN_CAP) { atomicAdd(&(bar)[XB_TMO], 1u); break; } } } } while (0)
struct XcdBarrier { unsigned* bar; unsigned x; volatile LAS unsigned* st; };
DI XcdBarrier xcd_barrier_post(unsigned* bar, volatile LAS unsigned* st) {
    XcdBarrier b; b.bar = bar; b.x = xb_xcc_id(); b.st = st;
    if (threadIdx.x == 0) (void)xb_add(&bar[XB_XCNT(b.x)], 1u);
    return b;
}
DI void xcd_barrier_complete(unsigned* bar, unsigned x, unsigned& nloc, unsigned& nx) {
    const unsigned G = gridDim.x * gridDim.y * gridDim.z;
    unsigned sum, cnt, mine, sp = 0u;
    for (;;) {
        sum = 0u; cnt = 0u; mine = 0u;
#pragma unroll
        for (unsigned j = 0; j < 16; ++j) { const unsigned c = xb_ld(&bar[XB_XCNT(j)]); sum += c; cnt += (c > 0u) ? 1u : 0u; mine = (j == x) ? c : mine; }
        if (sum == G) break;
        __builtin_amdgcn_s_sleep(1);
        if ((++sp & 255u) == 0u) { if (xb_ld(&bar[XB_TMO])) break; if (sp > XB_SPIN_CAP) { atomicAdd(&bar[XB_TMO], 1u); break; } }
    }
    nloc = mine > 0u ? mine : 1u; nx = cnt > 0u ? cnt : 1u;
}
DI void xcd_barrier(const XcdBarrier& b) {
    asm volatile("s_waitcnt vmcnt(0)" ::: "memory");
    __syncthreads();
    if (threadIdx.x == 0) {
        unsigned* bar = b.bar;
        __builtin_amdgcn_s_waitcnt(0);
        unsigned nloc = b.st[0], nx = b.st[1];
        if (nloc == 0u) { xcd_barrier_complete(bar, b.x, nloc, nx); b.st[0] = nloc; b.st[1] = nx; }
        const unsigned old = xb_add(&bar[XB_XSUB(b.x)], 1u);
        const unsigned gen = old / nloc;
        if (old + 1u == (gen + 1u) * nloc) {
            __builtin_amdgcn_fence(__ATOMIC_RELEASE, "agent");
            asm volatile("s_waitcnt vmcnt(0)" ::: "memory");
            const unsigned og = xb_add(&bar[XB_TOP], 1u);
            const unsigned tg = og / nx;
            if (og + 1u == (tg + 1u) * nx) xb_add(&bar[XB_TOPGEN], 1u);
            else XB_SPIN(xb_ld(&bar[XB_TOPGEN]) == tg, bar);
            __builtin_amdgcn_fence(__ATOMIC_ACQUIRE, "agent");
            xb_add(&bar[XB_XGEN(b.x)], 1u);
            asm volatile("s_waitcnt vmcnt(0)" ::: "memory");
        } else {
            XB_SPIN(xb_ld(&bar[XB_XGEN(b.x)]) == gen, bar);
            __builtin_amdgcn_fence(__ATOMIC_ACQUIRE, "agent");
            asm volatile("s_waitcnt vmcnt(0)" ::: "memory");
        }
    }
    __syncthreads();
}

struct Frame {
    LAS unsigned char* lds;
    int tid, lane, wave, vcu, G;
    unsigned char* ws;
    const float* const* in;
    float* out;
};

struct TJob { const float* W; const float* ks; bf16_t* out; int K, N, ldo, coff, upmap, ntile; };
constexpr int TRS = 260;
DI void tr_load(const TJob& J, int tile, int wave, int lane, f32x4 (&v)[8]) {
    const int nb = J.N >> 8, kb = tile / nb, n0 = (tile - kb * nb) << 8, k0 = kb << 6;
    const float* src = J.W + (size_t)(k0 + 8 * wave) * J.N + n0 + 4 * lane;
#pragma unroll
    for (int i = 0; i < 8; ++i) v[i] = *(const f32x4*)(src + (size_t)i * J.N);
    if (J.ks) {
#pragma unroll
        for (int i = 0; i < 8; ++i) v[i] = v[i] * J.ks[k0 + 8 * wave + i];
    }
}
DI void tr_to_lds(LAS unsigned* P, int wave, int lane, const f32x4 (&v)[8]) {
#pragma unroll
    for (int i = 0; i < 4; ++i) {
        u32x4 w; w.x = pk2(v[2 * i].x, v[2 * i + 1].x); w.y = pk2(v[2 * i].y, v[2 * i + 1].y); w.z = pk2(v[2 * i].z, v[2 * i + 1].z); w.w = pk2(v[2 * i].w, v[2 * i + 1].w);
        *(LAS u32x4*)(P + (4 * wave + i) * TRS + 4 * lane) = w;
    }
}
DI void tr_store(const TJob& J, int tile, LAS const unsigned* P, int wave, int lane) {
    const int nb = J.N >> 8, kb = tile / nb, n0 = (tile - kb * nb) << 8, k0 = kb << 6;
    const int c = lane & 7;
#pragma unroll
    for (int jj = 0; jj < 4; ++jj) {
        const int nl = 32 * wave + 8 * jj + (lane >> 3), n = n0 + nl;
        u32x4 w; w.x = P[(4 * c + 0) * TRS + nl]; w.y = P[(4 * c + 1) * TRS + nl]; w.z = P[(4 * c + 2) * TRS + nl]; w.w = P[(4 * c + 3) * TRS + nl];
        int orow = n;
        if (J.upmap == 1) { const int b128 = n >> 7, half = b128 >= 43 ? 1 : 0; orow = 256 * (b128 - 43 * half) + 128 * half + (n & 127); }
        if (J.upmap == 2 && n >= DP && n < DP + 4 * DH) {
            const int sec = (n - DP) >> 10, c = (n - DP) & 1023, t = c >> 6, cc = c & 63;
            orow = DP + 256 * t + 128 * (sec >> 1) + 8 * (cc >> 2) + 4 * (sec & 1) + (cc & 3); }
        if (J.upmap == 2 && n >= DP + 4 * DH) {
            const int g = n - (DP + 4 * DH), half = g >= DM ? 1 : 0, ch = g - half * DM; orow = DP + 4 * DH + 256 * (ch >> 7) + 128 * half + (ch & 127); }
        *(u32x4*)(J.out + (size_t)orow * J.ldo + J.coff + k0 + 8 * c) = w;
    }
}
constexpr int TJ_NT[7] = {(DM / 64) * (DIN / 256), (DM / 64) * (DFF2 / 256), (DFF / 64) * (DM / 256), (DH / 64) * (DM / 256), (DM / 64) * (DM / 256), (DM / 64) * (DM / 256), (PLE / 64) * (DM / 256)};
constexpr int TJ_B1 = TJ_NT[0], TJ_B2 = TJ_B1 + TJ_NT[1], TJ_B3 = TJ_B2 + TJ_NT[2], TJ_B4 = TJ_B3 + TJ_NT[3], TJ_B5 = TJ_B4 + TJ_NT[4], TJ_B6 = TJ_B5 + TJ_NT[5], TJ_TOTAL = TJ_B6 + TJ_NT[6];
DI TJob tr_job(const Frame& F, int g, int& tile) {
    unsigned char* ws = F.ws; TJob J;
    if (g < TJ_B1)      { J = TJob{F.in[3],  F.in[2],  (bf16_t*)(ws + WS_WIN),   DM,  DIN,  DM,  0,  2, 0}; tile = g; }
    else if (g < TJ_B2) { J = TJob{F.in[12], F.in[11], (bf16_t*)(ws + WS_WUP),   DM,  DFF2, DM,  0,  1, 0}; tile = g - TJ_B1; }
    else if (g < TJ_B3) { J = TJob{F.in[15], nullptr,  (bf16_t*)(ws + WS_WDOWN), DFF, DM,   DFF, 0,  0, 0}; tile = g - TJ_B2; }
    else if (g < TJ_B4) { J = TJob{F.in[9],  nullptr,  (bf16_t*)(ws + WS_WAB),   DH,  DM,   DM,  DP, 0, 0}; tile = g - TJ_B3; }
    else if (g < TJ_B5) { J = TJob{F.in[10], nullptr,  (bf16_t*)(ws + WS_WOUT),  DM,  DM,   DM,  0,  0, 0}; tile = g - TJ_B4; }
    else if (g < TJ_B6) { J = TJob{F.in[17], F.in[16], (bf16_t*)(ws + WS_WPG),   DM,  DM,   DM,  0,  0, 0}; tile = g - TJ_B5; }
    else                { J = TJob{F.in[18], nullptr,  (bf16_t*)(ws + WS_WPLE),  PLE, DM,   PLE, 0,  0, 0}; tile = g - TJ_B6; }
    return J;
}
DI void p0_transpose_win(Frame& F) {
    LAS unsigned* P = (LAS unsigned*)F.lds;
    f32x4 v[8];
    int g = F.vcu, tile = 0;
    bool have = g < TJ_B1;
    TJob Jc{}, Jn{}; int tc = 0;
    if (have) { Jn = tr_job(F, g, tile); tr_load(Jn, tile, F.wave, F.lane, v); }
    while (have) {
        tr_to_lds(P, F.wave, F.lane, v);
        __syncthreads();
        Jc = Jn; tc = tile;
        g += F.G; have = g < TJ_B1;
        if (have) { Jn = tr_job(F, g, tile); tr_load(Jn, tile, F.wave, F.lane, v); }
        tr_store(Jc, tc, P, F.wave, F.lane);
        __syncthreads();
    }
}
DI void p0_fold_wa(Frame& F, const float* wmix, const float* scale, const float* wa, bf16_t* WAB, int tile) {
    const int g = tile >> 6, c0 = 64 * ((tile >> 4) & 3), n0 = 128 * (tile & 15);
    const int ci = F.wave & 1, ni = F.wave >> 1, r = F.lane & 31, kh = F.lane >> 5;
    const float* arow = wmix + ((size_t)g * 256 + c0 + 32 * ci + r) * 256;
    const float* bcol = wa + (size_t)(g * 256) * DM + n0 + 32 * ni + r;
    const float* sc = scale + g * 256;
    f32x16 acc;
#pragma unroll
    for (int i = 0; i < 16; ++i) acc[i] = 0.f;
#pragma unroll 1
    for (int q0 = 0; q0 < 64; q0 += 8) {
        f32x4 av[8]; float bv[16];
#pragma unroll
        for (int i = 0; i < 8; ++i) av[i] = *(const f32x4*)(arow + 4 * (q0 + i));
#pragma unroll
        for (int j = 0; j < 16; ++j) { const int d = 4 * q0 + 2 * j + kh; bv[j] = sc[d] * bcol[(size_t)d * DM]; }
#pragma unroll
        for (int i = 0; i < 8; ++i) {
            acc = __builtin_amdgcn_mfma_f32_32x32x2f32(kh ? av[i].y : av[i].x, bv[2 * i], acc, 0, 0, 0);
            acc = __builtin_amdgcn_mfma_f32_32x32x2f32(kh ? av[i].w : av[i].z, bv[2 * i + 1], acc, 0, 0, 0);
        }
    }
    bf16_t* orow = WAB + (size_t)(n0 + 32 * ni + r) * DM + g * 256 + c0 + 32 * ci + 4 * kh;
#pragma unroll
    for (int i4 = 0; i4 < 4; ++i4) { u32x2 w; w.x = pk2(acc[4 * i4], acc[4 * i4 + 1]); w.y = pk2(acc[4 * i4 + 2], acc[4 * i4 + 3]); *(u32x2*)(orow + 8 * i4) = w; }
}

DI void p0_prologue(Frame& F) {
    unsigned char* ws = F.ws;
    const int gw = F.vcu * NWAVES + F.wave, NGW = F.G * NWAVES;
    {
        const float* x = F.in[0]; bf16_t* XB = (bf16_t*)(ws + WS_XB); float* R1 = (float*)(ws + WS_R1);
        for (int m = gw; m < S; m += NGW) {
            const f32x4* xr = (const f32x4*)(x + (size_t)m * DM) + F.lane;
            f32x4 v[8]; float s = 0.f;
#pragma unroll
            for (int j = 0; j < 8; ++j) { v[j] = xr[64 * j]; s += (v[j].x * v[j].x + v[j].y * v[j].y) + (v[j].z * v[j].z + v[j].w * v[j].w); }
            s = wave_sum(s);
            if (F.lane == 0) R1[m] = rsqrtf(s * (1.f / DM) + EPS);
            u32x2* o = (u32x2*)(XB + (size_t)m * DM) + F.lane;
#pragma unroll
            for (int j = 0; j < 8; ++j) { u32x2 w; w.x = pk2(v[j].x, v[j].y); w.y = pk2(v[j].z, v[j].w); o[64 * j] = w; }
        }
    }
    {
        const f32x4* p = (const f32x4*)F.in[1]; u32x2* PB = (u32x2*)(ws + WS_PB);
        const int gt = F.vcu * 512 + F.tid, NGT = F.G * 512;
        for (int i = gt; i < S * PLE / 4; i += NGT) { const f32x4 v = p[i]; u32x2 w; w.x = pk2(v.x, v.y); w.y = pk2(v.z, v.w); PB[i] = w; }
        float* LB = (float*)(ws + WS_LB); const float* lbl = F.in[6];
        if (gt < DH) { const float l0 = lbl[gt], l1 = lbl[DH + gt], mx = fmaxf(l0, l1), e0 = __expf(l0 - mx), e1 = __expf(l1 - mx); LB[gt] = e0 / (e0 + e1); }
    }
    p0_transpose_win(F);
}
constexpr int CW_QUEUE = 20480;
DI void convert_rest(Frame& F) {
    unsigned* head = (unsigned*)(F.ws + WS_CTL) + CW_QUEUE;
    volatile LAS unsigned* slot = (volatile LAS unsigned*)(F.lds + MISC_OFF) + 20;
    LAS unsigned* P = (LAS unsigned*)F.lds;
    constexpr int NFOLD = 256, NITEM = NFOLD + (TJ_TOTAL - TJ_B1);
    for (;;) {
        __syncthreads();
        if (F.tid == 0) slot[0] = __hip_atomic_fetch_add(head, 1u, __ATOMIC_RELAXED, __HIP_MEMORY_SCOPE_AGENT);
        __syncthreads();
        const int item = (int)__builtin_amdgcn_readfirstlane(slot[0]);
        if (item >= NITEM) break;
        if (item < NFOLD) { p0_fold_wa(F, F.in[4], F.in[5], F.in[8], (bf16_t*)(F.ws + WS_WAB), item); }
        else {
            int tile = 0; const TJob J = tr_job(F, TJ_B1 + item - NFOLD, tile);
            f32x4 v[8];
            tr_load(J, tile, F.wave, F.lane, v);
            tr_to_lds(P, F.wave, F.lane, v);
            __syncthreads();
            tr_store(J, tile, P, F.wave, F.lane);
        }
    }
}


DI float row_rstd(const float* ssq, int row, int fq) {
    const f32x4* p = (const f32x4*)(ssq + (size_t)row * 32 + fq * 8);
    const f32x4 a = p[0], b = p[1];
    float s = ((a.x + a.y) + (a.z + a.w)) + ((b.x + b.y) + (b.z + b.w));
    s += __shfl_xor(s, 16); s += __shfl_xor(s, 32);
    return rsqrtf(s * (1.f / DM) + EPS);
}

DI void row_rstd8(const float* ssq, int row0, int fq, float (&r)[2][4]) {
    f32x4 a[2][4], b[2][4];
#pragma unroll
    for (int ai = 0; ai < 2; ++ai)
#pragma unroll
        for (int m = 0; m < 4; ++m) { const f32x4* p = (const f32x4*)(ssq + (size_t)(row0 + ai * 128 + m * 16) * 32 + fq * 8); a[ai][m] = p[0]; b[ai][m] = p[1]; }
#pragma unroll
    for (int ai = 0; ai < 2; ++ai)
#pragma unroll
        for (int m = 0; m < 4; ++m) {
            float s = ((a[ai][m].x + a[ai][m].y) + (a[ai][m].z + a[ai][m].w)) + ((b[ai][m].x + b[ai][m].y) + (b[ai][m].z + b[ai][m].w));
            s += __shfl_xor(s, 16); s += __shfl_xor(s, 32);
            r[ai][m] = rsqrtf(s * (1.f / DM) + EPS);
        }
}
DI void lds_read4x16(unsigned addr, f32x4& a, f32x4& b, f32x4& c, f32x4& d) {
    asm volatile("ds_read_b128 %0, %4\n\tds_read_b128 %1, %4 offset:1024\n\tds_read_b128 %2, %4 offset:2048\n\tds_read_b128 %3, %4 offset:3072\n\ts_waitcnt lgkmcnt(0)"
                 : "=&v"(a), "=&v"(b), "=&v"(c), "=&v"(d) : "v"(addr) : "memory");
}

struct EpiProj {
    static constexpr int MIDK = 0; static constexpr bool AFTER_DRAIN = false; static constexpr bool HAS_PRE = false;
    unsigned char* ws; float* dout;
    DI void operator()(const AccT& acc, const Unit& u, int wr, int wc, int fr, int fq) const {
        asm volatile("" : "+v"(fr), "+v"(fq));
        const float* R1 = (const float*)(ws + WS_R1);
        const int pn = u.pn, row0 = u.pm * 256 + wr * 64 + fr, cl = wc * 32 + 8 * fq;
        float rs[2][4];
#pragma unroll
        for (int ai = 0; ai < 2; ++ai)
#pragma unroll
            for (int m = 0; m < 4; ++m) rs[ai][m] = R1[row0 + ai * 128 + m * 16];
        if (pn >= 4 && pn < 20) {
            const float* LB = (const float*)(ws + WS_LB); bf16_t* Qp = (bf16_t*)(ws + WS_Q); bf16_t* K2 = (bf16_t*)(ws + WS_KK);
            bf16_t* Vo = (bf16_t*)(ws + WS_V); bf16_t* SGo = (bf16_t*)(ws + WS_SG); float* DL = (float*)(ws + WS_DL);
            const int t = pn - 4, hd = t >> 1, k4 = 64 * (t & 1) + 16 * wc + 4 * fq;
            const int lane = fq * 16 + fr, bsel = ((lane & ~15) | 15) << 2;
            const f32x4 lb = *(const f32x4*)(LB + hd * 128 + k4);
#pragma unroll
            for (int ai = 0; ai < 2; ++ai) {
                f32x4 lf[4], kk[4];
#pragma unroll
                for (int m = 0; m < 4; ++m)
#pragma unroll
                    for (int c = 0; c < 4; ++c) { const float v = acc[ai][0][m][1][c] * rs[ai][m]; const float sg = sigm(v); const float f = lb[c] + (1.f - lb[c]) * sg;
                        lf[m][c] = __logf(f); kk[m][c] = (1.f - lb[c]) * (1.f - sg); }
                f32x4 b63;
#pragma unroll
                for (int c = 0; c < 4; ++c) {
                    float carry = 0.f;
#pragma unroll
                    for (int m = 0; m < 4; ++m) {
                        float x = lf[m][c];
                        x += dppf<0x111>(x); x += dppf<0x112>(x); x += dppf<0x114>(x); x += dppf<0x118>(x);
                        const float tot = __builtin_bit_cast(float, __builtin_amdgcn_ds_bpermute(bsel, __builtin_bit_cast(int, x)));
                        lf[m][c] = x + carry; carry += tot;
                    }
                    b63[c] = carry;
                }
                const int chunk = 4 * u.pm + 2 * ai + wr;
                if (fr == 0) { f32x4 e63; e63.x = __expf(b63.x); e63.y = __expf(b63.y); e63.z = __expf(b63.z); e63.w = __expf(b63.w); *(f32x4*)(DL + (size_t)chunk * DH + hd * 128 + k4) = e63; }
#pragma unroll
                for (int m = 0; m < 4; ++m) {
                    const size_t of = (size_t)(chunk * 8 + hd) * 8192 + fq_off(m >> 1, 4 * (t & 1) + wc, 16 * (m & 1) + fr + 32 * (fq >> 1)) + 4 * (fq & 1);
                    const size_t orow = (size_t)(row0 + ai * 128 + m * 16) * DH + hd * 128 + k4;
                    f32x4 qp, k2, vv, sgv;
#pragma unroll
                    for (int c = 0; c < 4; ++c) {
                        const float ex = __expf(lf[m][c]);
                        qp[c] = acc[ai][0][m][0][c] * rs[ai][m] * ex; k2[c] = kk[m][c] * __builtin_amdgcn_rcpf(ex);
                        vv[c] = acc[ai][1][m][0][c] * rs[ai][m]; const float g = acc[ai][1][m][1][c] * rs[ai][m]; sgv[c] = g * sigm(g);
                    }
                    u32x2 w;
                    w.x = pk2(qp.x, qp.y); w.y = pk2(qp.z, qp.w); *(u32x2*)(Qp + of) = w;
                    w.x = pk2(k2.x, k2.y); w.y = pk2(k2.z, k2.w); *(u32x2*)(K2 + of) = w;
                    w.x = pk2(vv.x, vv.y); w.y = pk2(vv.z, vv.w); *(u32x2*)(Vo + orow) = w;
                    w.x = pk2(sgv.x, sgv.y); w.y = pk2(sgv.z, sgv.w); *(u32x2*)(SGo + orow) = w;
                }
            }
        } else if (pn >= 20) {
            bf16_t* RT = (bf16_t*)dout; bf16_t* GBo = (bf16_t*)dout + (size_t)S * DM;
            const int ch0 = 128 * (pn - 20) + cl;
#pragma unroll
            for (int ai = 0; ai < 2; ++ai)
#pragma unroll
                for (int m = 0; m < 4; ++m) {
                    const size_t o = (size_t)(row0 + ai * 128 + m * 16) * DM + ch0;
                    f32x4 r0, r1, g0, g1;
#pragma unroll
                    for (int c = 0; c < 4; ++c) {
                        const float ea0 = __expf(-__builtin_amdgcn_fmed3f(acc[ai][0][m][0][c] * rs[ai][m], -60.f, 60.f)), eb0 = __expf(-__builtin_amdgcn_fmed3f(acc[ai][1][m][0][c] * rs[ai][m], -60.f, 60.f));
                        const float ea1 = __expf(-__builtin_amdgcn_fmed3f(acc[ai][0][m][1][c] * rs[ai][m], -60.f, 60.f)), eb1 = __expf(-__builtin_amdgcn_fmed3f(acc[ai][1][m][1][c] * rs[ai][m], -60.f, 60.f));
                        r0[c] = (1.0f + eb0) * __builtin_amdgcn_rcpf(1.0f + ea0); g0[c] = __builtin_amdgcn_rcpf(1.0f + eb0);
                        r1[c] = (1.0f + eb1) * __builtin_amdgcn_rcpf(1.0f + ea1); g1[c] = __builtin_amdgcn_rcpf(1.0f + eb1);
                    }
                    *(u32x4*)(RT + o) = pack8(r0, r1); *(u32x4*)(GBo + o) = pack8(g0, g1);
                }
        } else {
        bf16_t* O = (bf16_t*)(ws + WS_UP);
#pragma unroll
        for (int ai = 0; ai < 2; ++ai)
#pragma unroll
            for (int m = 0; m < 4; ++m) {
                bf16_t* rowp = O + (size_t)(row0 + ai * 128 + m * 16) * DP + pn * 256 + cl;
#pragma unroll
                for (int bj = 0; bj < 2; ++bj) *(u32x4*)(rowp + bj * 128) = pack8(acc[ai][bj][m][0] * rs[ai][m], acc[ai][bj][m][1] * rs[ai][m]);
            }
        }
        asm volatile("" :: "v"(rs[0][0]), "v"(rs[0][1]), "v"(rs[0][2]), "v"(rs[0][3]), "v"(rs[1][0]), "v"(rs[1][1]), "v"(rs[1][2]), "v"(rs[1][3]));
    }
};

struct EpiBf {
    static constexpr int MIDK = 0; static constexpr bool AFTER_DRAIN = false; static constexpr bool HAS_PRE = false;
    bf16_t* O; int ld;
    DI void operator()(const AccT& acc, const Unit& u, int wr, int wc, int fr, int fq) const {
        asm volatile("" : "+v"(fr), "+v"(fq));
        const int row0 = u.pm * 256 + wr * 64 + fr, col0 = u.pn * 256 + wc * 32 + 8 * fq;
#pragma unroll
        for (int ai = 0; ai < 2; ++ai)
#pragma unroll
            for (int m = 0; m < 4; ++m)
#pragma unroll
                for (int bj = 0; bj < 2; ++bj) *(u32x4*)(O + (size_t)(row0 + ai * 128 + m * 16) * ld + col0 + bj * 128) = pack8(acc[ai][bj][m][0], acc[ai][bj][m][1]);
    }
};
template <int MODE> struct EpiGate {
    static constexpr int MIDK = 0; static constexpr bool AFTER_DRAIN = false; static constexpr bool HAS_PRE = false;
    const bf16_t* G; float* TMP; bf16_t* MG;
    DI void operator()(const AccT& acc, const Unit& u, int wr, int wc, int fr, int fq) const {
        asm volatile("" : "+v"(fr), "+v"(fq));
        const int row0 = u.pm * 256 + wr * 64 + fr, col0 = u.pn * 256 + wc * 32 + 8 * fq;
#pragma unroll
        for (int ai = 0; ai < 2; ++ai)
#pragma unroll
            for (int m = 0; m < 4; ++m)
#pragma unroll
                for (int bj = 0; bj < 2; ++bj) {
                    const size_t o = (size_t)(row0 + ai * 128 + m * 16) * DM + col0 + bj * 128;
                    f32x4 g0, g1; unpack8(*(const u32x4*)(G + o), g0, g1);
                    f32x4 v0 = acc[ai][bj][m][0] * g0, v1 = acc[ai][bj][m][1] * g1;
                    if (MODE == 0) { *(f32x4*)(TMP + o) = v0; *(f32x4*)(TMP + o + 4) = v1; }
                    else { v0 += *(const f32x4*)(TMP + o); v1 += *(const f32x4*)(TMP + o + 4); *(u32x4*)(MG + o) = pack8(v0, v1); }
                }
    }
};
struct EpiMerge {
    static constexpr int MIDK = 16; static constexpr bool AFTER_DRAIN = false; static constexpr bool HAS_PRE = false;
    const bf16_t* GA; const bf16_t* GB; bf16_t* MG;
    DI void mid(AccT& acc, const Unit& u, int wr, int wc, int fr, int fq) const {
        asm volatile("" : "+v"(fr), "+v"(fq));
        const int row0 = u.pm * 256 + wr * 64 + fr, col0 = u.pn * 256 + wc * 32 + 8 * fq;
#pragma unroll
        for (int ai = 0; ai < 2; ++ai)
#pragma unroll
            for (int m = 0; m < 4; ++m)
#pragma unroll
                for (int bj = 0; bj < 2; ++bj) {
                    const size_t o = (size_t)(row0 + ai * 128 + m * 16) * DM + col0 + bj * 128;
                    f32x4 a0, a1; unpack8(*(const u32x4*)(GA + o), a0, a1);
                    acc[ai][bj][m][0] = acc[ai][bj][m][0] * a0; acc[ai][bj][m][1] = acc[ai][bj][m][1] * a1;
                }
    }
    DI void operator()(const AccT& acc, const Unit& u, int wr, int wc, int fr, int fq) const {
        asm volatile("" : "+v"(fr), "+v"(fq));
        const int row0 = u.pm * 256 + wr * 64 + fr, col0 = u.pn * 256 + wc * 32 + 8 * fq;
#pragma unroll
        for (int ai = 0; ai < 2; ++ai)
#pragma unroll
            for (int m = 0; m < 4; ++m)
#pragma unroll
                for (int bj = 0; bj < 2; ++bj) {
                    const size_t o = (size_t)(row0 + ai * 128 + m * 16) * DM + col0 + bj * 128;
                    f32x4 b0, b1; unpack8(*(const u32x4*)(GB + o), b0, b1);
                    *(u32x4*)(MG + o) = pack8(acc[ai][bj][m][0] * b0, acc[ai][bj][m][1] * b1);
                }
    }
};
template <bool BF> struct EpiResB {
    static constexpr int MIDK = 0; static constexpr bool AFTER_DRAIN = false; static constexpr bool HAS_PRE = false;
    const void* base; bf16_t* xb; float* ssq;
    DI void operator()(const AccT& acc, const Unit& u, int wr, int wc, int fr, int fq) const {
        asm volatile("" : "+v"(fr), "+v"(fq));
        const int row0 = u.pm * 256 + wr * 64 + fr, col0 = u.pn * 256 + wc * 32 + 8 * fq;
#pragma unroll
        for (int ai = 0; ai < 2; ++ai)
#pragma unroll
            for (int m = 0; m < 4; ++m) {
                const int row = row0 + ai * 128 + m * 16; float s = 0.f;
#pragma unroll
                for (int bj = 0; bj < 2; ++bj) {
                    const size_t o = (size_t)row * DM + col0 + bj * 128;
                    f32x4 x0, x1;
                    if (BF) unpack8(*(const u32x4*)((const bf16_t*)base + o), x0, x1);
                    else { x0 = *(const f32x4*)((const float*)base + o); x1 = *(const f32x4*)((const float*)base + o + 4); }
                    const f32x4 v0 = acc[ai][bj][m][0] + x0, v1 = acc[ai][bj][m][1] + x1;
                    *(u32x4*)(xb + o) = pack8(v0, v1);
                    s += ((v0.x * v0.x + v0.y * v0.y) + (v0.z * v0.z + v0.w * v0.w)) + ((v1.x * v1.x + v1.y * v1.y) + (v1.z * v1.z + v1.w * v1.w));
                }
                s += __shfl_xor(s, 16); s += __shfl_xor(s, 32);
                if (fq == 0) ssq[(size_t)row * 32 + u.pn * 4 + wc] = s;
            }
    }
};
struct EpiRes {
    static constexpr int MIDK = 0; static constexpr bool AFTER_DRAIN = false; static constexpr bool HAS_PRE = false;
    const float* base; float* xo; bf16_t* xb; float* ssq;
    DI void operator()(const AccT& acc, const Unit& u, int wr, int wc, int fr, int fq) const {
        asm volatile("" : "+v"(fr), "+v"(fq));
        const int row0 = u.pm * 256 + wr * 64 + fr, col0 = u.pn * 256 + wc * 32 + 8 * fq;
#pragma unroll
        for (int ai = 0; ai < 2; ++ai)
#pragma unroll
            for (int m = 0; m < 4; ++m) {
                const int row = row0 + ai * 128 + m * 16; float s = 0.f;
#pragma unroll
                for (int bj = 0; bj < 2; ++bj) {
                    const size_t o = (size_t)row * DM + col0 + bj * 128;
                    const f32x4 v0 = acc[ai][bj][m][0] + *(const f32x4*)(base + o), v1 = acc[ai][bj][m][1] + *(const f32x4*)(base + o + 4);
                    *(f32x4*)(xo + o) = v0; *(f32x4*)(xo + o + 4) = v1; *(u32x4*)(xb + o) = pack8(v0, v1);
                    s += ((v0.x * v0.x + v0.y * v0.y) + (v0.z * v0.z + v0.w * v0.w)) + ((v1.x * v1.x + v1.y * v1.y) + (v1.z * v1.z + v1.w * v1.w));
                }
                s += __shfl_xor(s, 16); s += __shfl_xor(s, 32);
                if (fq == 0) ssq[(size_t)row * 32 + u.pn * 4 + wc] = s;
            }
    }
};
constexpr int CONV_LDS = 131584;
struct EpiUp {
    static constexpr int MIDK = 0; static constexpr bool AFTER_DRAIN = false; static constexpr bool HAS_PRE = true;
    unsigned char* ws; const float* cw; const float* cb; LAS unsigned char* lds;
    DI void pre(LAS unsigned char* l, const Unit& u, int wid, int lane) const {
        if (wid < 4) {
            const int col = (lane < 32) ? 128 * u.pn + 4 * lane : DFF + 128 * u.pn + 4 * (lane - 32);
            const float* src = (wid < 3 ? cw + (size_t)wid * DFF2 : cb) + col;
            __builtin_amdgcn_global_load_lds((const unsigned*)src, (LAS unsigned*)(l + CONV_LDS + (u.ui & 1) * 4096 + wid * 1024), 16, 0, 0);
        }
    }
    DI void operator()(const AccT& acc, const Unit& u, int wr, int wc, int fr, int fq) const {
        asm volatile("" : "+v"(fr), "+v"(fq));
        const float* SSQ = (const float*)(ws + WS_SSQ1); bf16_t* ACT = (bf16_t*)(ws + WS_ACT); float* ZB = (float*)(ws + WS_ZB);
        const int row0 = u.pm * 256 + wr * 64 + fr, j = u.pn;
#pragma unroll
        for (int ai = 0; ai < 2; ++ai) {
            float r2[4];
#pragma unroll
            for (int m = 0; m < 4; ++m) r2[m] = row_rstd(SSQ, row0 + ai * 128 + m * 16, fq);
            const int blk = 4 * u.pm + 2 * ai + wr;
#pragma unroll
            for (int n = 0; n < 2; ++n) {
                int fq2 = fq; asm volatile("" : "+v"(fq2));
                const int ch = 128 * j + 32 * wc + 8 * fq2 + 4 * n;
                const int pc = 256 * j + 32 * wc + 8 * fq2 + 4 * n;
                const unsigned cbase = (unsigned)(size_t)(lds + CONV_LDS + (u.ui & 1) * 4096) + (unsigned)(32 * wc + 8 * fq2) * 4u;
                float* zb = ZB + (size_t)blk * 4 * DFF2 + pc;
                if (fr < 2) { *(f32x4*)(zb + (size_t)fr * DFF2) = acc[ai][0][0][n] * r2[0]; *(f32x4*)(zb + (size_t)fr * DFF2 + 128) = acc[ai][1][0][n] * r2[0]; }
                if (fr >= 14) { *(f32x4*)(zb + (size_t)(fr - 12) * DFF2) = acc[ai][0][3][n] * r2[3]; *(f32x4*)(zb + (size_t)(fr - 12) * DFF2 + 128) = acc[ai][1][3][n] * r2[3]; }
                f32x4 uv[4];
                {
                    f32x4 w0, w1, w2, bb; lds_read4x16(cbase + (128 + 4 * n) * 4u, w0, w1, w2, bb);
#pragma unroll
                    for (int m = 0; m < 4; ++m) {
                        const f32x4 zc = acc[ai][1][m][n] * r2[m], zp = acc[ai][1][m > 0 ? m - 1 : 0][n] * r2[m > 0 ? m - 1 : 0];
#pragma unroll
                        for (int c = 0; c < 4; ++c) {
                            const float s1 = (m > 0 && fr == 15) ? zp[c] : zc[c], s2 = (m > 0 && fr >= 14) ? zp[c] : zc[c];
                            uv[m][c] = bb[c] + w2[c] * zc[c] + w1[c] * dppf<0x121>(s1) + w0[c] * dppf<0x122>(s2);
                        }
                    }
                }
                {
                    f32x4 w0, w1, w2, bb; lds_read4x16(cbase + (4 * n) * 4u, w0, w1, w2, bb);
#pragma unroll
                    for (int m = 0; m < 4; ++m) {
                        const f32x4 zc = acc[ai][0][m][n] * r2[m], zp = acc[ai][0][m > 0 ? m - 1 : 0][n] * r2[m > 0 ? m - 1 : 0];
                        f32x4 ug;
#pragma unroll
                        for (int c = 0; c < 4; ++c) {
                            const float s1 = (m > 0 && fr == 15) ? zp[c] : zc[c], s2 = (m > 0 && fr >= 14) ? zp[c] : zc[c];
                            ug[c] = bb[c] + w2[c] * zc[c] + w1[c] * dppf<0x121>(s1) + w0[c] * dppf<0x122>(s2);
                        }
                        if (m > 0 || fr >= 2) {
                            u32x2 w; w.x = pk2(ug.x * sigm(ug.x) * uv[m].x, ug.y * sigm(ug.y) * uv[m].y); w.y = pk2(ug.z * sigm(ug.z) * uv[m].z, ug.w * sigm(ug.w) * uv[m].w);
                            *(u32x2*)(ACT + (size_t)(row0 + ai * 128 + m * 16) * DFF + ch) = w;
                        }
                    }
                }
                __builtin_amdgcn_sched_barrier(0);
            }
        }
    }
};
struct EpiUpKS {
    static constexpr int MIDK = 0; static constexpr bool AFTER_DRAIN = true; static constexpr bool HAS_PRE = true;
    EpiUp base;
    DI void pre(LAS unsigned char* l, const Unit& u, int wid, int lane) const {
        base.pre(l, u, wid, lane);
        if (u.kind == 1 && wid == 0 && lane == 0) __hip_atomic_store((unsigned*)(base.ws + WS_CTL) + CW_KS + 64 * u.sl + 1, 1u + xb_xcc_id(), __ATOMIC_RELAXED, __HIP_MEMORY_SCOPE_AGENT);
    }
    DI void fused(AccT& acc, const Unit& u, int wr, int wc, int fr, int fq) const {
        int f0 = fr, f1 = fq; asm volatile("" : "+v"(f0), "+v"(f1));
        float* slab = (float*)(base.ws + WS_SLAB) + (size_t)u.sl * 65536 + (size_t)(((wr * 4 + wc) * 64 + f1 * 16 + f0) * 4);
        unsigned* flag = (unsigned*)(base.ws + WS_CTL) + CW_KS + 64 * u.sl;
        if (u.kind == 2) {
#pragma unroll
            for (int a = 0; a < 2; ++a)
#pragma unroll
                for (int b = 0; b < 2; ++b)
#pragma unroll
                    for (int m = 0; m < 4; ++m)
#pragma unroll
                        for (int n = 0; n < 2; ++n) *(f32x4*)(slab + (size_t)((((a * 2 + b) * 4 + m) * 2 + n) * 2048)) = acc[a][b][m][n];
            asm volatile("s_waitcnt vmcnt(0)" ::: "memory");
            __syncthreads();
            if (wr == 0 && wc == 0 && (f0 | f1) == 0) {
                const bool same_l2 = __hip_atomic_load(flag + 1, __ATOMIC_RELAXED, __HIP_MEMORY_SCOPE_AGENT) == 1u + xb_xcc_id();
                if (!same_l2) __builtin_amdgcn_fence(__ATOMIC_RELEASE, "agent");
                __hip_atomic_store(flag, 1u, __ATOMIC_RELAXED, __HIP_MEMORY_SCOPE_AGENT);
            }
            return;
        }
        if (wr == 0 && wc == 0) {
            unsigned spins = 0;
            while ((unsigned)__builtin_amdgcn_readfirstlane(__hip_atomic_load(flag, __ATOMIC_RELAXED, __HIP_MEMORY_SCOPE_AGENT)) == 0u) {
                __builtin_amdgcn_s_sleep(2);
                if (++spins > (1u << 22)) break;
            }
            __builtin_amdgcn_fence(__ATOMIC_ACQUIRE, "agent");
            asm volatile("s_waitcnt vmcnt(0)" ::: "memory");
        }
        __syncthreads();
#define KS_LOAD(t, g) _Pragma("unroll") for (int q = 0; q < 8; ++q) t[q] = *(const f32x4*)(sp + (size_t)(((g) * 8 + q) * 2048))
#define KS_ADD(t, g) do { _Pragma("unroll") for (int q = 0; q < 8; ++q) acc[(g) >> 1][(g) & 1][q >> 1][q & 1] += t[q]; \
            asm volatile("" : "+v"(sp), "+v"(acc[(g) >> 1][(g) & 1][0][0]), "+v"(acc[(g) >> 1][(g) & 1][0][1]), "+v"(acc[(g) >> 1][(g) & 1][1][0]), "+v"(acc[(g) >> 1][(g) & 1][1][1]), \
                         "+v"(acc[(g) >> 1][(g) & 1][2][0]), "+v"(acc[(g) >> 1][(g) & 1][2][1]), "+v"(acc[(g) >> 1][(g) & 1][3][0]), "+v"(acc[(g) >> 1][(g) & 1][3][1])); } while (0)
        {
            const float* sp = slab; asm volatile("" : "+v"(sp));
            f32x4 t0[8], t1[8];
            KS_LOAD(t0, 0); KS_LOAD(t1, 1);
            KS_ADD(t0, 0); KS_LOAD(t0, 2);
            KS_ADD(t1, 1); KS_LOAD(t1, 3);
            KS_ADD(t0, 2); KS_ADD(t1, 3);
        }
#undef KS_LOAD
#undef KS_ADD
        base(acc, u, wr, wc, fr, fq);
    }
};
constexpr int CW_PANEL = 16384;
struct EpiPle {
    static constexpr int MIDK = 0; static constexpr bool AFTER_DRAIN = true; static constexpr bool HAS_PRE = false;
    unsigned char* ws; float* xo; const float* wf;
    DI void fused(AccT& acc, const Unit& u, int wr, int wc, int fr, int fq) const {
        asm volatile("" : "+v"(fr), "+v"(fq));
        const float* SSQ = (const float*)(ws + WS_SSQ2); float* ssq = (float*)(ws + WS_SSQ3); const bf16_t* Eb = (const bf16_t*)(ws + WS_E); const bf16_t* X2 = (const bf16_t*)(ws + WS_XB);
        unsigned* cnt = (unsigned*)(ws + WS_CTL) + CW_PANEL + 64 * u.pm;
        const int row0 = u.pm * 256 + wr * 64 + fr, col0 = u.pn * 256 + wc * 32 + 8 * fq;
#pragma unroll
        for (int ai = 0; ai < 2; ++ai)
#pragma unroll
            for (int m = 0; m < 4; ++m) {
                const int row = row0 + ai * 128 + m * 16; float s = 0.f;
                const float r3 = row_rstd(SSQ, row, fq);
#pragma unroll
                for (int bj = 0; bj < 2; ++bj) {
                    const size_t o = (size_t)row * DM + col0 + bj * 128;
                    f32x4 e0, e1, v0, v1; unpack8(*(const u32x4*)(Eb + o), e0, e1); unpack8(*(const u32x4*)(X2 + o), v0, v1);
#pragma unroll
                    for (int c = 0; c < 4; ++c) { v0[c] += sigm(acc[ai][bj][m][0][c] * r3) * e0[c]; v1[c] += sigm(acc[ai][bj][m][1][c] * r3) * e1[c]; }
                    acc[ai][bj][m][0] = v0; acc[ai][bj][m][1] = v1;
                    s += ((v0.x * v0.x + v0.y * v0.y) + (v0.z * v0.z + v0.w * v0.w)) + ((v1.x * v1.x + v1.y * v1.y) + (v1.z * v1.z + v1.w * v1.w));
                }
                s += __shfl_xor(s, 16); s += __shfl_xor(s, 32);
                if (fq == 0) __hip_atomic_store((unsigned*)ssq + (size_t)row * 32 + u.pn * 4 + wc, __builtin_bit_cast(unsigned, s), __ATOMIC_RELAXED, __HIP_MEMORY_SCOPE_AGENT);
            }
        asm volatile("s_waitcnt vmcnt(0)" ::: "memory");
        if ((fr | fq) == 0) __hip_atomic_fetch_add(cnt, 1u, __ATOMIC_RELAXED, __HIP_MEMORY_SCOPE_AGENT);
        if (wr == 0 && wc == 0) {
            unsigned spins = 0;
            while ((unsigned)__builtin_amdgcn_readfirstlane(__hip_atomic_load(cnt, __ATOMIC_RELAXED, __HIP_MEMORY_SCOPE_AGENT)) < 64u) {
                __builtin_amdgcn_s_sleep(2);
                if (++spins > (1u << 22)) break;
            }
            __builtin_amdgcn_fence(__ATOMIC_ACQUIRE, "agent");
            asm volatile("s_waitcnt vmcnt(0)" ::: "memory");
        }
        __syncthreads();
        const f32x4 w00 = *(const f32x4*)(wf + col0), w01 = *(const f32x4*)(wf + col0 + 4), w10 = *(const f32x4*)(wf + col0 + 128), w11 = *(const f32x4*)(wf + col0 + 132);
#pragma unroll
        for (int ai = 0; ai < 2; ++ai)
#pragma unroll
            for (int m = 0; m < 4; ++m) {
                const int row = row0 + ai * 128 + m * 16;
                const float r4 = row_rstd(ssq, row, fq);
                const size_t o = (size_t)row * DM + col0;
                *(f32x4*)(xo + o) = acc[ai][0][m][0] * r4 * w00; *(f32x4*)(xo + o + 4) = acc[ai][0][m][1] * r4 * w01;
                *(f32x4*)(xo + o + 128) = acc[ai][1][m][0] * r4 * w10; *(f32x4*)(xo + o + 132) = acc[ai][1][m][1] * r4 * w11;
            }
    }
};

template <int W> DI void pool_item(const bf16_t* UP, bf16_t* DOB, int t0, int c0) {
    f32x4 ra[W + 7], rb[W + 7];
#pragma unroll
    for (int i = 0; i < W + 7; ++i) { const int t = t0 - (W - 1) + i; if (t >= 0) unpack8(*(const u32x4*)(UP + (size_t)t * DP + c0), ra[i], rb[i]); else { ra[i] = (f32x4){0.f, 0.f, 0.f, 0.f}; rb[i] = ra[i]; } }
    f32x4 sa = {0.f, 0.f, 0.f, 0.f}, sb = sa;
#pragma unroll
    for (int i = 0; i < W - 1; ++i) { sa += ra[i]; sb += rb[i]; }
#pragma unroll
    for (int j = 0; j < 8; ++j) {
        sa += ra[W - 1 + j]; sb += rb[W - 1 + j];
        const int t = t0 + j; const float inv = 1.f / (float)((t + 1 < W) ? t + 1 : W);
        *(u32x4*)(DOB + (size_t)t * DM + c0) = pack8(sa * inv - ra[W - 1 + j], sb * inv - rb[W - 1 + j]);
        sa -= ra[j]; sb -= rb[j];
    }
}
DI void pool_phase(Frame& F) {
    const bf16_t* UP = (const bf16_t*)(F.ws + WS_UP); bf16_t* DOB = (bf16_t*)(F.ws + WS_DOB);
    const int gt = F.vcu * 512 + F.tid, NGT = F.G * 512;
    for (int idx = gt; idx < (S / 8) * 128; idx += NGT) {
        const int t0 = (idx >> 7) * 8, c0 = (idx & 127) * 8, g = c0 >> 8;
        if (g == 0) pool_item<2>(UP, DOB, t0, c0); else if (g == 1) pool_item<4>(UP, DOB, t0, c0); else if (g == 2) pool_item<8>(UP, DOB, t0, c0); else pool_item<16>(UP, DOB, t0, c0);
    }
}

constexpr int TROW = 72;
constexpr int SROW = 136;
constexpr int H_VT = 0, H_KT = 18432, H_ST = 36864, H_QF = 71680, H_KF = 88064, H_NRM = 104448;
DI int ctile_off(int vt, int kt, int i, int lane) { return ((vt * 4 + kt) * 16 + i) * 64 + lane; }
DI int b63_off(int k) { return fq_off(1, k >> 4, 31 + 32 * ((k >> 3) & 1)) + (k & 7); }

struct HRegs { u32x4 v0, v1, q[2], k2[2]; f32x4 ea[2], eb[2]; float d0, d1; };
struct HCur { float d0, d1; };
template <bool WITH_Q>
DI void h_load_chunk(Frame& F, int uidx, HRegs& R) {
    const bf16_t* V = (const bf16_t*)(F.ws + WS_V); const bf16_t* K2 = (const bf16_t*)(F.ws + WS_KK); const bf16_t* Q = (const bf16_t*)(F.ws + WS_Q);
    const float* DL = (const float*)(F.ws + WS_DL);
    const int tid = F.tid, s = tid & 63, cg = F.wave;
    const int n = uidx >> 3, h = uidx & 7, t = 64 * n + s, col = h * 128 + 16 * cg;
    R.v0 = *(const u32x4*)(V + (size_t)t * DH + col); R.v1 = *(const u32x4*)(V + (size_t)t * DH + col + 8);
#pragma unroll
    for (int i = 0; i < 2; ++i) {
        const int f = tid + 512 * i, k0 = 16 * ((f >> 6) & 7) + 8 * ((f & 63) >> 5);
        R.k2[i] = *(const u32x4*)(K2 + (size_t)uidx * 8192 + f * 8);
        if (WITH_Q) R.q[i] = *(const u32x4*)(Q + (size_t)uidx * 8192 + f * 8);
        R.ea[i] = *(const f32x4*)(DL + (size_t)n * DH + h * 128 + k0); R.eb[i] = *(const f32x4*)(DL + (size_t)n * DH + h * 128 + k0 + 4);
    }
    { const int kt0 = 2 * (F.wave & 1), r = F.lane & 31; R.d0 = DL[(size_t)n * DH + h * 128 + 32 * kt0 + r]; R.d1 = DL[(size_t)n * DH + h * 128 + 32 * kt0 + 32 + r]; }
}
template <bool WITH_Q>
DI void h_stage_chunk(Frame& F, const HRegs& R, HCur& C) {
    C.d0 = R.d0; C.d1 = R.d1;
    LAS short* VT = (LAS short*)(F.lds + H_VT); LAS short* KT = (LAS short*)(F.lds + H_KT);
    const int tid = F.tid, s = tid & 63, cg = F.wave;
    const unsigned vw[8] = {R.v0.x, R.v0.y, R.v0.z, R.v0.w, R.v1.x, R.v1.y, R.v1.z, R.v1.w};
#pragma unroll
    for (int i = 0; i < 8; ++i) { VT[(16 * cg + 2 * i) * TROW + s] = (short)(vw[i] & 0xffffu); VT[(16 * cg + 2 * i + 1) * TROW + s] = (short)(vw[i] >> 16); }
#pragma unroll
    for (int i = 0; i < 2; ++i) {
        const int f = tid + 512 * i, ti = f >> 9, st = (f >> 6) & 7, lp = f & 63, ss = 32 * ti + (lp & 31), k0 = 16 * st + 8 * (lp >> 5);
        if (WITH_Q) { *(LAS u32x4*)(F.lds + H_QF + f * 16) = R.q[i]; *(LAS u32x4*)(F.lds + H_KF + f * 16) = R.k2[i]; }
        f32x4 ka, kb; unpack8(R.k2[i], ka, kb);
        const u32x4 kp = pack8(ka * R.ea[i], kb * R.eb[i]);
        const unsigned kw[4] = {kp.x, kp.y, kp.z, kp.w};
#pragma unroll
        for (int c = 0; c < 4; ++c) { KT[(k0 + 2 * c) * TROW + ss] = (short)(kw[c] & 0xffffu); KT[(k0 + 2 * c + 1) * TROW + ss] = (short)(kw[c] >> 16); }
    }
}
DI void h_state_update(Frame& F, const HCur& C, f32x16& s0, f32x16& s1) {
    const LAS short* VT = (const LAS short*)(F.lds + H_VT); const LAS short* KT = (const LAS short*)(F.lds + H_KT);
    const int vt = F.wave >> 1, kt0 = 2 * (F.wave & 1), r = F.lane & 31, hh = F.lane >> 5;
    const float d0 = C.d0, d1 = C.d1;
#pragma unroll
    for (int i = 0; i < 16; ++i) { s0[i] *= d0; s1[i] *= d1; }
#pragma unroll
    for (int st = 0; st < 4; ++st) {
        const int sx = 16 * st + 8 * hh;
        const bf16x8 af = *(const LAS bf16x8*)(VT + (32 * vt + r) * TROW + sx);
        const bf16x8 b0 = *(const LAS bf16x8*)(KT + (32 * kt0 + r) * TROW + sx), b1 = *(const LAS bf16x8*)(KT + (32 * (kt0 + 1) + r) * TROW + sx);
        s0 = __builtin_amdgcn_mfma_f32_32x32x16_bf16(af, b0, s0, 0, 0, 0);
        s1 = __builtin_amdgcn_mfma_f32_32x32x16_bf16(af, b1, s1, 0, 0, 0);
    }
}
DI void h1_phase(Frame& F) {
    float* LT = (float*)(F.ws + WS_LT);
    for (int ub = F.vcu; ub < (NCHUNK / 4) * 8; ub += F.G) {
        const int blk = ub >> 3, h = ub & 7;
        f32x16 s0, s1;
#pragma unroll
        for (int i = 0; i < 16; ++i) { s0[i] = 0.f; s1[i] = 0.f; }
        HRegs R; h_load_chunk<false>(F, (4 * blk) * 8 + h, R);
#pragma unroll 1
        for (int c = 0; c < 4; ++c) {
            const int uidx = (4 * blk + c) * 8 + h;
            __syncthreads();
            HCur C; h_stage_chunk<false>(F, R, C);
            if (c < 3) h_load_chunk<false>(F, uidx + 8, R);
            __syncthreads();
            h_state_update(F, C, s0, s1);
        }
        float* lt = LT + (size_t)ub * 16384; const int vt = F.wave >> 1, kt0 = 2 * (F.wave & 1);
#pragma unroll
        for (int i = 0; i < 16; ++i) { lt[ctile_off(vt, kt0, i, F.lane)] = s0[i]; lt[ctile_off(vt, kt0 + 1, i, F.lane)] = s1[i]; }
    }
    __syncthreads();
}
DI void h2_phase(Frame& F) {
    float* LT = (float*)(F.ws + WS_LT); const float* DL = (const float*)(F.ws + WS_DL);
    const int gt = F.vcu * 512 + F.tid, NGT = F.G * 512;
    for (int idx = gt; idx < 8 * 16384; idx += NGT) {
        const int h = idx >> 14, e = idx & 16383, k = 32 * ((e >> 10) & 3) + (e & 31);
        float st = 0.f;
        for (int b0 = 0; b0 < NCHUNK / 4; b0 += 4) {
            float L[4], d[4];
#pragma unroll
            for (int j = 0; j < 4; ++j) {
                L[j] = LT[(size_t)((b0 + j) * 8 + h) * 16384 + e];
                const float* dl = DL + (size_t)(4 * (b0 + j)) * DH + h * 128 + k;
                d[j] = (dl[0] * dl[DH]) * (dl[2 * DH] * dl[3 * DH]);
            }
#pragma unroll
            for (int j = 0; j < 4; ++j) { LT[(size_t)((b0 + j) * 8 + h) * 16384 + e] = st; st = d[j] * st + L[j]; }
        }
    }
}
DI void h3_phase(Frame& F) {
    const float* LT = (const float*)(F.ws + WS_LT); const bf16_t* SG = (const bf16_t*)(F.ws + WS_SG); bf16_t* DOB = (bf16_t*)(F.ws + WS_DOB); const float* NW = F.in[7];
    const int lane = F.lane, r = lane & 31, hh = lane >> 5;
    const LAS short* VT = (const LAS short*)(F.lds + H_VT); LAS short* ST = (LAS short*)(F.lds + H_ST); LAS float* NRM = (LAS float*)(F.lds + H_NRM);
    for (int ub = F.vcu; ub < (NCHUNK / 4) * 8; ub += F.G) {
        const int blk = ub >> 3, h = ub & 7, hc = h * 128;
        const int vts = F.wave >> 1, kt0 = 2 * (F.wave & 1);
        const int vto = F.wave & 3, ti = F.wave >> 2;
        f32x16 s0, s1;
        { const float* lt = LT + (size_t)ub * 16384;
#pragma unroll
          for (int i = 0; i < 16; ++i) { s0[i] = lt[ctile_off(vts, kt0, i, lane)]; s1[i] = lt[ctile_off(vts, kt0 + 1, i, lane)]; } }
        HRegs R; h_load_chunk<true>(F, (4 * blk) * 8 + h, R);
#pragma unroll 1
        for (int c = 0; c < 4; ++c) {
            const int uidx = (4 * blk + c) * 8 + h, t0 = 64 * (4 * blk + c);
            __syncthreads();
            HCur C; h_stage_chunk<true>(F, R, C);
            if (c < 3) h_load_chunk<true>(F, uidx + 8, R);
#pragma unroll
            for (int i = 0; i < 16; ++i) { const int v = 32 * vts + 8 * (i >> 2) + 4 * hh + (i & 3);
                ST[v * SROW + 32 * kt0 + r] = (short)(pk2(s0[i], 0.f) & 0xffffu); ST[v * SROW + 32 * kt0 + 32 + r] = (short)(pk2(s1[i], 0.f) & 0xffffu); }
            __syncthreads();
            f32x16 O;
            {
                bf16x8 qf[8];
#pragma unroll
                for (int st = 0; st < 8; ++st) qf[st] = *(const LAS bf16x8*)(F.lds + H_QF + ((ti * 8 + st) * 64 + lane) * 16);
                f32x16 X[2];
#pragma unroll
                for (int i = 0; i < 16; ++i) { X[0][i] = 0.f; X[1][i] = 0.f; O[i] = 0.f; }
#pragma unroll
                for (int sb = 0; sb < 2; ++sb) {
                    if (sb <= ti) {
#pragma unroll
                        for (int st = 0; st < 8; ++st)
                            X[sb] = __builtin_amdgcn_mfma_f32_32x32x16_bf16(*(const LAS bf16x8*)(F.lds + H_KF + ((sb * 8 + st) * 64 + lane) * 16), qf[st], X[sb], 0, 0, 0);
                    }
                }
#pragma unroll
                for (int i = 0; i < 16; ++i) { const int sl = 8 * (i >> 2) + 4 * hh + (i & 3); const bool keep = sl <= r;
                    if (ti == 0) X[0][i] = keep ? X[0][i] : 0.f; else X[1][i] = keep ? X[1][i] : 0.f; }
#pragma unroll
                for (int sb = 0; sb < 2; ++sb) {
                    if (sb <= ti) {
#pragma unroll
                        for (int sp = 0; sp < 2; ++sp) {
                            u32x4 xb; xb.x = pk2(X[sb][8 * sp + 0], X[sb][8 * sp + 1]); xb.y = pk2(X[sb][8 * sp + 2], X[sb][8 * sp + 3]); xb.z = pk2(X[sb][8 * sp + 4], X[sb][8 * sp + 5]); xb.w = pk2(X[sb][8 * sp + 6], X[sb][8 * sp + 7]);
                            const int sbase = 32 * sb + 16 * sp + 4 * hh;
                            const s16x4 lo = *(const LAS s16x4*)(VT + (32 * vto + r) * TROW + sbase), hi = *(const LAS s16x4*)(VT + (32 * vto + r) * TROW + sbase + 8);
                            O = __builtin_amdgcn_mfma_f32_32x32x16_bf16(__builtin_shufflevector(lo, hi, 0, 1, 2, 3, 4, 5, 6, 7), __builtin_bit_cast(bf16x8, xb), O, 0, 0, 0);
                        }
                    }
                }
#pragma unroll
                for (int st = 0; st < 8; ++st)
                    O = __builtin_amdgcn_mfma_f32_32x32x16_bf16(*(const LAS bf16x8*)(ST + (32 * vto + r) * SROW + 16 * st + 8 * hh), qf[st], O, 0, 0, 0);
            }
            { float ss = 0.f;
#pragma unroll
              for (int i = 0; i < 16; ++i) ss += O[i] * O[i];
              ss += __shfl_xor(ss, 32);
              if (hh == 0) NRM[(ti * 4 + vto) * 32 + r] = ss; }
            h_state_update(F, C, s0, s1);
            __syncthreads();
            {
                const float ssum = (NRM[(ti * 4 + 0) * 32 + r] + NRM[(ti * 4 + 1) * 32 + r]) + (NRM[(ti * 4 + 2) * 32 + r] + NRM[(ti * 4 + 3) * 32 + r]);
                const float rn = rsqrtf(ssum * (1.f / 128.f) + EPS);
                const int tq = t0 + 32 * ti + r;
#pragma unroll
                for (int g4 = 0; g4 < 4; ++g4) {
                    const int v0 = 32 * vto + 8 * g4 + 4 * hh;
                    const f32x4 nw = *(const f32x4*)(NW + hc + v0);
                    const u32x2 sg = *(const u32x2*)(SG + (size_t)tq * DH + hc + v0);
                    u32x2 w;
                    w.x = pk2(O[4 * g4 + 0] * rn * nw.x * bf_lo(sg.x), O[4 * g4 + 1] * rn * nw.y * bf_hi(sg.x));
                    w.y = pk2(O[4 * g4 + 2] * rn * nw.z * bf_lo(sg.y), O[4 * g4 + 3] * rn * nw.w * bf_hi(sg.y));
                    *(u32x2*)(DOB + (size_t)tq * DM + DP + hc + v0) = w;
                }
            }
        }
    }
    __syncthreads();
}
DI void fixup_panel(Frame& F, int pm) {
    const float* ZB = (const float*)(F.ws + WS_ZB); bf16_t* ACT = (bf16_t*)(F.ws + WS_ACT); const float* cw = F.in[13]; const float* cb = F.in[14];
    const f32x4 zero = {0.f, 0.f, 0.f, 0.f};
    for (int cg = F.tid; cg < DFF / 4; cg += NWAVES * 64) {
        const int c = 4 * cg, pg = 256 * (c >> 7) + (c & 127);
        f32x4 w0[2], w1[2], w2[2], bb[2];
#pragma unroll
        for (int hv = 0; hv < 2; ++hv) { const int oc = c + DFF * hv; w0[hv] = *(const f32x4*)(cw + oc); w1[hv] = *(const f32x4*)(cw + DFF2 + oc); w2[hv] = *(const f32x4*)(cw + 2 * DFF2 + oc); bb[hv] = *(const f32x4*)(cb + oc); }
#pragma unroll
        for (int bi = 0; bi < 4; ++bi) {
            const int b = 4 * pm + bi;
            f32x4 u0[2], u1[2];
#pragma unroll
            for (int hv = 0; hv < 2; ++hv) {
                const float* zb = ZB + (size_t)b * 4 * DFF2 + pg + 128 * hv;
                const f32x4 r0 = *(const f32x4*)zb, r1 = *(const f32x4*)(zb + DFF2);
                const f32x4 p2 = b > 0 ? *(const f32x4*)(zb - 2 * DFF2) : zero, p3 = b > 0 ? *(const f32x4*)(zb - DFF2) : zero;
                u0[hv] = bb[hv] + w2[hv] * r0 + w1[hv] * p3 + w0[hv] * p2;
                u1[hv] = bb[hv] + w2[hv] * r1 + w1[hv] * r0 + w0[hv] * p3;
            }
            u32x2 a, d;
            a.x = pk2(u0[0].x * sigm(u0[0].x) * u0[1].x, u0[0].y * sigm(u0[0].y) * u0[1].y); a.y = pk2(u0[0].z * sigm(u0[0].z) * u0[1].z, u0[0].w * sigm(u0[0].w) * u0[1].w);
            d.x = pk2(u1[0].x * sigm(u1[0].x) * u1[1].x, u1[0].y * sigm(u1[0].y) * u1[1].y); d.y = pk2(u1[0].z * sigm(u1[0].z) * u1[1].z, u1[0].w * sigm(u1[0].w) * u1[1].w);
            *(u32x2*)(ACT + (size_t)(64 * b) * DFF + c) = a;
            *(u32x2*)(ACT + (size_t)(64 * b + 1) * DFF + c) = d;
        }
    }
    asm volatile("s_waitcnt vmcnt(0)" ::: "memory");
    __syncthreads();
}
DI void final_phase(Frame& F) {
    const float* SSQ = (const float*)(F.ws + WS_SSQ3); const float* wf = F.in[19]; float* out = F.out;
    const int gw = F.vcu * NWAVES + F.wave, NGW = F.G * NWAVES;
    for (int m = gw; m < S; m += NGW) {
        float s = F.lane < 32 ? SSQ[(size_t)m * 32 + F.lane] : 0.f;
        s = wave_sum(s);
        const float rr = rsqrtf(s * (1.f / DM) + EPS);
        f32x4* xr = (f32x4*)(out + (size_t)m * DM) + F.lane; const f32x4* wr_ = (const f32x4*)wf + F.lane;
#pragma unroll
        for (int j = 0; j < 8; ++j) { const f32x4 v = xr[64 * j], w = wr_[64 * j]; xr[64 * j] = v * rr * w; }
    }
}

struct Args { const float* in[20]; float* out; unsigned char* ws; int ph_lo, ph_hi, li, pad; };
constexpr int NPHASE = 10;
#define WGM_G1 2
#define WGM_G5 2
#define WGM_SQ 2

#define REP_P0 1
#define REP_P1 1
#define REP_P2 1
#define REP_P4 1
#define REP_P5 1
#define REP_P6 1
#define REP_P7 1
#define REP_BAR 1
#define KS_NTP 18
#define TS_PHASE 99

__global__ void __launch_bounds__(NWAVES * 64, 2) mk_fwd(Args args) {
    extern __shared__ __attribute__((aligned(16))) unsigned char lds[];
    Frame F;
    F.lds = (LAS unsigned char*)lds;
    F.tid = threadIdx.x; F.lane = F.tid & 63; F.wave = __builtin_amdgcn_readfirstlane(F.tid >> 6);
    F.G = gridDim.x; { const int bx = blockIdx.x; F.vcu = (F.G % 8 == 0) ? (bx % 8) * (F.G / 8) + bx / 8 : bx; }
    F.ws = args.ws; F.out = args.out; F.in = args.in;
    volatile LAS unsigned* MISC = (volatile LAS unsigned*)(F.lds + MISC_OFF);
    for (int u = F.tid; u < (LDS_BYTES - LDSCTL_OFF) / 4; u += NWAVES * 64) ((LAS unsigned*)(F.lds + LDSCTL_OFF))[u] = 0u;
    __syncthreads();
    const bool multi = (args.ph_hi - args.ph_lo) > 1;
    XcdBarrier bar; bar.bar = (unsigned*)(args.ws + WS_CTL) + CW_BAR + args.li * XCD_BAR_WORDS; bar.x = 0; bar.st = nullptr;
    if (multi) bar = xcd_barrier_post(bar.bar, MISC + 8);
    const int lo = args.ph_lo, hi = args.ph_hi;
    if (TS_PHASE == 0 && blockIdx.x == 0 && F.tid == 0) MISC[16] = (unsigned)__builtin_amdgcn_s_memrealtime();
#define IN(k) (lo <= (k) && (k) < hi)
#define SEAM(k) do { if (IN(k) && IN((k) + 1)) xcd_barrier(bar); if (TS_PHASE != 99 && blockIdx.x == 0 && F.tid == 0) { const unsigned long long _t = __builtin_amdgcn_s_memrealtime(); if ((k) + 1 == TS_PHASE) MISC[16] = (unsigned)_t; if ((k) == TS_PHASE) MISC[17] = (unsigned)_t; } } while (0)
    unsigned char* ws = args.ws;
    const int bid = (int)blockIdx.x;

#define BODY_P1 {     \
        pg8::Gemm g{(const bf16_t*)(ws + WS_XB), (const bf16_t*)(ws + WS_WIN), DM, DM, DM}; pg8::StaticOrder So; So.init(S, DIN, F.G, bid, WGM_G1); \
        EpiProj E{ws, F.out}; \
        pg8::gemm_phase<EpiProj, true>(F.lds, g, So, E); \
        convert_rest(F); }
#define BODY_P5 {     \
        pg8::Gemm g{(const bf16_t*)(ws + WS_DOB), (const bf16_t*)(ws + WS_WAB), DM, DM, DM}; pg8::StaticOrder So; So.init(S, DM, F.G, bid, WGM_SQ); \
        EpiMerge E{(const bf16_t*)F.out, (const bf16_t*)F.out + (size_t)S * DM, (bf16_t*)(ws + WS_MG)}; \
        pg8::gemm_phase<EpiMerge, true>(F.lds, g, So, E); }
#define BODY_P6 {     \
        pg8::Gemm g{(const bf16_t*)(ws + WS_MG), (const bf16_t*)(ws + WS_WOUT), DM, DM, DM}; pg8::StaticOrder So; So.init(S, DM, F.G, bid, WGM_SQ); \
        EpiResB<true> E{(const void*)(ws + WS_XB), (bf16_t*)(ws + WS_XB), (float*)(ws + WS_SSQ1)}; \
        pg8::gemm_phase<EpiResB<true>, true>(F.lds, g, So, E); }
#define BODY_P7 {     \
        pg8::Gemm g{(const bf16_t*)(ws + WS_XB), (const bf16_t*)(ws + WS_WUP), DM, DM, DM}; pg8::StaticOrder So; So.init(S, DFF2, F.G, bid, WGM_G5); \
        pg8::SplitTail Ss; Ss.init(S, DFF2, F.G, bid, WGM_G5, DM / 64, KS_NTP); if (Ss.split) So.lim = Ss.full * F.G; \
        EpiUp E{ws, F.in[13], F.in[14], F.lds}; \
        pg8::gemm_phase<EpiUp, true>(F.lds, g, So, E); \
        { EpiUpKS Ek{E}; pg8::gemm_phase<EpiUpKS, true, pg8::SplitTail>(F.lds, g, Ss, Ek); } \
        {   \
          pg8::Gemm g2{(const bf16_t*)(ws + WS_PB), (const bf16_t*)(ws + WS_WPLE), PLE, PLE, PLE}; pg8::TailOrder2 St; St.init(S, DM, F.G, bid, Ss.rem, Ss.split); \
          EpiBf E2{(bf16_t*)(ws + WS_E), DM}; \
          pg8::gemm_phase<EpiBf, false, pg8::TailOrder2>(F.lds, g2, St, E2); } }

    if (IN(0)) { for (int rp = 0; rp <= args.pad; ++rp) p0_prologue(F); } SEAM(0);
    if (multi) for (int rb = 1; rb < REP_BAR; ++rb) xcd_barrier(bar);
    if (IN(1)) { BODY_P1 if (REP_P1 > 1) BODY_P1 } SEAM(1);
    if (IN(2)) { h1_phase(F); pool_phase(F); if (REP_P2 > 1) { h1_phase(F); pool_phase(F); } if (REP_P2 > 2) { h1_phase(F); pool_phase(F); } } SEAM(2);
    if (IN(3)) { h2_phase(F); } SEAM(3);
    if (IN(4)) { h3_phase(F); if (REP_P4 > 1) h3_phase(F); if (REP_P4 > 2) h3_phase(F); } SEAM(4);
    if (IN(5)) { BODY_P5 if (REP_P5 > 1) BODY_P5 } SEAM(5);
    if (IN(6)) { BODY_P6 if (REP_P6 > 1) BODY_P6 } SEAM(6);
    if (IN(7)) { BODY_P7 if (REP_P7 > 1) BODY_P7 } SEAM(7);
    if (IN(8)) {
        pg8::Gemm g{(const bf16_t*)(ws + WS_ACT), (const bf16_t*)(ws + WS_WDOWN), DFF, DFF, DFF}; pg8::StaticOrder So; So.init(S, DM, F.G, bid, WGM_SQ);
        { Unit u0; if (So.next(0, u0)) fixup_panel(F, u0.pm); }
        EpiResB<true> E{(const void*)(ws + WS_XB), (bf16_t*)(ws + WS_XB), (float*)(ws + WS_SSQ2)};
        pg8::gemm_phase<EpiResB<true>, true>(F.lds, g, So, E);
    } SEAM(8);
    if (IN(9)) {
        pg8::Gemm g{(const bf16_t*)(ws + WS_XB), (const bf16_t*)(ws + WS_WPG), DM, DM, DM}; pg8::StaticOrder So; So.init(S, DM, F.G, bid, WGM_SQ);
        EpiPle E{ws, F.out, F.in[19]};
        pg8::gemm_phase<EpiPle, true>(F.lds, g, So, E);
    }
    if (TS_PHASE != 99 && blockIdx.x == 0 && F.tid == 0) { const unsigned long long t1 = __builtin_amdgcn_s_memrealtime(); if (TS_PHASE == 9) MISC[17] = (unsigned)t1; unsigned span = MISC[17] - MISC[16]; if (span > 100000u) span = 100000u;
        while ((unsigned)(__builtin_amdgcn_s_memrealtime() - t1) < 2u * span) __builtin_amdgcn_s_sleep(8); }
#undef IN
#undef SEAM
}

#ifndef MK_N_LAUNCHES
#define MK_N_LAUNCHES 1
#endif
extern "C" void kernel_launch(void* const* d_in, const int* in_sizes, int n_in, void* d_out, int out_size, void* d_ws, size_t ws_size, hipStream_t stream) {
    static int grid = 0;
    if (grid == 0) {
        if (n_in != 20 || in_sizes[0] != S * DM || out_size != S * DM || ws_size < WS_END) { fprintf(stderr, "kernel_launch: unexpected shapes / workspace (%zu < %zu)\n", ws_size, (size_t)WS_END); grid = -1; return; }
        int dev = 0, cus = 0, per_cu = 0;
        if (hipGetDevice(&dev) != hipSuccess || hipDeviceGetAttribute(&cus, hipDeviceAttributeMultiprocessorCount, dev) != hipSuccess) { grid = -1; return; }
        if (hipFuncSetAttribute((const void*)mk_fwd, hipFuncAttributeMaxDynamicSharedMemorySize, LDS_BYTES) != hipSuccess) { fprintf(stderr, "kernel_launch: hipFuncSetAttribute failed\n"); grid = -1; return; }
        if (hipOccupancyMaxActiveBlocksPerMultiprocessor(&per_cu, (const void*)mk_fwd, NWAVES * 64, LDS_BYTES) != hipSuccess || per_cu < 1) { fprintf(stderr, "kernel_launch: occupancy query says %d\n", per_cu); per_cu = 1; }
        (void)hipGetLastError();
        grid = cus;
    }
    if (grid < 0) return;
    (void)hipMemsetAsync((char*)d_ws + WS_CTL, 0, CTL_ZERO_BYTES, stream);
    Args a{};
    for (int i = 0; i < 20; ++i) a.in[i] = (const float*)d_in[i];
    a.out = (float*)d_out; a.ws = (unsigned char*)d_ws; a.pad = REP_P0 - 1;
    if (MK_N_LAUNCHES == 1) {
        a.ph_lo = 0; a.ph_hi = NPHASE; a.li = 0;
        hipLaunchKernelGGL(mk_fwd, dim3(grid), dim3(NWAVES * 64), LDS_BYTES, stream, a);
    } else {
        for (int ph = 0; ph < NPHASE; ++ph) { a.ph_lo = ph; a.ph_hi = ph + 1; a.li = 0; hipLaunchKernelGGL(mk_fwd, dim3(grid), dim3(NWAVES * 64), LDS_BYTES, stream, a); }
    }
}
```

```cpp
#include <hip/hip_runtime.h>
#include <cstdio>
#include <cstdint>

#define LAS __attribute__((address_space(3)))
#define GAS __attribute__((address_space(1)))
typedef unsigned short bf16_t;
typedef short bf16x8 __attribute__((ext_vector_type(8)));
typedef short s16x4 __attribute__((ext_vector_type(4)));
typedef float f32x4 __attribute__((ext_vector_type(4)));
typedef float f32x2 __attribute__((ext_vector_type(2)));
typedef float f32x16 __attribute__((ext_vector_type(16)));
typedef unsigned u32x4 __attribute__((ext_vector_type(4)));
typedef unsigned u32x2 __attribute__((ext_vector_type(2)));
typedef __bf16 bf16v2 __attribute__((ext_vector_type(2)));
#define DI __device__ __forceinline__

constexpr int S = 8192, DM = 2048, DP = 1024, DH = 1024, DIN = 9216, DFF = 5504, DFF2 = 11008, PLE = 256, NCHUNK = 128;
constexpr float EPS = 1e-6f;

DI unsigned pk2(float lo, float hi) { f32x2 v = {lo, hi}; bf16v2 r = __builtin_convertvector(v, bf16v2); return __builtin_bit_cast(unsigned, r); }
DI float bf_lo(unsigned w) { return __builtin_bit_cast(float, w << 16); }
DI float bf_hi(unsigned w) { return __builtin_bit_cast(float, w & 0xffff0000u); }
DI float sigm(float v) { return __builtin_amdgcn_rcpf(1.0f + __expf(-v)); }
DI float wave_sum(float v) {
#pragma unroll
    for (int o = 1; o < 64; o <<= 1) v += __shfl_xor(v, o);
    return v;
}
template <int CTRL> DI float dppf(float v) { return __builtin_bit_cast(float, __builtin_amdgcn_update_dpp(0, __builtin_bit_cast(int, v), CTRL, 0xf, 0xf, true)); }
DI u32x4 pack8(f32x4 a, f32x4 b) { u32x4 w; w.x = pk2(a.x, a.y); w.y = pk2(a.z, a.w); w.z = pk2(b.x, b.y); w.w = pk2(b.z, b.w); return w; }
DI void unpack8(u32x4 w, f32x4& a, f32x4& b) { a.x = bf_lo(w.x); a.y = bf_hi(w.x); a.z = bf_lo(w.y); a.w = bf_hi(w.y); b.x = bf_lo(w.z); b.y = bf_hi(w.z); b.z = bf_lo(w.w); b.w = bf_hi(w.w); }

DI int fq_off(int ti, int st, int lanep) { return ((ti * 8 + st) * 64 + lanep) * 8; }

namespace pg8 {
constexpr int BM = 256, BK = 64, HALF = 128, HTB = HALF * BK * 2, STAGE_BYTES = 8 * HTB, NXCD = 8, WGM = 8;
__host__ __device__ __forceinline__ int lds_byte(int r, int c) { const int st = (r >> 4) * 2 + (c >> 5), rr = r & 15, cc = c & 31, ob = rr * 64 + cc * 2; return st * 1024 + (ob ^ (((ob >> 9) & 1) << 5)); }
__host__ __device__ __forceinline__ void stage_rc(int b, int& R, int& C) { const int st = b / 1024, sb = b % 1024, swz = sb ^ (((sb >> 9) & 1) << 5); R = (st >> 1) * 16 + swz / 64; C = (st & 1) * 32 + (swz % 64) / 2; }
__host__ __device__ __forceinline__ int perm32(int rho) { const int n = rho >> 4, i = rho & 15; return 8 * (i >> 2) + 4 * n + (i & 3); }

struct Unit { int pm, pn, ui, k0, ntu, kind, sl; };
struct Gemm { const bf16_t* A; const bf16_t* Bt; int lda, ldb, K; };

struct StaticOrder {
    static constexpr bool KSPLIT = false;
    int nM, nN, nwg, G, c, wgm, lim;
    DI void init(int M, int N, int G_, int c_, int wgm_ = WGM) { nM = M / BM; nN = N / BM; nwg = nM * nN; G = G_; c = c_; wgm = wgm_; lim = nwg; }
    DI bool next(int i, Unit& u) const { return at((long)i * G + c, u); }
    DI bool at(long L, Unit& u) const {
        if (L >= lim) return false;
        int wgid = (int)L; { const int q = nwg / NXCD, r = nwg % NXCD, xcd = wgid % NXCD, off = wgid / NXCD; wgid = (xcd < r ? xcd * (q + 1) : r * (q + 1) + (xcd - r) * q) + off; }
        const int nig = wgm * nN, gid = wgid / nig, fm = gid * wgm, gsz = (nM - fm) < wgm ? (nM - fm) : wgm;
        u.pm = fm + ((wgid % nig) % gsz); u.pn = (wgid % nig) / gsz; return true;
    }
};

struct SplitTail {
    static constexpr bool KSPLIT = true;
    StaticOrder so; int full, rem, nt, ntp; bool split;
    DI void init(int M, int N, int G_, int c_, int wgm_, int nt_, int ntp_) { so.init(M, N, G_, c_, wgm_); full = so.nwg / G_; rem = so.nwg % G_; split = rem > 0 && 2 * rem <= G_; nt = nt_; ntp = ntp_; }
    DI bool next(int i, Unit& u) const {
        if (!split || i != 0) return false;
        int c = so.c; u.k0 = 0; u.ntu = ntp; u.kind = 1;
        if (c >= rem) { if (c >= 2 * rem) return false; c -= rem; u.k0 = ntp; u.ntu = nt - ntp; u.kind = 2; }
        u.sl = c;
        return so.at((long)full * so.G + c, u);
    }
};
struct TailOrder2 {
    static constexpr bool KSPLIT = false;
    int nN, nE, c, idle0, I, a, sec0, nsec;
    DI void init(int M, int N, int G, int c_, int rem, bool split) { nN = N / BM; nE = (M / BM) * nN; c = c_; sec0 = rem; nsec = split ? rem : 0; idle0 = rem + nsec; I = G - idle0;
        a = I > 0 ? (nE + I - 1) / I : 0; if (split && a > 3) a = 3; }
    DI bool next(int i, Unit& u) const {
        int L;
        if (c >= idle0) { if (i >= a) return false; L = (c - idle0) + i * I; }
        else if (c >= sec0 && nsec > 0) { L = a * I + (c - sec0) + i * nsec; }
        else return false;
        if (L >= nE) return false;
        u.pm = L / nN; u.pn = L - u.pm * nN; return true;
    }
};
struct TailOrder {
    static constexpr bool KSPLIT = false;
    int nM, nN, nwg, G, c, c0;
    DI void init(int M, int N, int G_, int c_, int c0_) { nM = M / BM; nN = N / BM; nwg = nM * nN; G = G_; c = c_; c0 = c0_; }
    DI bool next(int i, Unit& u) const {
        if (c < c0) return false;
        const int L = (c - c0) + i * (G - c0); if (L >= nwg) return false;
        u.pm = L / nN; u.pn = L - u.pm * nN; return true;
    }
};
template <class Epi, bool ALIGN_EPI, class Sched = StaticOrder>
DI void gemm_phase(LAS unsigned char* lds, const Gemm g, const Sched& S, const Epi& E) {
    int tid_o = threadIdx.x; asm volatile("" : "+v"(tid_o));
    const int tid = tid_o, wid = __builtin_amdgcn_readfirstlane(tid >> 6), lane = tid & 63, wr = wid >> 2, wc = wid & 3, fr = lane & 15, fq = lane >> 4;
    const int K = g.K, nt = K / BK;
    unsigned voffA[2], voffB[2];
#pragma unroll
    for (int i = 0; i < 2; ++i) { int R, C; stage_rc(tid * 16 + i * 8192, R, C); const int Rb = (R & ~31) + perm32(R & 31);
        voffA[i] = (unsigned)(R * g.lda + C) * 2u; voffB[i] = (unsigned)(Rb * g.ldb + C) * 2u; }
    const size_t kstep = (size_t)(BK * 2);
    const size_t hstepA = (size_t)HALF * g.lda * 2, hstepB = (size_t)HALF * g.ldb * 2;
    const size_t tstepA = 2 * hstepA, tstepB = 2 * hstepB;
    const unsigned ldsw = (unsigned)wid * 1024u;
    const int aoff = lds_byte(wr * 64 + fr, fq * 8), boff = lds_byte(wc * 32 + fr, fq * 8);
#define PG8_SA(b, h) (((b) * 2 + (h)) * HTB)
#define PG8_SB(b, h) ((4 + (b) * 2 + (h)) * HTB)
#define PG8_STAGE(bufoff, gbase, voff) do { _Pragma("unroll") for (int _i = 0; _i < 2; ++_i) \
        __builtin_amdgcn_global_load_lds((const unsigned*)((const char*)(gbase) + (voff)[_i]), (LAS unsigned*)(lds + (bufoff) + ldsw + _i * 8192), 16, 0, 0); } while (0)
#define PG8_LDA(dst, b, h) do { _Pragma("unroll") for (int m = 0; m < 4; ++m) _Pragma("unroll") for (int k = 0; k < 2; ++k) dst[m][k] = *(const LAS bf16x8*)(lds + PG8_SA(b, h) + aoff + m * 2048 + k * 1024); } while (0)
#define PG8_LDB(dst, b, h) do { _Pragma("unroll") for (int n = 0; n < 2; ++n) _Pragma("unroll") for (int k = 0; k < 2; ++k) dst[n][k] = *(const LAS bf16x8*)(lds + PG8_SB(b, h) + boff + n * 2048 + k * 1024); } while (0)
#define PG8_MMA(ai, bj, At, Bt) do { __builtin_amdgcn_s_setprio(1); _Pragma("unroll") for (int m = 0; m < 4; ++m) _Pragma("unroll") for (int n = 0; n < 2; ++n) _Pragma("unroll") for (int k = 0; k < 2; ++k) \
        acc[ai][bj][m][n] = __builtin_amdgcn_mfma_f32_16x16x32_bf16(Bt[n][k], At[m][k], acc[ai][bj][m][n], 0, 0, 0); __builtin_amdgcn_s_setprio(0); } while (0)
#define PG8_WAIT_V(n) asm volatile("s_waitcnt vmcnt(" #n ")" ::: "memory")
#define PG8_WAIT_L(n) asm volatile("s_waitcnt lgkmcnt(" #n ")" ::: "memory")
#define PG8_BAR __builtin_amdgcn_s_barrier()
#define PG8_SCHED __builtin_amdgcn_sched_barrier(0)
    Unit cur, nxt; int ui = 0;
    if (!S.next(0, cur)) return;
    cur.ui = 0;
    if constexpr (Epi::HAS_PRE) E.pre(lds, cur, wid, lane);
    f32x4 acc[2][2][4][2];
#pragma unroll
    for (int a = 0; a < 2; ++a)
#pragma unroll
        for (int b = 0; b < 2; ++b)
#pragma unroll
            for (int m = 0; m < 4; ++m)
#pragma unroll
                for (int n = 0; n < 2; ++n) acc[a][b][m][n] = (f32x4){0.f, 0.f, 0.f, 0.f};
    bf16x8 At[4][2], B0[2][2], B1[2][2];
    const char* cA = (const char*)g.A + (size_t)cur.pm * tstepA; const char* cB = (const char*)g.Bt + (size_t)cur.pn * tstepB;
    if constexpr (Sched::KSPLIT) { cA += (size_t)cur.k0 * kstep; cB += (size_t)cur.k0 * kstep; }
    PG8_STAGE(PG8_SB(0, 0), cB, voffB); PG8_STAGE(PG8_SB(0, 1), cB + hstepB, voffB); PG8_STAGE(PG8_SA(0, 0), cA, voffA); PG8_STAGE(PG8_SA(0, 1), cA + hstepA, voffA);
    if (wr == 1) PG8_BAR;
    PG8_WAIT_V(2); PG8_BAR;
    PG8_STAGE(PG8_SB(1, 0), cB + kstep, voffB); PG8_STAGE(PG8_SA(1, 0), cA + kstep, voffA); PG8_STAGE(PG8_SB(1, 1), cB + hstepB + kstep, voffB);
    PG8_WAIT_V(6); PG8_BAR;
    for (;;) {
        const bool has_next = S.next(ui + 1, nxt);
        const char* nA = has_next ? (const char*)g.A + (size_t)nxt.pm * tstepA : cA; const char* nB = has_next ? (const char*)g.Bt + (size_t)nxt.pn * tstepB : cB;
        if constexpr (Sched::KSPLIT) { if (has_next) { nA += (size_t)nxt.k0 * kstep; nB += (size_t)nxt.k0 * kstep; } }
        const int ntc = Sched::KSPLIT ? cur.ntu : nt;
        for (int t = 0; t < ntc; t += 2) {
            const bool last = (t == ntc - 2);
            const char* a1 = cA + (size_t)(t + 1) * kstep;
            const char* a2 = last ? nA : cA + (size_t)(t + 2) * kstep; const char* b2 = last ? nB : cB + (size_t)(t + 2) * kstep;
            const char* a3 = a2 + kstep; const char* b3 = b2 + kstep;
            if constexpr (Epi::MIDK != 0) { if (t == Epi::MIDK) E.mid(acc, cur, wr, wc, fr, fq); }
            PG8_LDB(B0, 0, 0); PG8_LDB(B1, 0, 1); PG8_SCHED; PG8_LDA(At, 0, 0); PG8_STAGE(PG8_SA(1, 1), a1 + hstepA, voffA);
            PG8_WAIT_V(8); PG8_WAIT_L(0); PG8_BAR; PG8_MMA(0, 0, At, B0); PG8_MMA(0, 1, At, B1); PG8_BAR; PG8_SCHED;
            PG8_LDA(At, 0, 1); PG8_STAGE(PG8_SB(0, 0), b2, voffB); PG8_STAGE(PG8_SB(0, 1), b2 + hstepB, voffB); PG8_STAGE(PG8_SA(0, 0), a2, voffA);
            PG8_WAIT_V(8); PG8_WAIT_L(0); PG8_BAR; PG8_MMA(1, 0, At, B0); PG8_MMA(1, 1, At, B1); PG8_BAR; PG8_SCHED;
            PG8_LDB(B0, 1, 0); PG8_LDB(B1, 1, 1); PG8_SCHED; PG8_LDA(At, 1, 0); PG8_STAGE(PG8_SA(0, 1), a2 + hstepA, voffA);
            PG8_WAIT_V(8); PG8_WAIT_L(0); PG8_BAR; PG8_MMA(0, 0, At, B0); PG8_MMA(0, 1, At, B1); PG8_BAR; PG8_SCHED;
            PG8_LDA(At, 1, 1); PG8_STAGE(PG8_SB(1, 0), b3, voffB); PG8_STAGE(PG8_SB(1, 1), b3 + hstepB, voffB); PG8_STAGE(PG8_SA(1, 0), a3, voffA);
            PG8_WAIT_V(8); PG8_WAIT_L(0); PG8_BAR; PG8_MMA(1, 0, At, B0); PG8_MMA(1, 1, At, B1); PG8_BAR; PG8_SCHED;
        }
        if constexpr (ALIGN_EPI) { if (wr == 0) PG8_BAR; }
        if constexpr (!Epi::AFTER_DRAIN) E(acc, cur, wr, wc, fr, fq);
        if (!has_next) break;
#pragma unroll
        for (int a = 0; a < 2; ++a)
#pragma unroll
            for (int b = 0; b < 2; ++b)
#pragma unroll
                for (int m = 0; m < 4; ++m)
#pragma unroll
                    for (int n = 0; n < 2; ++n) acc[a][b][m][n] = (f32x4){0.f, 0.f, 0.f, 0.f};
        cur = nxt; cA = nA; cB = nB; ++ui; cur.ui = ui;
        if constexpr (Epi::HAS_PRE) E.pre(lds, cur, wid, lane);
        if constexpr (ALIGN_EPI) { if (wr == 1) PG8_BAR; }
    }
    PG8_WAIT_V(0);
    if constexpr (!ALIGN_EPI) { if (wr == 0) PG8_BAR; }
    PG8_BAR;
    if constexpr (Epi::AFTER_DRAIN) E.fused(acc, cur, wr, wc, fr, fq);
#undef PG8_SA
#undef PG8_SB
#undef PG8_STAGE
#undef PG8_LDA
#undef PG8_LDB
#undef PG8_MMA
#undef PG8_WAIT_V
#undef PG8_WAIT_L
#undef PG8_BAR
#undef PG8_SCHED
}
}
using pg8::Unit;
typedef f32x4 AccT[2][2][4][2];

constexpr size_t MiB = 1u << 20;
constexpr size_t WS_CTL = 0, CTL_ZERO_BYTES = 1 * MiB;
constexpr size_t WS_R1 = 1 * MiB, WS_LB = WS_R1 + 65536;
constexpr size_t WS_SSQ1 = 2 * MiB, WS_SSQ2 = 3 * MiB, WS_SSQ3 = 4 * MiB;
constexpr size_t WS_WAB = 6 * MiB, WS_WOUT = 14 * MiB, WS_WPG = 22 * MiB, WS_WPLE = 30 * MiB, WS_WDOWN = 31 * MiB, WS_WUP = 53 * MiB, WS_WIN = 96 * MiB;
constexpr size_t WS_XB = 132 * MiB;
constexpr size_t WS_UP = 164 * MiB, WS_Q = 180 * MiB, WS_KK = 196 * MiB, WS_V = 212 * MiB, WS_SG = 228 * MiB;
constexpr size_t WS_KP = 244 * MiB, WS_DL = 260 * MiB;
constexpr size_t WS_BC = 244 * MiB;
constexpr size_t WS_DOB = 276 * MiB;
constexpr size_t WS_PB = 308 * MiB;
constexpr size_t WS_ZB = 312 * MiB;
constexpr size_t WS_END = 344 * MiB;
constexpr size_t WS_LT = 96 * MiB;
constexpr size_t WS_TMP = 164 * MiB;
constexpr size_t WS_MG = 244 * MiB;
constexpr size_t WS_STB = 312 * MiB;
constexpr size_t WS_E = 96 * MiB;
constexpr size_t WS_ACT = 164 * MiB;
static_assert(WS_WUP + (size_t)DFF2 * DM * 2 <= WS_WIN && WS_WIN + (size_t)DIN * DM * 2 <= WS_XB && WS_LT + (size_t)256 * 16384 * 4 <= WS_XB, "ws map");
static_assert(WS_ACT + (size_t)S * DFF * 2 <= WS_DOB && WS_ZB + (size_t)128 * 4 * DFF2 * 4 <= WS_END, "ws map 2");

constexpr int CW_BAR = 4096;
constexpr int CW_KS = 24576;
constexpr size_t WS_SLAB = WS_DOB;
constexpr int RING_BYTES = 131072, LDSCTL_OFF = RING_BYTES, MISC_OFF = LDSCTL_OFF + 320, LDS_BYTES = 147456;
constexpr int NWAVES = 8;

typedef GAS unsigned gu32;
#define RLX_AGENT __ATOMIC_RELAXED, __HIP_MEMORY_SCOPE_AGENT
#define LDS_WAIT() asm volatile("s_waitcnt lgkmcnt(0)" ::: "memory")

#define XB_TMO      128
#define XB_XCNT(j)  (256  + 64 * (j))
#define XB_XSUB(j)  (1280 + 64 * (j))
#define XB_XGEN(j)  (2304 + 64 * (j))
#define XB_TOP      3328
#define XB_TOPGEN   3392
#define XCD_BAR_WORDS 3456
#define XB_SPIN_CAP (1u << 22)
DI unsigned xb_ld(unsigned* p)              { return __hip_atomic_load(p, __ATOMIC_RELAXED, __HIP_MEMORY_SCOPE_AGENT); }
DI unsigned xb_add(unsigned* p, unsigned v) { return __hip_atomic_fetch_add(p, v, __ATOMIC_RELAXED, __HIP_MEMORY_SCOPE_AGENT); }
DI unsigned xb_xcc_id() { return (unsigned)__builtin_amdgcn_s_getreg((3 << 11) | 20) & 0xFu; }
#define XB_SPIN(cond, bar) do { unsigned _sp = 0; while (cond) { __builtin_amdgcn_s_sleep(1); \
    if ((++_sp & 255u) == 0u) { if (xb_ld(&(bar)[XB_TMO])) break; if (_sp > XB_SPIN_CAP) { atomicAdd(&(bar)[XB_TMO], 1u); break; } } } } while (0)
struct XcdBarrier { unsigned* bar; unsigned x; volatile LAS unsigned* st; };
DI XcdBarrier xcd_barrier_post(unsigned* bar, volatile LAS unsigned* st) {
    XcdBarrier b; b.bar = bar; b.x = xb_xcc_id(); b.st = st;
    if (threadIdx.x == 0) (void)xb_add(&bar[XB_XCNT(b.x)], 1u);
    return b;
}
DI void xcd_barrier_complete(unsigned* bar, unsigned x, unsigned& nloc, unsigned& nx) {
    const unsigned G = gridDim.x * gridDim.y * gridDim.z;
    unsigned sum, cnt, mine, sp = 0u;
    for (;;) {
        sum = 0u; cnt = 0u; mine = 0u;
#pragma unroll
        for (unsigned j = 0; j < 16; ++j) { const unsigned c = xb_ld(&bar[XB_XCNT(j)]); sum += c; cnt += (c > 0u) ? 1u : 0u; mine = (j == x) ? c : mine; }
        if (sum == G) break;
        __builtin_amdgcn_s_sleep(1);
        if ((++sp & 255u) == 0u) { if (xb_ld(&bar[XB_TMO])) break; if (sp > XB_SPIN_CAP) { atomicAdd(&bar[XB_TMO], 1u); break; } }
    }
    nloc = mine > 0u ? mine : 1u; nx = cnt > 0u ? cnt : 1u;
}
DI void xcd_barrier(const XcdBarrier& b) {
    asm volatile("s_waitcnt vmcnt(0)" ::: "memory");
    __syncthreads();
    if (threadIdx.x == 0) {
        unsigned* bar = b.bar;
        __builtin_amdgcn_s_waitcnt(0);
        __builtin_amdgcn_fence(__ATOMIC_ACQUIRE, "agent");
        unsigned nloc = b.st[0], nx = b.st[1];
        if (nloc == 0u) { xcd_barrier_complete(bar, b.x, nloc, nx); b.st[0] = nloc; b.st[1] = nx; }
        const unsigned old = xb_add(&bar[XB_XSUB(b.x)], 1u);
        const unsigned gen = old / nloc;
        if (old + 1u == (gen + 1u) * nloc) {
            __builtin_amdgcn_fence(__ATOMIC_RELEASE, "agent");
            asm volatile("s_waitcnt vmcnt(0)" ::: "memory");
            const unsigned og = xb_add(&bar[XB_TOP], 1u);
            const unsigned tg = og / nx;
            if (og + 1u == (tg + 1u) * nx) xb_add(&bar[XB_TOPGEN], 1u);
            else XB_SPIN(xb_ld(&bar[XB_TOPGEN]) == tg, bar);
            xb_add(&bar[XB_XGEN(b.x)], 1u);
            asm volatile("s_waitcnt vmcnt(0)" ::: "memory");
        } else {
            XB_SPIN(xb_ld(&bar[XB_XGEN(b.x)]) == gen, bar);
            asm volatile("s_waitcnt vmcnt(0)" ::: "memory");
        }
    }
    __syncthreads();
}

struct Frame {
    LAS unsigned char* lds;
    int tid, lane, wave, vcu, G;
    unsigned char* ws;
    const float* const* in;
    float* out;
};

struct TJob { const float* W; const float* ks; bf16_t* out; int K, N, ldo, coff, upmap, ntile; };
constexpr int TRS = 260;
DI void tr_load(const TJob& J, int tile, int wave, int lane, f32x4 (&v)[8]) {
    const int nb = J.N >> 8, kb = tile / nb, n0 = (tile - kb * nb) << 8, k0 = kb << 6;
    const float* src = J.W + (size_t)(k0 + 8 * wave) * J.N + n0 + 4 * lane;
#pragma unroll
    for (int i = 0; i < 8; ++i) v[i] = *(const f32x4*)(src + (size_t)i * J.N);
    if (J.ks) {
#pragma unroll
        for (int i = 0; i < 8; ++i) v[i] = v[i] * J.ks[k0 + 8 * wave + i];
    }
}
DI void tr_to_lds(LAS unsigned* P, int wave, int lane, const f32x4 (&v)[8]) {
#pragma unroll
    for (int i = 0; i < 4; ++i) {
        u32x4 w; w.x = pk2(v[2 * i].x, v[2 * i + 1].x); w.y = pk2(v[2 * i].y, v[2 * i + 1].y); w.z = pk2(v[2 * i].z, v[2 * i + 1].z); w.w = pk2(v[2 * i].w, v[2 * i + 1].w);
        *(LAS u32x4*)(P + (4 * wave + i) * TRS + 4 * lane) = w;
    }
}
DI void tr_store(const TJob& J, int tile, LAS const unsigned* P, int wave, int lane) {
    const int nb = J.N >> 8, kb = tile / nb, n0 = (tile - kb * nb) << 8, k0 = kb << 6;
    const int c = lane & 7;
#pragma unroll
    for (int jj = 0; jj < 4; ++jj) {
        const int nl = 32 * wave + 8 * jj + (lane >> 3), n = n0 + nl;
        u32x4 w; w.x = P[(4 * c + 0) * TRS + nl]; w.y = P[(4 * c + 1) * TRS + nl]; w.z = P[(4 * c + 2) * TRS + nl]; w.w = P[(4 * c + 3) * TRS + nl];
        int orow = n;
        if (J.upmap == 1) { const int b128 = n >> 7, half = b128 >= 43 ? 1 : 0; orow = 256 * (b128 - 43 * half) + 128 * half + (n & 127); }
        if (J.upmap == 2 && n >= DP && n < DP + 4 * DH) {
            const int sec = (n - DP) >> 10, c = (n - DP) & 1023, t = c >> 6, cc = c & 63;
            orow = DP + 256 * t + 128 * (sec >> 1) + 8 * (cc >> 2) + 4 * (sec & 1) + (cc & 3); }
        if (J.upmap == 2 && n >= DP + 4 * DH) {
            const int g = n - (DP + 4 * DH), half = g >= DM ? 1 : 0, ch = g - half * DM; orow = DP + 4 * DH + 256 * (ch >> 7) + 128 * half + (ch & 127); }
        *(u32x4*)(J.out + (size_t)orow * J.ldo + J.coff + k0 + 8 * c) = w;
    }
}
constexpr int TJ_NT[7] = {(DM / 64) * (DIN / 256), (DM / 64) * (DFF2 / 256), (DFF / 64) * (DM / 256), (DH / 64) * (DM / 256), (DM / 64) * (DM / 256), (DM / 64) * (DM / 256), (PLE / 64) * (DM / 256)};
constexpr int TJ_B1 = TJ_NT[0], TJ_B2 = TJ_B1 + TJ_NT[1], TJ_B3 = TJ_B2 + TJ_NT[2], TJ_B4 = TJ_B3 + TJ_NT[3], TJ_B5 = TJ_B4 + TJ_NT[4], TJ_B6 = TJ_B5 + TJ_NT[5], TJ_TOTAL = TJ_B6 + TJ_NT[6];
DI TJob tr_job(const Frame& F, int g, int& tile) {
    unsigned char* ws = F.ws; TJob J;
    if (g < TJ_B1)      { J = TJob{F.in[3],  F.in[2],  (bf16_t*)(ws + WS_WIN),   DM,  DIN,  DM,  0,  2, 0}; tile = g; }
    else if (g < TJ_B2) { J = TJob{F.in[12], F.in[11], (bf16_t*)(ws + WS_WUP),   DM,  DFF2, DM,  0,  1, 0}; tile = g - TJ_B1; }
    else if (g < TJ_B3) { J = TJob{F.in[15], nullptr,  (bf16_t*)(ws + WS_WDOWN), DFF, DM,   DFF, 0,  0, 0}; tile = g - TJ_B2; }
    else if (g < TJ_B4) { J = TJob{F.in[9],  nullptr,  (bf16_t*)(ws + WS_WAB),   DH,  DM,   DM,  DP, 0, 0}; tile = g - TJ_B3; }
    else if (g < TJ_B5) { J = TJob{F.in[10], nullptr,  (bf16_t*)(ws + WS_WOUT),  DM,  DM,   DM,  0,  0, 0}; tile = g - TJ_B4; }
    else if (g < TJ_B6) { J = TJob{F.in[17], F.in[16], (bf16_t*)(ws + WS_WPG),   DM,  DM,   DM,  0,  0, 0}; tile = g - TJ_B5; }
    else                { J = TJob{F.in[18], nullptr,  (bf16_t*)(ws + WS_WPLE),  PLE, DM,   PLE, 0,  0, 0}; tile = g - TJ_B6; }
    return J;
}
DI void p0_transpose_win(Frame& F) {
    LAS unsigned* P = (LAS unsigned*)F.lds;
    f32x4 v[8];
    int g = F.vcu, tile = 0;
    bool have = g < TJ_B1;
    TJob Jc{}, Jn{}; int tc = 0;
    if (have) { Jn = tr_job(F, g, tile); tr_load(Jn, tile, F.wave, F.lane, v); }
    while (have) {
        tr_to_lds(P, F.wave, F.lane, v);
        __syncthreads();
        Jc = Jn; tc = tile;
        g += F.G; have = g < TJ_B1;
        if (have) { Jn = tr_job(F, g, tile); tr_load(Jn, tile, F.wave, F.lane, v); }
        tr_store(Jc, tc, P, F.wave, F.lane);
        __syncthreads();
    }
}
DI void p0_fold_wa(Frame& F, const float* wmix, const float* scale, const float* wa, bf16_t* WAB, int tile) {
    const int g = tile >> 6, c0 = 64 * ((tile >> 4) & 3), n0 = 128 * (tile & 15);
    const int ci = F.wave & 1, ni = F.wave >> 1, r = F.lane & 31, kh = F.lane >> 5;
    const float* arow = wmix + ((size_t)g * 256 + c0 + 32 * ci + r) * 256;
    const float* bcol = wa + (size_t)(g * 256) * DM + n0 + 32 * ni + r;
    const float* sc = scale + g * 256;
    f32x16 acc;
#pragma unroll
    for (int i = 0; i < 16; ++i) acc[i] = 0.f;
#pragma unroll 1
    for (int q0 = 0; q0 < 64; q0 += 8) {
        f32x4 av[8]; float bv[16];
#pragma unroll
        for (int i = 0; i < 8; ++i) av[i] = *(const f32x4*)(arow + 4 * (q0 + i));
#pragma unroll
        for (int j = 0; j < 16; ++j) { const int d = 4 * q0 + 2 * j + kh; bv[j] = sc[d] * bcol[(size_t)d * DM]; }
#pragma unroll
        for (int i = 0; i < 8; ++i) {
            acc = __builtin_amdgcn_mfma_f32_32x32x2f32(kh ? av[i].y : av[i].x, bv[2 * i], acc, 0, 0, 0);
            acc = __builtin_amdgcn_mfma_f32_32x32x2f32(kh ? av[i].w : av[i].z, bv[2 * i + 1], acc, 0, 0, 0);
        }
    }
    bf16_t* orow = WAB + (size_t)(n0 + 32 * ni + r) * DM + g * 256 + c0 + 32 * ci + 4 * kh;
#pragma unroll
    for (int i4 = 0; i4 < 4; ++i4) { u32x2 w; w.x = pk2(acc[4 * i4], acc[4 * i4 + 1]); w.y = pk2(acc[4 * i4 + 2], acc[4 * i4 + 3]); *(u32x2*)(orow + 8 * i4) = w; }
}

DI void p0_prologue(Frame& F) {
    unsigned char* ws = F.ws;
    const int gw = F.vcu * NWAVES + F.wave, NGW = F.G * NWAVES;
    {
        const float* x = F.in[0]; bf16_t* XB = (bf16_t*)(ws + WS_XB); float* R1 = (float*)(ws + WS_R1);
        for (int m = gw; m < S; m += NGW) {
            const f32x4* xr = (const f32x4*)(x + (size_t)m * DM) + F.lane;
            f32x4 v[8]; float s = 0.f;
#pragma unroll
            for (int j = 0; j < 8; ++j) { v[j] = xr[64 * j]; s += (v[j].x * v[j].x + v[j].y * v[j].y) + (v[j].z * v[j].z + v[j].w * v[j].w); }
            s = wave_sum(s);
            if (F.lane == 0) R1[m] = rsqrtf(s * (1.f / DM) + EPS);
            u32x2* o = (u32x2*)(XB + (size_t)m * DM) + F.lane;
#pragma unroll
            for (int j = 0; j < 8; ++j) { u32x2 w; w.x = pk2(v[j].x, v[j].y); w.y = pk2(v[j].z, v[j].w); o[64 * j] = w; }
        }
    }
    {
        const f32x4* p = (const f32x4*)F.in[1]; u32x2* PB = (u32x2*)(ws + WS_PB);
        const int gt = F.vcu * 512 + F.tid, NGT = F.G * 512;
        for (int i = gt; i < S * PLE / 4; i += NGT) { const f32x4 v = p[i]; u32x2 w; w.x = pk2(v.x, v.y); w.y = pk2(v.z, v.w); PB[i] = w; }
        float* LB = (float*)(ws + WS_LB); const float* lbl = F.in[6];
        if (gt < DH) { const float l0 = lbl[gt], l1 = lbl[DH + gt], mx = fmaxf(l0, l1), e0 = __expf(l0 - mx), e1 = __expf(l1 - mx); LB[gt] = e0 / (e0 + e1); }
    }
    p0_transpose_win(F);
}
constexpr int CW_QUEUE = 20480;
DI void convert_rest(Frame& F) {
    unsigned* head = (unsigned*)(F.ws + WS_CTL) + CW_QUEUE;
    volatile LAS unsigned* slot = (volatile LAS unsigned*)(F.lds + MISC_OFF) + 20;
    LAS unsigned* P = (LAS unsigned*)F.lds;
    constexpr int NFOLD = 256, NITEM = NFOLD + (TJ_TOTAL - TJ_B1);
    for (;;) {
        __syncthreads();
        if (F.tid == 0) slot[0] = __hip_atomic_fetch_add(head, 1u, __ATOMIC_RELAXED, __HIP_MEMORY_SCOPE_AGENT);
        __syncthreads();
        const int item = (int)__builtin_amdgcn_readfirstlane(slot[0]);
        if (item >= NITEM) break;
        if (item < NFOLD) { p0_fold_wa(F, F.in[4], F.in[5], F.in[8], (bf16_t*)(F.ws + WS_WAB), item); }
        else {
            int tile = 0; const TJob J = tr_job(F, TJ_B1 + item - NFOLD, tile);
            f32x4 v[8];
            tr_load(J, tile, F.wave, F.lane, v);
            tr_to_lds(P, F.wave, F.lane, v);
            __syncthreads();
            tr_store(J, tile, P, F.wave, F.lane);
        }
    }
}


DI float row_rstd(const float* ssq, int row, int fq) {
    const f32x4* p = (const f32x4*)(ssq + (size_t)row * 32 + fq * 8);
    const f32x4 a = p[0], b = p[1];
    float s = ((a.x + a.y) + (a.z + a.w)) + ((b.x + b.y) + (b.z + b.w));
    s += __shfl_xor(s, 16); s += __shfl_xor(s, 32);
    return rsqrtf(s * (1.f / DM) + EPS);
}

DI void row_rstd8(const float* ssq, int row0, int fq, float (&r)[2][4]) {
    f32x4 a[2][4], b[2][4];
#pragma unroll
    for (int ai = 0; ai < 2; ++ai)
#pragma unroll
        for (int m = 0; m < 4; ++m) { const f32x4* p = (const f32x4*)(ssq + (size_t)(row0 + ai * 128 + m * 16) * 32 + fq * 8); a[ai][m] = p[0]; b[ai][m] = p[1]; }
#pragma unroll
    for (int ai = 0; ai < 2; ++ai)
#pragma unroll
        for (int m = 0; m < 4; ++m) {
            float s = ((a[ai][m].x + a[ai][m].y) + (a[ai][m].z + a[ai][m].w)) + ((b[ai][m].x + b[ai][m].y) + (b[ai][m].z + b[ai][m].w));
            s += __shfl_xor(s, 16); s += __shfl_xor(s, 32);
            r[ai][m] = rsqrtf(s * (1.f / DM) + EPS);
        }
}
DI void lds_read4x16(unsigned addr, f32x4& a, f32x4& b, f32x4& c, f32x4& d) {
    asm volatile("ds_read_b128 %0, %4\n\tds_read_b128 %1, %4 offset:1024\n\tds_read_b128 %2, %4 offset:2048\n\tds_read_b128 %3, %4 offset:3072\n\ts_waitcnt lgkmcnt(0)"
                 : "=&v"(a), "=&v"(b), "=&v"(c), "=&v"(d) : "v"(addr) : "memory");
}

struct EpiProj {
    static constexpr int MIDK = 0; static constexpr bool AFTER_DRAIN = false; static constexpr bool HAS_PRE = false;
    unsigned char* ws; float* dout;
    DI void operator()(const AccT& acc, const Unit& u, int wr, int wc, int fr, int fq) const {
        asm volatile("" : "+v"(fr), "+v"(fq));
        const float* R1 = (const float*)(ws + WS_R1);
        const int pn = u.pn, row0 = u.pm * 256 + wr * 64 + fr, cl = wc * 32 + 8 * fq;
        float rs[2][4];
#pragma unroll
        for (int ai = 0; ai < 2; ++ai)
#pragma unroll
            for (int m = 0; m < 4; ++m) rs[ai][m] = R1[row0 + ai * 128 + m * 16];
        if (pn >= 4 && pn < 20) {
            const float* LB = (const float*)(ws + WS_LB); bf16_t* Qp = (bf16_t*)(ws + WS_Q); bf16_t* K2 = (bf16_t*)(ws + WS_KK);
            bf16_t* Vo = (bf16_t*)(ws + WS_V); bf16_t* SGo = (bf16_t*)(ws + WS_SG); float* DL = (float*)(ws + WS_DL);
            const int t = pn - 4, hd = t >> 1, k4 = 64 * (t & 1) + 16 * wc + 4 * fq;
            const int lane = fq * 16 + fr, bsel = ((lane & ~15) | 15) << 2;
            const f32x4 lb = *(const f32x4*)(LB + hd * 128 + k4);
#pragma unroll
            for (int ai = 0; ai < 2; ++ai) {
                f32x4 lf[4], kk[4];
#pragma unroll
                for (int m = 0; m < 4; ++m)
#pragma unroll
                    for (int c = 0; c < 4; ++c) { const float v = acc[ai][0][m][1][c] * rs[ai][m]; const float sg = sigm(v); const float f = lb[c] + (1.f - lb[c]) * sg;
                        lf[m][c] = __logf(f); kk[m][c] = (1.f - lb[c]) * (1.f - sg); }
                f32x4 b63;
#pragma unroll
                for (int c = 0; c < 4; ++c) {
                    float carry = 0.f;
#pragma unroll
                    for (int m = 0; m < 4; ++m) {
                        float x = lf[m][c];
                        x += dppf<0x111>(x); x += dppf<0x112>(x); x += dppf<0x114>(x); x += dppf<0x118>(x);
                        const float tot = __builtin_bit_cast(float, __builtin_amdgcn_ds_bpermute(bsel, __builtin_bit_cast(int, x)));
                        lf[m][c] = x + carry; carry += tot;
                    }
                    b63[c] = carry;
                }
                const int chunk = 4 * u.pm + 2 * ai + wr;
                if (fr == 0) { f32x4 e63; e63.x = __expf(b63.x); e63.y = __expf(b63.y); e63.z = __expf(b63.z); e63.w = __expf(b63.w); *(f32x4*)(DL + (size_t)chunk * DH + hd * 128 + k4) = e63; }
#pragma unroll
                for (int m = 0; m < 4; ++m) {
                    const size_t of = (size_t)(chunk * 8 + hd) * 8192 + fq_off(m >> 1, 4 * (t & 1) + wc, 16 * (m & 1) + fr + 32 * (fq >> 1)) + 4 * (fq & 1);
                    const size_t orow = (size_t)(row0 + ai * 128 + m * 16) * DH + hd * 128 + k4;
                    f32x4 qp, k2, vv, sgv;
#pragma unroll
                    for (int c = 0; c < 4; ++c) {
                        const float ex = __expf(lf[m][c]);
                        qp[c] = acc[ai][0][m][0][c] * rs[ai][m] * ex; k2[c] = kk[m][c] * __builtin_amdgcn_rcpf(ex);
                        vv[c] = acc[ai][1][m][0][c] * rs[ai][m]; const float g = acc[ai][1][m][1][c] * rs[ai][m]; sgv[c] = g * sigm(g);
                    }
                    u32x2 w;
                    w.x = pk2(qp.x, qp.y); w.y = pk2(qp.z, qp.w); *(u32x2*)(Qp + of) = w;
                    w.x = pk2(k2.x, k2.y); w.y = pk2(k2.z, k2.w); *(u32x2*)(K2 + of) = w;
                    w.x = pk2(vv.x, vv.y); w.y = pk2(vv.z, vv.w); *(u32x2*)(Vo + orow) = w;
                    w.x = pk2(sgv.x, sgv.y); w.y = pk2(sgv.z, sgv.w); *(u32x2*)(SGo + orow) = w;
                }
            }
        } else if (pn >= 20) {
            bf16_t* RT = (bf16_t*)dout; bf16_t* GBo = (bf16_t*)dout + (size_t)S * DM;
            const int ch0 = 128 * (pn - 20) + cl;
#pragma unroll
            for (int ai = 0; ai < 2; ++ai)
#pragma unroll
                for (int m = 0; m < 4; ++m) {
                    const size_t o = (size_t)(row0 + ai * 128 + m * 16) * DM + ch0;
                    f32x4 r0, r1, g0, g1;
#pragma unroll
                    for (int c = 0; c < 4; ++c) {
                        const float ea0 = __expf(-__builtin_amdgcn_fmed3f(acc[ai][0][m][0][c] * rs[ai][m], -60.f, 60.f)), eb0 = __expf(-__builtin_amdgcn_fmed3f(acc[ai][1][m][0][c] * rs[ai][m], -60.f, 60.f));
                        const float ea1 = __expf(-__builtin_amdgcn_fmed3f(acc[ai][0][m][1][c] * rs[ai][m], -60.f, 60.f)), eb1 = __expf(-__builtin_amdgcn_fmed3f(acc[ai][1][m][1][c] * rs[ai][m], -60.f, 60.f));
                        r0[c] = (1.0f + eb0) * __builtin_amdgcn_rcpf(1.0f + ea0); g0[c] = __builtin_amdgcn_rcpf(1.0f + eb0);
                        r1[c] = (1.0f + eb1) * __builtin_amdgcn_rcpf(1.0f + ea1); g1[c] = __builtin_amdgcn_rcpf(1.0f + eb1);
                    }
                    *(u32x4*)(RT + o) = pack8(r0, r1); *(u32x4*)(GBo + o) = pack8(g0, g1);
                }
        } else {
        bf16_t* O = (bf16_t*)(ws + WS_UP);
#pragma unroll
        for (int ai = 0; ai < 2; ++ai)
#pragma unroll
            for (int m = 0; m < 4; ++m) {
                bf16_t* rowp = O + (size_t)(row0 + ai * 128 + m * 16) * DP + pn * 256 + cl;
#pragma unroll
                for (int bj = 0; bj < 2; ++bj) *(u32x4*)(rowp + bj * 128) = pack8(acc[ai][bj][m][0] * rs[ai][m], acc[ai][bj][m][1] * rs[ai][m]);
            }
        }
        asm volatile("" :: "v"(rs[0][0]), "v"(rs[0][1]), "v"(rs[0][2]), "v"(rs[0][3]), "v"(rs[1][0]), "v"(rs[1][1]), "v"(rs[1][2]), "v"(rs[1][3]));
    }
};

struct EpiBf {
    static constexpr int MIDK = 0; static constexpr bool AFTER_DRAIN = false; static constexpr bool HAS_PRE = false;
    bf16_t* O; int ld;
    DI void operator()(const AccT& acc, const Unit& u, int wr, int wc, int fr, int fq) const {
        asm volatile("" : "+v"(fr), "+v"(fq));
        const int row0 = u.pm * 256 + wr * 64 + fr, col0 = u.pn * 256 + wc * 32 + 8 * fq;
#pragma unroll
        for (int ai = 0; ai < 2; ++ai)
#pragma unroll
            for (int m = 0; m < 4; ++m)
#pragma unroll
                for (int bj = 0; bj < 2; ++bj) *(u32x4*)(O + (size_t)(row0 + ai * 128 + m * 16) * ld + col0 + bj * 128) = pack8(acc[ai][bj][m][0], acc[ai][bj][m][1]);
    }
};
template <int MODE> struct EpiGate {
    static constexpr int MIDK = 0; static constexpr bool AFTER_DRAIN = false; static constexpr bool HAS_PRE = false;
    const bf16_t* G; float* TMP; bf16_t* MG;
    DI void operator()(const AccT& acc, const Unit& u, int wr, int wc, int fr, int fq) const {
        asm volatile("" : "+v"(fr), "+v"(fq));
        const int row0 = u.pm * 256 + wr * 64 + fr, col0 = u.pn * 256 + wc * 32 + 8 * fq;
#pragma unroll
        for (int ai = 0; ai < 2; ++ai)
#pragma unroll
            for (int m = 0; m < 4; ++m)
#pragma unroll
                for (int bj = 0; bj < 2; ++bj) {
                    const size_t o = (size_t)(row0 + ai * 128 + m * 16) * DM + col0 + bj * 128;
                    f32x4 g0, g1; unpack8(*(const u32x4*)(G + o), g0, g1);
                    f32x4 v0 = acc[ai][bj][m][0] * g0, v1 = acc[ai][bj][m][1] * g1;
                    if (MODE == 0) { *(f32x4*)(TMP + o) = v0; *(f32x4*)(TMP + o + 4) = v1; }
                    else { v0 += *(const f32x4*)(TMP + o); v1 += *(const f32x4*)(TMP + o + 4); *(u32x4*)(MG + o) = pack8(v0, v1); }
                }
    }
};
struct EpiMerge {
    static constexpr int MIDK = 16; static constexpr bool AFTER_DRAIN = false; static constexpr bool HAS_PRE = false;
    const bf16_t* GA; const bf16_t* GB; bf16_t* MG;
    DI void mid(AccT& acc, const Unit& u, int wr, int wc, int fr, int fq) const {
        asm volatile("" : "+v"(fr), "+v"(fq));
        const int row0 = u.pm * 256 + wr * 64 + fr, col0 = u.pn * 256 + wc * 32 + 8 * fq;
#pragma unroll
        for (int ai = 0; ai < 2; ++ai)
#pragma unroll
            for (int m = 0; m < 4; ++m)
#pragma unroll
                for (int bj = 0; bj < 2; ++bj) {
                    const size_t o = (size_t)(row0 + ai * 128 + m * 16) * DM + col0 + bj * 128;
                    f32x4 a0, a1; unpack8(*(const u32x4*)(GA + o), a0, a1);
                    acc[ai][bj][m][0] = acc[ai][bj][m][0] * a0; acc[ai][bj][m][1] = acc[ai][bj][m][1] * a1;
                }
    }
    DI void operator()(const AccT& acc, const Unit& u, int wr, int wc, int fr, int fq) const {
        asm volatile("" : "+v"(fr), "+v"(fq));
        const int row0 = u.pm * 256 + wr * 64 + fr, col0 = u.pn * 256 + wc * 32 + 8 * fq;
#pragma unroll
        for (int ai = 0; ai < 2; ++ai)
#pragma unroll
            for (int m = 0; m < 4; ++m)
#pragma unroll
                for (int bj = 0; bj < 2; ++bj) {
                    const size_t o = (size_t)(row0 + ai * 128 + m * 16) * DM + col0 + bj * 128;
                    f32x4 b0, b1; unpack8(*(const u32x4*)(GB + o), b0, b1);
                    *(u32x4*)(MG + o) = pack8(acc[ai][bj][m][0] * b0, acc[ai][bj][m][1] * b1);
                }
    }
};
template <bool BF> struct EpiResB {
    static constexpr int MIDK = 0; static constexpr bool AFTER_DRAIN = false; static constexpr bool HAS_PRE = false;
    const void* base; bf16_t* xb; float* ssq;
    DI void operator()(const AccT& acc, const Unit& u, int wr, int wc, int fr, int fq) const {
        asm volatile("" : "+v"(fr), "+v"(fq));
        const int row0 = u.pm * 256 + wr * 64 + fr, col0 = u.pn * 256 + wc * 32 + 8 * fq;
#pragma unroll
        for (int ai = 0; ai < 2; ++ai)
#pragma unroll
            for (int m = 0; m < 4; ++m) {
                const int row = row0 + ai * 128 + m * 16; float s = 0.f;
#pragma unroll
                for (int bj = 0; bj < 2; ++bj) {
                    const size_t o = (size_t)row * DM + col0 + bj * 128;
                    f32x4 x0, x1;
                    if (BF) unpack8(*(const u32x4*)((const bf16_t*)base + o), x0, x1);
                    else { x0 = *(const f32x4*)((const float*)base + o); x1 = *(const f32x4*)((const float*)base + o + 4); }
                    const f32x4 v0 = acc[ai][bj][m][0] + x0, v1 = acc[ai][bj][m][1] + x1;
                    *(u32x4*)(xb + o) = pack8(v0, v1);
                    s += ((v0.x * v0.x + v0.y * v0.y) + (v0.z * v0.z + v0.w * v0.w)) + ((v1.x * v1.x + v1.y * v1.y) + (v1.z * v1.z + v1.w * v1.w));
                }
                s += __shfl_xor(s, 16); s += __shfl_xor(s, 32);
                if (fq == 0) ssq[(size_t)row * 32 + u.pn * 4 + wc] = s;
            }
    }
};
struct EpiRes {
    static constexpr int MIDK = 0; static constexpr bool AFTER_DRAIN = false; static constexpr bool HAS_PRE = false;
    const float* base; float* xo; bf16_t* xb; float* ssq;
    DI void operator()(const AccT& acc, const Unit& u, int wr, int wc, int fr, int fq) const {
        asm volatile("" : "+v"(fr), "+v"(fq));
        const int row0 = u.pm * 256 + wr * 64 + fr, col0 = u.pn * 256 + wc * 32 + 8 * fq;
#pragma unroll
        for (int ai = 0; ai < 2; ++ai)
#pragma unroll
            for (int m = 0; m < 4; ++m) {
                const int row = row0 + ai * 128 + m * 16; float s = 0.f;
#pragma unroll
                for (int bj = 0; bj < 2; ++bj) {
                    const size_t o = (size_t)row * DM + col0 + bj * 128;
                    const f32x4 v0 = acc[ai][bj][m][0] + *(const f32x4*)(base + o), v1 = acc[ai][bj][m][1] + *(const f32x4*)(base + o + 4);
                    *(f32x4*)(xo + o) = v0; *(f32x4*)(xo + o + 4) = v1; *(u32x4*)(xb + o) = pack8(v0, v1);
                    s += ((v0.x * v0.x + v0.y * v0.y) + (v0.z * v0.z + v0.w * v0.w)) + ((v1.x * v1.x + v1.y * v1.y) + (v1.z * v1.z + v1.w * v1.w));
                }
                s += __shfl_xor(s, 16); s += __shfl_xor(s, 32);
                if (fq == 0) ssq[(size_t)row * 32 + u.pn * 4 + wc] = s;
            }
    }
};
constexpr int CONV_LDS = 131584;
struct EpiUp {
    static constexpr int MIDK = 0; static constexpr bool AFTER_DRAIN = false; static constexpr bool HAS_PRE = true;
    unsigned char* ws; const float* cw; const float* cb; LAS unsigned char* lds;
    DI void pre(LAS unsigned char* l, const Unit& u, int wid, int lane) const {
        if (wid < 4) {
            const int col = (lane < 32) ? 128 * u.pn + 4 * lane : DFF + 128 * u.pn + 4 * (lane - 32);
            const float* src = (wid < 3 ? cw + (size_t)wid * DFF2 : cb) + col;
            __builtin_amdgcn_global_load_lds((const unsigned*)src, (LAS unsigned*)(l + CONV_LDS + (u.ui & 1) * 4096 + wid * 1024), 16, 0, 0);
        }
    }
    DI void operator()(const AccT& acc, const Unit& u, int wr, int wc, int fr, int fq) const {
        asm volatile("" : "+v"(fr), "+v"(fq));
        const float* SSQ = (const float*)(ws + WS_SSQ1); bf16_t* ACT = (bf16_t*)(ws + WS_ACT); float* ZB = (float*)(ws + WS_ZB);
        const int row0 = u.pm * 256 + wr * 64 + fr, j = u.pn;
#pragma unroll
        for (int ai = 0; ai < 2; ++ai) {
            float r2[4];
#pragma unroll
            for (int m = 0; m < 4; ++m) r2[m] = row_rstd(SSQ, row0 + ai * 128 + m * 16, fq);
            const int blk = 4 * u.pm + 2 * ai + wr;
#pragma unroll
            for (int n = 0; n < 2; ++n) {
                int fq2 = fq; asm volatile("" : "+v"(fq2));
                const int ch = 128 * j + 32 * wc + 8 * fq2 + 4 * n;
                const int pc = 256 * j + 32 * wc + 8 * fq2 + 4 * n;
                const unsigned cbase = (unsigned)(size_t)(lds + CONV_LDS + (u.ui & 1) * 4096) + (unsigned)(32 * wc + 8 * fq2) * 4u;
                float* zb = ZB + (size_t)blk * 4 * DFF2 + pc;
                if (fr < 2) { *(f32x4*)(zb + (size_t)fr * DFF2) = acc[ai][0][0][n] * r2[0]; *(f32x4*)(zb + (size_t)fr * DFF2 + 128) = acc[ai][1][0][n] * r2[0]; }
                if (fr >= 14) { *(f32x4*)(zb + (size_t)(fr - 12) * DFF2) = acc[ai][0][3][n] * r2[3]; *(f32x4*)(zb + (size_t)(fr - 12) * DFF2 + 128) = acc[ai][1][3][n] * r2[3]; }
                f32x4 uv[4];
                {
                    f32x4 w0, w1, w2, bb; lds_read4x16(cbase + (128 + 4 * n) * 4u, w0, w1, w2, bb);
#pragma unroll
                    for (int m = 0; m < 4; ++m) {
                        const f32x4 zc = acc[ai][1][m][n] * r2[m], zp = acc[ai][1][m > 0 ? m - 1 : 0][n] * r2[m > 0 ? m - 1 : 0];
#pragma unroll
                        for (int c = 0; c < 4; ++c) {
                            const float s1 = (m > 0 && fr == 15) ? zp[c] : zc[c], s2 = (m > 0 && fr >= 14) ? zp[c] : zc[c];
                            uv[m][c] = bb[c] + w2[c] * zc[c] + w1[c] * dppf<0x121>(s1) + w0[c] * dppf<0x122>(s2);
                        }
                    }
                }
                {
                    f32x4 w0, w1, w2, bb; lds_read4x16(cbase + (4 * n) * 4u, w0, w1, w2, bb);
#pragma unroll
                    for (int m = 0; m < 4; ++m) {
                        const f32x4 zc = acc[ai][0][m][n] * r2[m], zp = acc[ai][0][m > 0 ? m - 1 : 0][n] * r2[m > 0 ? m - 1 : 0];
                        f32x4 ug;
#pragma unroll
                        for (int c = 0; c < 4; ++c) {
                            const float s1 = (m > 0 && fr == 15) ? zp[c] : zc[c], s2 = (m > 0 && fr >= 14) ? zp[c] : zc[c];
                            ug[c] = bb[c] + w2[c] * zc[c] + w1[c] * dppf<0x121>(s1) + w0[c] * dppf<0x122>(s2);
                        }
                        if (m > 0 || fr >= 2) {
                            u32x2 w; w.x = pk2(ug.x * sigm(ug.x) * uv[m].x, ug.y * sigm(ug.y) * uv[m].y); w.y = pk2(ug.z * sigm(ug.z) * uv[m].z, ug.w * sigm(ug.w) * uv[m].w);
                            *(u32x2*)(ACT + (size_t)(row0 + ai * 128 + m * 16) * DFF + ch) = w;
                        }
                    }
                }
                __builtin_amdgcn_sched_barrier(0);
            }
        }
    }
};
struct EpiUpKS {
    static constexpr int MIDK = 0; static constexpr bool AFTER_DRAIN = true; static constexpr bool HAS_PRE = true;
    EpiUp base;
    DI void pre(LAS unsigned char* l, const Unit& u, int wid, int lane) const {
        base.pre(l, u, wid, lane);
        if (u.kind == 1 && wid == 0 && lane == 0) __hip_atomic_store((unsigned*)(base.ws + WS_CTL) + CW_KS + 64 * u.sl + 1, 1u + xb_xcc_id(), __ATOMIC_RELAXED, __HIP_MEMORY_SCOPE_AGENT);
    }
    DI void fused(AccT& acc, const Unit& u, int wr, int wc, int fr, int fq) const {
        int f0 = fr, f1 = fq; asm volatile("" : "+v"(f0), "+v"(f1));
        float* slab = (float*)(base.ws + WS_SLAB) + (size_t)u.sl * 65536 + (size_t)(((wr * 4 + wc) * 64 + f1 * 16 + f0) * 4);
        unsigned* flag = (unsigned*)(base.ws + WS_CTL) + CW_KS + 64 * u.sl;
        if (u.kind == 2) {
#pragma unroll
            for (int a = 0; a < 2; ++a)
#pragma unroll
                for (int b = 0; b < 2; ++b)
#pragma unroll
                    for (int m = 0; m < 4; ++m)
#pragma unroll
                        for (int n = 0; n < 2; ++n) *(f32x4*)(slab + (size_t)((((a * 2 + b) * 4 + m) * 2 + n) * 2048)) = acc[a][b][m][n];
            asm volatile("s_waitcnt vmcnt(0)" ::: "memory");
            __syncthreads();
            if (wr == 0 && wc == 0 && (f0 | f1) == 0) {
                const bool same_l2 = __hip_atomic_load(flag + 1, __ATOMIC_RELAXED, __HIP_MEMORY_SCOPE_AGENT) == 1u + xb_xcc_id();
                if (!same_l2) __builtin_amdgcn_fence(__ATOMIC_RELEASE, "agent");
                __hip_atomic_store(flag, 1u, __ATOMIC_RELAXED, __HIP_MEMORY_SCOPE_AGENT);
            }
            return;
        }
        if (wr == 0 && wc == 0) {
            unsigned spins = 0;
            while ((unsigned)__builtin_amdgcn_readfirstlane(__hip_atomic_load(flag, __ATOMIC_RELAXED, __HIP_MEMORY_SCOPE_AGENT)) == 0u) {
                __builtin_amdgcn_s_sleep(2);
                if (++spins > (1u << 22)) break;
            }
            __builtin_amdgcn_fence(__ATOMIC_ACQUIRE, "agent");
            asm volatile("s_waitcnt vmcnt(0)" ::: "memory");
        }
        __syncthreads();
#define KS_LOAD(t, g) _Pragma("unroll") for (int q = 0; q < 8; ++q) t[q] = *(const f32x4*)(sp + (size_t)(((g) * 8 + q) * 2048))
#define KS_ADD(t, g) do { _Pragma("unroll") for (int q = 0; q < 8; ++q) acc[(g) >> 1][(g) & 1][q >> 1][q & 1] += t[q]; \
            asm volatile("" : "+v"(sp), "+v"(acc[(g) >> 1][(g) & 1][0][0]), "+v"(acc[(g) >> 1][(g) & 1][0][1]), "+v"(acc[(g) >> 1][(g) & 1][1][0]), "+v"(acc[(g) >> 1][(g) & 1][1][1]), \
                         "+v"(acc[(g) >> 1][(g) & 1][2][0]), "+v"(acc[(g) >> 1][(g) & 1][2][1]), "+v"(acc[(g) >> 1][(g) & 1][3][0]), "+v"(acc[(g) >> 1][(g) & 1][3][1])); } while (0)
        {
            const float* sp = slab; asm volatile("" : "+v"(sp));
            f32x4 t0[8], t1[8];
            KS_LOAD(t0, 0); KS_LOAD(t1, 1);
            KS_ADD(t0, 0); KS_LOAD(t0, 2);
            KS_ADD(t1, 1); KS_LOAD(t1, 3);
            KS_ADD(t0, 2); KS_ADD(t1, 3);
        }
#undef KS_LOAD
#undef KS_ADD
        base(acc, u, wr, wc, fr, fq);
    }
};
constexpr int CW_PANEL = 16384;
struct EpiPle {
    static constexpr int MIDK = 0; static constexpr bool AFTER_DRAIN = true; static constexpr bool HAS_PRE = false;
    unsigned char* ws; float* xo; const float* wf;
    DI void fused(AccT& acc, const Unit& u, int wr, int wc, int fr, int fq) const {
        asm volatile("" : "+v"(fr), "+v"(fq));
        const float* SSQ = (const float*)(ws + WS_SSQ2); float* ssq = (float*)(ws + WS_SSQ3); const bf16_t* Eb = (const bf16_t*)(ws + WS_E); const bf16_t* X2 = (const bf16_t*)(ws + WS_XB);
        unsigned* cnt = (unsigned*)(ws + WS_CTL) + CW_PANEL + 64 * u.pm;
        const int row0 = u.pm * 256 + wr * 64 + fr, col0 = u.pn * 256 + wc * 32 + 8 * fq;
#pragma unroll
        for (int ai = 0; ai < 2; ++ai)
#pragma unroll
            for (int m = 0; m < 4; ++m) {
                const int row = row0 + ai * 128 + m * 16; float s = 0.f;
                const float r3 = row_rstd(SSQ, row, fq);
#pragma unroll
                for (int bj = 0; bj < 2; ++bj) {
                    const size_t o = (size_t)row * DM + col0 + bj * 128;
                    f32x4 e0, e1, v0, v1; unpack8(*(const u32x4*)(Eb + o), e0, e1); unpack8(*(const u32x4*)(X2 + o), v0, v1);
#pragma unroll
                    for (int c = 0; c < 4; ++c) { v0[c] += sigm(acc[ai][bj][m][0][c] * r3) * e0[c]; v1[c] += sigm(acc[ai][bj][m][1][c] * r3) * e1[c]; }
                    acc[ai][bj][m][0] = v0; acc[ai][bj][m][1] = v1;
                    s += ((v0.x * v0.x + v0.y * v0.y) + (v0.z * v0.z + v0.w * v0.w)) + ((v1.x * v1.x + v1.y * v1.y) + (v1.z * v1.z + v1.w * v1.w));
                }
                s += __shfl_xor(s, 16); s += __shfl_xor(s, 32);
                if (fq == 0) __hip_atomic_store((unsigned*)ssq + (size_t)row * 32 + u.pn * 4 + wc, __builtin_bit_cast(unsigned, s), __ATOMIC_RELAXED, __HIP_MEMORY_SCOPE_AGENT);
            }
        asm volatile("s_waitcnt vmcnt(0)" ::: "memory");
        if ((fr | fq) == 0) __hip_atomic_fetch_add(cnt, 1u, __ATOMIC_RELAXED, __HIP_MEMORY_SCOPE_AGENT);
        if (wr == 0 && wc == 0) {
            unsigned spins = 0;
            while ((unsigned)__builtin_amdgcn_readfirstlane(__hip_atomic_load(cnt, __ATOMIC_RELAXED, __HIP_MEMORY_SCOPE_AGENT)) < 64u) {
                __builtin_amdgcn_s_sleep(2);
                if (++spins > (1u << 22)) break;
            }
            __builtin_amdgcn_fence(__ATOMIC_ACQUIRE, "agent");
            asm volatile("s_waitcnt vmcnt(0)" ::: "memory");
        }
        __syncthreads();
        const f32x4 w00 = *(const f32x4*)(wf + col0), w01 = *(const f32x4*)(wf + col0 + 4), w10 = *(const f32x4*)(wf + col0 + 128), w11 = *(const f32x4*)(wf + col0 + 132);
#pragma unroll
        for (int ai = 0; ai < 2; ++ai)
#pragma unroll
            for (int m = 0; m < 4; ++m) {
                const int row = row0 + ai * 128 + m * 16;
                const float r4 = row_rstd(ssq, row, fq);
                const size_t o = (size_t)row * DM + col0;
                *(f32x4*)(xo + o) = acc[ai][0][m][0] * r4 * w00; *(f32x4*)(xo + o + 4) = acc[ai][0][m][1] * r4 * w01;
                *(f32x4*)(xo + o + 128) = acc[ai][1][m][0] * r4 * w10; *(f32x4*)(xo + o + 132) = acc[ai][1][m][1] * r4 * w11;
            }
    }
};

template <int W> DI void pool_item(const bf16_t* UP, bf16_t* DOB, int t0, int c0) {
    f32x4 ra[W + 7], rb[W + 7];
#pragma unroll
    for (int i = 0; i < W + 7; ++i) { const int t = t0 - (W - 1) + i; if (t >= 0) unpack8(*(const u32x4*)(UP + (size_t)t * DP + c0), ra[i], rb[i]); else { ra[i] = (f32x4){0.f, 0.f, 0.f, 0.f}; rb[i] = ra[i]; } }
    f32x4 sa = {0.f, 0.f, 0.f, 0.f}, sb = sa;
#pragma unroll
    for (int i = 0; i < W - 1; ++i) { sa += ra[i]; sb += rb[i]; }
#pragma unroll
    for (int j = 0; j < 8; ++j) {
        sa += ra[W - 1 + j]; sb += rb[W - 1 + j];
        const int t = t0 + j; const float inv = 1.f / (float)((t + 1 < W) ? t + 1 : W);
        *(u32x4*)(DOB + (size_t)t * DM + c0) = pack8(sa * inv - ra[W - 1 + j], sb * inv - rb[W - 1 + j]);
        sa -= ra[j]; sb -= rb[j];
    }
}
DI void pool_phase(Frame& F) {
    const bf16_t* UP = (const bf16_t*)(F.ws + WS_UP); bf16_t* DOB = (bf16_t*)(F.ws + WS_DOB);
    const int gt = F.vcu * 512 + F.tid, NGT = F.G * 512;
    for (int idx = gt; idx < (S / 8) * 128; idx += NGT) {
        const int t0 = (idx >> 7) * 8, c0 = (idx & 127) * 8, g = c0 >> 8;
        if (g == 0) pool_item<2>(UP, DOB, t0, c0); else if (g == 1) pool_item<4>(UP, DOB, t0, c0); else if (g == 2) pool_item<8>(UP, DOB, t0, c0); else pool_item<16>(UP, DOB, t0, c0);
    }
}

constexpr int TROW = 72;
constexpr int SROW = 136;
constexpr int H_VT = 0, H_KT = 18432, H_ST = 36864, H_QF = 71680, H_KF = 88064, H_NRM = 104448;
DI int ctile_off(int vt, int kt, int i, int lane) { return ((vt * 4 + kt) * 16 + i) * 64 + lane; }
DI int b63_off(int k) { return fq_off(1, k >> 4, 31 + 32 * ((k >> 3) & 1)) + (k & 7); }

struct HRegs { u32x4 v0, v1, q[2], k2[2]; f32x4 ea[2], eb[2]; float d0, d1; };
struct HCur { float d0, d1; };
template <bool WITH_Q>
DI void h_load_chunk(Frame& F, int uidx, HRegs& R) {
    const bf16_t* V = (const bf16_t*)(F.ws + WS_V); const bf16_t* K2 = (const bf16_t*)(F.ws + WS_KK); const bf16_t* Q = (const bf16_t*)(F.ws + WS_Q);
    const float* DL = (const float*)(F.ws + WS_DL);
    const int tid = F.tid, s = tid & 63, cg = F.wave;
    const int n = uidx >> 3, h = uidx & 7, t = 64 * n + s, col = h * 128 + 16 * cg;
    R.v0 = *(const u32x4*)(V + (size_t)t * DH + col); R.v1 = *(const u32x4*)(V + (size_t)t * DH + col + 8);
#pragma unroll
    for (int i = 0; i < 2; ++i) {
        const int f = tid + 512 * i, k0 = 16 * ((f >> 6) & 7) + 8 * ((f & 63) >> 5);
        R.k2[i] = *(const u32x4*)(K2 + (size_t)uidx * 8192 + f * 8);
        if (WITH_Q) R.q[i] = *(const u32x4*)(Q + (size_t)uidx * 8192 + f * 8);
        R.ea[i] = *(const f32x4*)(DL + (size_t)n * DH + h * 128 + k0); R.eb[i] = *(const f32x4*)(DL + (size_t)n * DH + h * 128 + k0 + 4);
    }
    { const int kt0 = 2 * (F.wave & 1), r = F.lane & 31; R.d0 = DL[(size_t)n * DH + h * 128 + 32 * kt0 + r]; R.d1 = DL[(size_t)n * DH + h * 128 + 32 * kt0 + 32 + r]; }
}
template <bool WITH_Q>
DI void h_stage_chunk(Frame& F, const HRegs& R, HCur& C) {
    C.d0 = R.d0; C.d1 = R.d1;
    LAS short* VT = (LAS short*)(F.lds + H_VT); LAS short* KT = (LAS short*)(F.lds + H_KT);
    const int tid = F.tid, s = tid & 63, cg = F.wave;
    const unsigned vw[8] = {R.v0.x, R.v0.y, R.v0.z, R.v0.w, R.v1.x, R.v1.y, R.v1.z, R.v1.w};
#pragma unroll
    for (int i = 0; i < 8; ++i) { VT[(16 * cg + 2 * i) * TROW + s] = (short)(vw[i] & 0xffffu); VT[(16 * cg + 2 * i + 1) * TROW + s] = (short)(vw[i] >> 16); }
#pragma unroll
    for (int i = 0; i < 2; ++i) {
        const int f = tid + 512 * i, ti = f >> 9, st = (f >> 6) & 7, lp = f & 63, ss = 32 * ti + (lp & 31), k0 = 16 * st + 8 * (lp >> 5);
        if (WITH_Q) { *(LAS u32x4*)(F.lds + H_QF + f * 16) = R.q[i]; *(LAS u32x4*)(F.lds + H_KF + f * 16) = R.k2[i]; }
        f32x4 ka, kb; unpack8(R.k2[i], ka, kb);
        const u32x4 kp = pack8(ka * R.ea[i], kb * R.eb[i]);
        const unsigned kw[4] = {kp.x, kp.y, kp.z, kp.w};
#pragma unroll
        for (int c = 0; c < 4; ++c) { KT[(k0 + 2 * c) * TROW + ss] = (short)(kw[c] & 0xffffu); KT[(k0 + 2 * c + 1) * TROW + ss] = (short)(kw[c] >> 16); }
    }
}
DI void h_state_update(Frame& F, const HCur& C, f32x16& s0, f32x16& s1) {
    const LAS short* VT = (const LAS short*)(F.lds + H_VT); const LAS short* KT = (const LAS short*)(F.lds + H_KT);
    const int vt = F.wave >> 1, kt0 = 2 * (F.wave & 1), r = F.lane & 31, hh = F.lane >> 5;
    const float d0 = C.d0, d1 = C.d1;
#pragma unroll
    for (int i = 0; i < 16; ++i) { s0[i] *= d0; s1[i] *= d1; }
#pragma unroll
    for (int st = 0; st < 4; ++st) {
        const int sx = 16 * st + 8 * hh;
        const bf16x8 af = *(const LAS bf16x8*)(VT + (32 * vt + r) * TROW + sx);
        const bf16x8 b0 = *(const LAS bf16x8*)(KT + (32 * kt0 + r) * TROW + sx), b1 = *(const LAS bf16x8*)(KT + (32 * (kt0 + 1) + r) * TROW + sx);
        s0 = __builtin_amdgcn_mfma_f32_32x32x16_bf16(af, b0, s0, 0, 0, 0);
        s1 = __builtin_amdgcn_mfma_f32_32x32x16_bf16(af, b1, s1, 0, 0, 0);
    }
}
DI void h1_phase(Frame& F) {
    float* LT = (float*)(F.ws + WS_LT);
    for (int ub = F.vcu; ub < (NCHUNK / 4) * 8; ub += F.G) {
        const int blk = ub >> 3, h = ub & 7;
        f32x16 s0, s1;
#pragma unroll
        for (int i = 0; i < 16; ++i) { s0[i] = 0.f; s1[i] = 0.f; }
        HRegs R; h_load_chunk<false>(F, (4 * blk) * 8 + h, R);
#pragma unroll 1
        for (int c = 0; c < 4; ++c) {
            const int uidx = (4 * blk + c) * 8 + h;
            __syncthreads();
            HCur C; h_stage_chunk<false>(F, R, C);
            if (c < 3) h_load_chunk<false>(F, uidx + 8, R);
            __syncthreads();
            h_state_update(F, C, s0, s1);
        }
        float* lt = LT + (size_t)ub * 16384; const int vt = F.wave >> 1, kt0 = 2 * (F.wave & 1);
#pragma unroll
        for (int i = 0; i < 16; ++i) { lt[ctile_off(vt, kt0, i, F.lane)] = s0[i]; lt[ctile_off(vt, kt0 + 1, i, F.lane)] = s1[i]; }
    }
    __syncthreads();
}
DI void h2_phase(Frame& F) {
    float* LT = (float*)(F.ws + WS_LT); const float* DL = (const float*)(F.ws + WS_DL);
    const int gt = F.vcu * 512 + F.tid, NGT = F.G * 512;
    for (int idx = gt; idx < 8 * 16384; idx += NGT) {
        const int h = idx >> 14, e = idx & 16383, k = 32 * ((e >> 10) & 3) + (e & 31);
        float st = 0.f;
        for (int b0 = 0; b0 < NCHUNK / 4; b0 += 4) {
            float L[4], d[4];
#pragma unroll
            for (int j = 0; j < 4; ++j) {
                L[j] = LT[(size_t)((b0 + j) * 8 + h) * 16384 + e];
                const float* dl = DL + (size_t)(4 * (b0 + j)) * DH + h * 128 + k;
                d[j] = (dl[0] * dl[DH]) * (dl[2 * DH] * dl[3 * DH]);
            }
#pragma unroll
            for (int j = 0; j < 4; ++j) { LT[(size_t)((b0 + j) * 8 + h) * 16384 + e] = st; st = d[j] * st + L[j]; }
        }
    }
}
DI void h3_phase(Frame& F) {
    const float* LT = (const float*)(F.ws + WS_LT); const bf16_t* SG = (const bf16_t*)(F.ws + WS_SG); bf16_t* DOB = (bf16_t*)(F.ws + WS_DOB); const float* NW = F.in[7];
    const int lane = F.lane, r = lane & 31, hh = lane >> 5;
    const LAS short* VT = (const LAS short*)(F.lds + H_VT); LAS short* ST = (LAS short*)(F.lds + H_ST); LAS float* NRM = (LAS float*)(F.lds + H_NRM);
    for (int ub = F.vcu; ub < (NCHUNK / 4) * 8; ub += F.G) {
        const int blk = ub >> 3, h = ub & 7, hc = h * 128;
        const int vts = F.wave >> 1, kt0 = 2 * (F.wave & 1);
        const int vto = F.wave & 3, ti = F.wave >> 2;
        f32x16 s0, s1;
        { const float* lt = LT + (size_t)ub * 16384;
#pragma unroll
          for (int i = 0; i < 16; ++i) { s0[i] = lt[ctile_off(vts, kt0, i, lane)]; s1[i] = lt[ctile_off(vts, kt0 + 1, i, lane)]; } }
        HRegs R; h_load_chunk<true>(F, (4 * blk) * 8 + h, R);
#pragma unroll 1
        for (int c = 0; c < 4; ++c) {
            const int uidx = (4 * blk + c) * 8 + h, t0 = 64 * (4 * blk + c);
            __syncthreads();
            HCur C; h_stage_chunk<true>(F, R, C);
            if (c < 3) h_load_chunk<true>(F, uidx + 8, R);
#pragma unroll
            for (int i = 0; i < 16; ++i) { const int v = 32 * vts + 8 * (i >> 2) + 4 * hh + (i & 3);
                ST[v * SROW + 32 * kt0 + r] = (short)(pk2(s0[i], 0.f) & 0xffffu); ST[v * SROW + 32 * kt0 + 32 + r] = (short)(pk2(s1[i], 0.f) & 0xffffu); }
            __syncthreads();
            f32x16 O;
            {
                bf16x8 qf[8];
#pragma unroll
                for (int st = 0; st < 8; ++st) qf[st] = *(const LAS bf16x8*)(F.lds + H_QF + ((ti * 8 + st) * 64 + lane) * 16);
                f32x16 X[2];
#pragma unroll
                for (int i = 0; i < 16; ++i) { X[0][i] = 0.f; X[1][i] = 0.f; O[i] = 0.f; }
#pragma unroll
                for (int sb = 0; sb < 2; ++sb) {
                    if (sb <= ti) {
#pragma unroll
                        for (int st = 0; st < 8; ++st)
                            X[sb] = __builtin_amdgcn_mfma_f32_32x32x16_bf16(*(const LAS bf16x8*)(F.lds + H_KF + ((sb * 8 + st) * 64 + lane) * 16), qf[st], X[sb], 0, 0, 0);
                    }
                }
#pragma unroll
                for (int i = 0; i < 16; ++i) { const int sl = 8 * (i >> 2) + 4 * hh + (i & 3); const bool keep = sl <= r;
                    if (ti == 0) X[0][i] = keep ? X[0][i] : 0.f; else X[1][i] = keep ? X[1][i] : 0.f; }
#pragma unroll
                for (int sb = 0; sb < 2; ++sb) {
                    if (sb <= ti) {
#pragma unroll
                        for (int sp = 0; sp < 2; ++sp) {
                            u32x4 xb; xb.x = pk2(X[sb][8 * sp + 0], X[sb][8 * sp + 1]); xb.y = pk2(X[sb][8 * sp + 2], X[sb][8 * sp + 3]); xb.z = pk2(X[sb][8 * sp + 4], X[sb][8 * sp + 5]); xb.w = pk2(X[sb][8 * sp + 6], X[sb][8 * sp + 7]);
                            const int sbase = 32 * sb + 16 * sp + 4 * hh;
                            const s16x4 lo = *(const LAS s16x4*)(VT + (32 * vto + r) * TROW + sbase), hi = *(const LAS s16x4*)(VT + (32 * vto + r) * TROW + sbase + 8);
                            O = __builtin_amdgcn_mfma_f32_32x32x16_bf16(__builtin_shufflevector(lo, hi, 0, 1, 2, 3, 4, 5, 6, 7), __builtin_bit_cast(bf16x8, xb), O, 0, 0, 0);
                        }
                    }
                }
#pragma unroll
                for (int st = 0; st < 8; ++st)
                    O = __builtin_amdgcn_mfma_f32_32x32x16_bf16(*(const LAS bf16x8*)(ST + (32 * vto + r) * SROW + 16 * st + 8 * hh), qf[st], O, 0, 0, 0);
            }
            { float ss = 0.f;
#pragma unroll
              for (int i = 0; i < 16; ++i) ss += O[i] * O[i];
              ss += __shfl_xor(ss, 32);
              if (hh == 0) NRM[(ti * 4 + vto) * 32 + r] = ss; }
            h_state_update(F, C, s0, s1);
            __syncthreads();
            {
                const float ssum = (NRM[(ti * 4 + 0) * 32 + r] + NRM[(ti * 4 + 1) * 32 + r]) + (NRM[(ti * 4 + 2) * 32 + r] + NRM[(ti * 4 + 3) * 32 + r]);
                const float rn = rsqrtf(ssum * (1.f / 128.f) + EPS);
                const int tq = t0 + 32 * ti + r;
#pragma unroll
                for (int g4 = 0; g4 < 4; ++g4) {
                    const int v0 = 32 * vto + 8 * g4 + 4 * hh;
                    const f32x4 nw = *(const f32x4*)(NW + hc + v0);
                    const u32x2 sg = *(const u32x2*)(SG + (size_t)tq * DH + hc + v0);
                    u32x2 w;
                    w.x = pk2(O[4 * g4 + 0] * rn * nw.x * bf_lo(sg.x), O[4 * g4 + 1] * rn * nw.y * bf_hi(sg.x));
                    w.y = pk2(O[4 * g4 + 2] * rn * nw.z * bf_lo(sg.y), O[4 * g4 + 3] * rn * nw.w * bf_hi(sg.y));
                    *(u32x2*)(DOB + (size_t)tq * DM + DP + hc + v0) = w;
                }
            }
        }
    }
    __syncthreads();
}
DI void fixup_panel(Frame& F, int pm) {
    const float* ZB = (const float*)(F.ws + WS_ZB); bf16_t* ACT = (bf16_t*)(F.ws + WS_ACT); const float* cw = F.in[13]; const float* cb = F.in[14];
    const f32x4 zero = {0.f, 0.f, 0.f, 0.f};
    for (int cg = F.tid; cg < DFF / 4; cg += NWAVES * 64) {
        const int c = 4 * cg, pg = 256 * (c >> 7) + (c & 127);
        f32x4 w0[2], w1[2], w2[2], bb[2];
#pragma unroll
        for (int hv = 0; hv < 2; ++hv) { const int oc = c + DFF * hv; w0[hv] = *(const f32x4*)(cw + oc); w1[hv] = *(const f32x4*)(cw + DFF2 + oc); w2[hv] = *(const f32x4*)(cw + 2 * DFF2 + oc); bb[hv] = *(const f32x4*)(cb + oc); }
#pragma unroll
        for (int bi = 0; bi < 4; ++bi) {
            const int b = 4 * pm + bi;
            f32x4 u0[2], u1[2];
#pragma unroll
            for (int hv = 0; hv < 2; ++hv) {
                const float* zb = ZB + (size_t)b * 4 * DFF2 + pg + 128 * hv;
                const f32x4 r0 = *(const f32x4*)zb, r1 = *(const f32x4*)(zb + DFF2);
                const f32x4 p2 = b > 0 ? *(const f32x4*)(zb - 2 * DFF2) : zero, p3 = b > 0 ? *(const f32x4*)(zb - DFF2) : zero;
                u0[hv] = bb[hv] + w2[hv] * r0 + w1[hv] * p3 + w0[hv] * p2;
                u1[hv] = bb[hv] + w2[hv] * r1 + w1[hv] * r0 + w0[hv] * p3;
            }
            u32x2 a, d;
            a.x = pk2(u0[0].x * sigm(u0[0].x) * u0[1].x, u0[0].y * sigm(u0[0].y) * u0[1].y); a.y = pk2(u0[0].z * sigm(u0[0].z) * u0[1].z, u0[0].w * sigm(u0[0].w) * u0[1].w);
            d.x = pk2(u1[0].x * sigm(u1[0].x) * u1[1].x, u1[0].y * sigm(u1[0].y) * u1[1].y); d.y = pk2(u1[0].z * sigm(u1[0].z) * u1[1].z, u1[0].w * sigm(u1[0].w) * u1[1].w);
            *(u32x2*)(ACT + (size_t)(64 * b) * DFF + c) = a;
            *(u32x2*)(ACT + (size_t)(64 * b + 1) * DFF + c) = d;
        }
    }
    asm volatile("s_waitcnt vmcnt(0)" ::: "memory");
    __syncthreads();
}
DI void final_phase(Frame& F) {
    const float* SSQ = (const float*)(F.ws + WS_SSQ3); const float* wf = F.in[19]; float* out = F.out;
    const int gw = F.vcu * NWAVES + F.wave, NGW = F.G * NWAVES;
    for (int m = gw; m < S; m += NGW) {
        float s = F.lane < 32 ? SSQ[(size_t)m * 32 + F.lane] : 0.f;
        s = wave_sum(s);
        const float rr = rsqrtf(s * (1.f / DM) + EPS);
        f32x4* xr = (f32x4*)(out + (size_t)m * DM) + F.lane; const f32x4* wr_ = (const f32x4*)wf + F.lane;
#pragma unroll
        for (int j = 0; j < 8; ++j) { const f32x4 v = xr[64 * j], w = wr_[64 * j]; xr[64 * j] = v * rr * w; }
    }
}

struct Args { const float* in[20]; float* out; unsigned char* ws; int ph_lo, ph_hi, li, pad; };
constexpr int NPHASE = 10;
#define WGM_G1 2
#define WGM_G5 2
#define WGM_SQ 2

#define REP_P0 1
#define REP_P1 1
#define REP_P2 1
#define REP_P4 1
#define REP_P5 1
#define REP_P6 1
#define REP_P7 1
#define REP_BAR 1
#define KS_NTP 18
#define TS_PHASE 99

__global__ void __launch_bounds__(NWAVES * 64, 2) mk_fwd(Args args) {
    extern __shared__ __attribute__((aligned(16))) unsigned char lds[];
    Frame F;
    F.lds = (LAS unsigned char*)lds;
    F.tid = threadIdx.x; F.lane = F.tid & 63; F.wave = __builtin_amdgcn_readfirstlane(F.tid >> 6);
    F.G = gridDim.x; { const int bx = blockIdx.x; F.vcu = (F.G % 8 == 0) ? (bx % 8) * (F.G / 8) + bx / 8 : bx; }
    F.ws = args.ws; F.out = args.out; F.in = args.in;
    volatile LAS unsigned* MISC = (volatile LAS unsigned*)(F.lds + MISC_OFF);
    for (int u = F.tid; u < (LDS_BYTES - LDSCTL_OFF) / 4; u += NWAVES * 64) ((LAS unsigned*)(F.lds + LDSCTL_OFF))[u] = 0u;
    __syncthreads();
    const bool multi = (args.ph_hi - args.ph_lo) > 1;
    XcdBarrier bar; bar.bar = (unsigned*)(args.ws + WS_CTL) + CW_BAR + args.li * XCD_BAR_WORDS; bar.x = 0; bar.st = nullptr;
    if (multi) bar = xcd_barrier_post(bar.bar, MISC + 8);
    const int lo = args.ph_lo, hi = args.ph_hi;
    if (TS_PHASE == 0 && blockIdx.x == 0 && F.tid == 0) MISC[16] = (unsigned)__builtin_amdgcn_s_memrealtime();
#define IN(k) (lo <= (k) && (k) < hi)
#define SEAM(k) do { if (IN(k) && IN((k) + 1)) xcd_barrier(bar); if (TS_PHASE != 99 && blockIdx.x == 0 && F.tid == 0) { const unsigned long long _t = __builtin_amdgcn_s_memrealtime(); if ((k) + 1 == TS_PHASE) MISC[16] = (unsigned)_t; if ((k) == TS_PHASE) MISC[17] = (unsigned)_t; } } while (0)
    unsigned char* ws = args.ws;
    const int bid = (int)blockIdx.x;

#define BODY_P1 {     \
        pg8::Gemm g{(const bf16_t*)(ws + WS_XB), (const bf16_t*)(ws + WS_WIN), DM, DM, DM}; pg8::StaticOrder So; So.init(S, DIN, F.G, bid, WGM_G1); \
        EpiProj E{ws, F.out}; \
        pg8::gemm_phase<EpiProj, true>(F.lds, g, So, E); \
        convert_rest(F); }
#define BODY_P5 {     \
        pg8::Gemm g{(const bf16_t*)(ws + WS_DOB), (const bf16_t*)(ws + WS_WAB), DM, DM, DM}; pg8::StaticOrder So; So.init(S, DM, F.G, bid, WGM_SQ); \
        EpiMerge E{(const bf16_t*)F.out, (const bf16_t*)F.out + (size_t)S * DM, (bf16_t*)(ws + WS_MG)}; \
        pg8::gemm_phase<EpiMerge, true>(F.lds, g, So, E); }
#define BODY_P6 {     \
        pg8::Gemm g{(const bf16_t*)(ws + WS_MG), (const bf16_t*)(ws + WS_WOUT), DM, DM, DM}; pg8::StaticOrder So; So.init(S, DM, F.G, bid, WGM_SQ); \
        EpiResB<true> E{(const void*)(ws + WS_XB), (bf16_t*)(ws + WS_XB), (float*)(ws + WS_SSQ1)}; \
        pg8::gemm_phase<EpiResB<true>, true>(F.lds, g, So, E); }
#define BODY_P7 {     \
        pg8::Gemm g{(const bf16_t*)(ws + WS_XB), (const bf16_t*)(ws + WS_WUP), DM, DM, DM}; pg8::StaticOrder So; So.init(S, DFF2, F.G, bid, WGM_G5); \
        pg8::SplitTail Ss; Ss.init(S, DFF2, F.G, bid, WGM_G5, DM / 64, KS_NTP); if (Ss.split) So.lim = Ss.full * F.G; \
        EpiUp E{ws, F.in[13], F.in[14], F.lds}; \
        pg8::gemm_phase<EpiUp, true>(F.lds, g, So, E); \
        { EpiUpKS Ek{E}; pg8::gemm_phase<EpiUpKS, true, pg8::SplitTail>(F.lds, g, Ss, Ek); } \
        {   \
          pg8::Gemm g2{(const bf16_t*)(ws + WS_PB), (const bf16_t*)(ws + WS_WPLE), PLE, PLE, PLE}; pg8::TailOrder2 St; St.init(S, DM, F.G, bid, Ss.rem, Ss.split); \
          EpiBf E2{(bf16_t*)(ws + WS_E), DM}; \
          pg8::gemm_phase<EpiBf, false, pg8::TailOrder2>(F.lds, g2, St, E2); } }

    if (IN(0)) { for (int rp = 0; rp <= args.pad; ++rp) p0_prologue(F); } SEAM(0);
    if (multi) for (int rb = 1; rb < REP_BAR; ++rb) xcd_barrier(bar);
    if (IN(1)) { BODY_P1 if (REP_P1 > 1) BODY_P1 } SEAM(1);
    if (IN(2)) { h1_phase(F); pool_phase(F); if (REP_P2 > 1) { h1_phase(F); pool_phase(F); } if (REP_P2 > 2) { h1_phase(F); pool_phase(F); } } SEAM(2);
    if (IN(3)) { h2_phase(F); } SEAM(3);
    if (IN(4)) { h3_phase(F); if (REP_P4 > 1) h3_phase(F); if (REP_P4 > 2) h3_phase(F); } SEAM(4);
    if (IN(5)) { BODY_P5 if (REP_P5 > 1) BODY_P5 } SEAM(5);
    if (IN(6)) { BODY_P6 if (REP_P6 > 1) BODY_P6 } SEAM(6);
    if (IN(7)) { BODY_P7 if (REP_P7 > 1) BODY_P7 } SEAM(7);
    if (IN(8)) {
        pg8::Gemm g{(const bf16_t*)(ws + WS_ACT), (const bf16_t*)(ws + WS_WDOWN), DFF, DFF, DFF}; pg8::StaticOrder So; So.init(S, DM, F.G, bid, WGM_SQ);
        { Unit u0; if (So.next(0, u0)) fixup_panel(F, u0.pm); }
        EpiResB<true> E{(const void*)(ws + WS_XB), (bf16_t*)(ws + WS_XB), (float*)(ws + WS_SSQ2)};
        pg8::gemm_phase<EpiResB<true>, true>(F.lds, g, So, E);
    } SEAM(8);
    if (IN(9)) {
        pg8::Gemm g{(const bf16_t*)(ws + WS_XB), (const bf16_t*)(ws + WS_WPG), DM, DM, DM}; pg8::StaticOrder So; So.init(S, DM, F.G, bid, WGM_SQ);
        EpiPle E{ws, F.out, F.in[19]};
        pg8::gemm_phase<EpiPle, true>(F.lds, g, So, E);
    }
    if (TS_PHASE != 99 && blockIdx.x == 0 && F.tid == 0) { const unsigned long long t1 = __builtin_amdgcn_s_memrealtime(); if (TS_PHASE == 9) MISC[17] = (unsigned)t1; unsigned span = MISC[17] - MISC[16]; if (span > 100000u) span = 100000u;
        while ((unsigned)(__builtin_amdgcn_s_memrealtime() - t1) < 2u * span) __builtin_amdgcn_s_sleep(8); }
#undef IN
#undef SEAM
}

#ifndef MK_N_LAUNCHES
#define MK_N_LAUNCHES 1
#endif
extern "C" void kernel_launch(void* const* d_in, const int* in_sizes, int n_in, void* d_out, int out_size, void* d_ws, size_t ws_size, hipStream_t stream) {
    static int grid = 0;
    if (grid == 0) {
        if (n_in != 20 || in_sizes[0] != S * DM || out_size != S * DM || ws_size < WS_END) { fprintf(stderr, "kernel_launch: unexpected shapes / workspace (%zu < %zu)\n", ws_size, (size_t)WS_END); grid = -1; return; }
        int dev = 0, cus = 0, per_cu = 0;
        if (hipGetDevice(&dev) != hipSuccess || hipDeviceGetAttribute(&cus, hipDeviceAttributeMultiprocessorCount, dev) != hipSuccess) { grid = -1; return; }
        if (hipFuncSetAttribute((const void*)mk_fwd, hipFuncAttributeMaxDynamicSharedMemorySize, LDS_BYTES) != hipSuccess) { fprintf(stderr, "kernel_launch: hipFuncSetAttribute failed\n"); grid = -1; return; }
        if (hipOccupancyMaxActiveBlocksPerMultiprocessor(&per_cu, (const void*)mk_fwd, NWAVES * 64, LDS_BYTES) != hipSuccess || per_cu < 1) { fprintf(stderr, "kernel_launch: occupancy query says %d\n", per_cu); per_cu = 1; }
        (void)hipGetLastError();
        grid = cus;
    }
    if (grid < 0) return;
    (void)hipMemsetAsync((char*)d_ws + WS_CTL, 0, CTL_ZERO_BYTES, stream);
    Args a{};
    for (int i = 0; i < 20; ++i) a.in[i] = (const float*)d_in[i];
    a.out = (float*)d_out; a.ws = (unsigned char*)d_ws; a.pad = REP_P0 - 1;
    if (MK_N_LAUNCHES == 1) {
        a.ph_lo = 0; a.ph_hi = NPHASE; a.li = 0;
        hipLaunchKernelGGL(mk_fwd, dim3(grid), dim3(NWAVES * 64), LDS_BYTES, stream, a);
    } else {
        for (int ph = 0; ph < NPHASE; ++ph) { a.ph_lo = ph; a.ph_hi = ph + 1; a.li = 0; hipLaunchKernelGGL(mk_fwd, dim3(grid), dim3(NWAVES * 64), LDS_BYTES, stream, a); }
    }
}
```

```cpp
#include <hip/hip_runtime.h>
#include <cstdio>
#include <cstdint>

#define LAS __attribute__((address_space(3)))
#define GAS __attribute__((address_space(1)))
typedef unsigned short bf16_t;
typedef short bf16x8 __attribute__((ext_vector_type(8)));
typedef short s16x4 __attribute__((ext_vector_type(4)));
typedef float f32x4 __attribute__((ext_vector_type(4)));
typedef float f32x2 __attribute__((ext_vector_type(2)));
typedef float f32x16 __attribute__((ext_vector_type(16)));
typedef unsigned u32x4 __attribute__((ext_vector_type(4)));
typedef unsigned u32x2 __attribute__((ext_vector_type(2)));
typedef __bf16 bf16v2 __attribute__((ext_vector_type(2)));
#define DI __device__ __forceinline__

constexpr int S = 8192, DM = 2048, DP = 1024, DH = 1024, DIN = 9216, DFF = 5504, DFF2 = 11008, PLE = 256, NCHUNK = 128;
constexpr float EPS = 1e-6f;

DI unsigned pk2(float lo, float hi) { f32x2 v = {lo, hi}; bf16v2 r = __builtin_convertvector(v, bf16v2); return __builtin_bit_cast(unsigned, r); }
DI float bf_lo(unsigned w) { return __builtin_bit_cast(float, w << 16); }
DI float bf_hi(unsigned w) { return __builtin_bit_cast(float, w & 0xffff0000u); }
DI float sigm(float v) { return __builtin_amdgcn_rcpf(1.0f + __expf(-v)); }
DI float wave_sum(float v) {
#pragma unroll
    for (int o = 1; o < 64; o <<= 1) v += __shfl_xor(v, o);
    return v;
}
template <int CTRL> DI float dppf(float v) { return __builtin_bit_cast(float, __builtin_amdgcn_update_dpp(0, __builtin_bit_cast(int, v), CTRL, 0xf, 0xf, true)); }
DI u32x4 pack8(f32x4 a, f32x4 b) { u32x4 w; w.x = pk2(a.x, a.y); w.y = pk2(a.z, a.w); w.z = pk2(b.x, b.y); w.w = pk2(b.z, b.w); return w; }
DI void unpack8(u32x4 w, f32x4& a, f32x4& b) { a.x = bf_lo(w.x); a.y = bf_hi(w.x); a.z = bf_lo(w.y); a.w = bf_hi(w.y); b.x = bf_lo(w.z); b.y = bf_hi(w.z); b.z = bf_lo(w.w); b.w = bf_hi(w.w); }

DI int fq_off(int ti, int st, int lanep) { return ((ti * 8 + st) * 64 + lanep) * 8; }

#define NT_IN 1
#define CONV_QUOTA 8
namespace pg8 {
constexpr int BM = 256, BK = 64, HALF = 128, HTB = HALF * BK * 2, STAGE_BYTES = 8 * HTB, NXCD = 8, WGM = 8;
__host__ __device__ __forceinline__ int lds_byte(int r, int c) { const int st = (r >> 4) * 2 + (c >> 5), rr = r & 15, cc = c & 31, ob = rr * 64 + cc * 2; return st * 1024 + (ob ^ (((ob >> 9) & 1) << 5)); }
__host__ __device__ __forceinline__ void stage_rc(int b, int& R, int& C) { const int st = b / 1024, sb = b % 1024, swz = sb ^ (((sb >> 9) & 1) << 5); R = (st >> 1) * 16 + swz / 64; C = (st & 1) * 32 + (swz % 64) / 2; }
__host__ __device__ __forceinline__ int perm32(int rho) { const int n = rho >> 4, i = rho & 15; return 8 * (i >> 2) + 4 * n + (i & 3); }

struct Unit { int pm, pn, ui, k0, ntu, kind, sl; };
struct Gemm { const bf16_t* A; const bf16_t* Bt; int lda, ldb, K; };

struct StaticOrder {
    static constexpr bool KSPLIT = false;
    int nM, nN, nwg, G, c, wgm, lim;
    DI void init(int M, int N, int G_, int c_, int wgm_ = WGM) { nM = M / BM; nN = N / BM; nwg = nM * nN; G = G_; c = c_; wgm = wgm_; lim = nwg; }
    DI bool next(int i, Unit& u) const { return at((long)i * G + c, u); }
    DI bool at(long L, Unit& u) const {
        if (L >= lim) return false;
        int wgid = (int)L; { const int q = nwg / NXCD, r = nwg % NXCD, xcd = wgid % NXCD, off = wgid / NXCD; wgid = (xcd < r ? xcd * (q + 1) : r * (q + 1) + (xcd - r) * q) + off; }
        const int nig = wgm * nN, gid = wgid / nig, fm = gid * wgm, gsz = (nM - fm) < wgm ? (nM - fm) : wgm;
        u.pm = fm + ((wgid % nig) % gsz); u.pn = (wgid % nig) / gsz; return true;
    }
};

struct SplitTail {
    static constexpr bool KSPLIT = true;
    StaticOrder so; int full, rem, nt, ntp; bool split;
    DI void init(int M, int N, int G_, int c_, int wgm_, int nt_, int ntp_) { so.init(M, N, G_, c_, wgm_); full = so.nwg / G_; rem = so.nwg % G_; split = rem > 0 && 2 * rem <= G_; nt = nt_; ntp = ntp_; }
    DI bool next(int i, Unit& u) const {
        if (!split || i != 0) return false;
        int c = so.c; u.k0 = 0; u.ntu = ntp; u.kind = 1;
        if (c >= rem) { if (c >= 2 * rem) return false; c -= rem; u.k0 = ntp; u.ntu = nt - ntp; u.kind = 2; }
        u.sl = c;
        return so.at((long)full * so.G + c, u);
    }
};
struct FoldOrder {
    static constexpr bool KSPLIT = true;
    int c, c0;
    DI bool next(int i, Unit& u) const { const int L = c - c0; if (i != 0 || L < 0 || L >= 32) return false; u.pm = L & 7; u.pn = L >> 3; u.k0 = 4 * u.pn; u.ntu = 4; u.kind = 0; u.sl = 0; return true; }
};
struct TailOrder2 {
    static constexpr bool KSPLIT = false;
    int nN, nE, c, idle0, I, a, sec0, nsec;
    DI void init(int M, int N, int G, int c_, int rem, bool split) { nN = N / BM; nE = (M / BM) * nN; c = c_; sec0 = rem; nsec = split ? rem : 0; idle0 = rem + nsec; I = G - idle0;
        a = I > 0 ? (nE + I - 1) / I : 0; if (split && a > 3) a = 3; }
    DI bool next(int i, Unit& u) const {
        int L;
        if (c >= idle0) { if (i >= a) return false; L = (c - idle0) + i * I; }
        else if (c >= sec0 && nsec > 0) { L = a * I + (c - sec0) + i * nsec; }
        else return false;
        if (L >= nE) return false;
        u.pm = L / nN; u.pn = L - u.pm * nN; return true;
    }
};
struct TailOrder {
    static constexpr bool KSPLIT = false;
    int nM, nN, nwg, G, c, c0;
    DI void init(int M, int N, int G_, int c_, int c0_) { nM = M / BM; nN = N / BM; nwg = nM * nN; G = G_; c = c_; c0 = c0_; }
    DI bool next(int i, Unit& u) const {
        if (c < c0) return false;
        const int L = (c - c0) + i * (G - c0); if (L >= nwg) return false;
        u.pm = L / nN; u.pn = L - u.pm * nN; return true;
    }
};
template <class Epi, bool ALIGN_EPI, class Sched = StaticOrder>
DI void gemm_phase(LAS unsigned char* lds, const Gemm g, const Sched& S, const Epi& E) {
    int tid_o = threadIdx.x; asm volatile("" : "+v"(tid_o));
    const int tid = tid_o, wid = __builtin_amdgcn_readfirstlane(tid >> 6), lane = tid & 63, wr = wid >> 2, wc = wid & 3, fr = lane & 15, fq = lane >> 4;
    const int K = g.K, nt = K / BK;
    unsigned voffA[2], voffB[2];
#pragma unroll
    for (int i = 0; i < 2; ++i) { int R, C; stage_rc(tid * 16 + i * 8192, R, C); const int Rb = (R & ~31) + perm32(R & 31);
        voffA[i] = (unsigned)(R * g.lda + C) * 2u; voffB[i] = (unsigned)(Rb * g.ldb + C) * 2u; }
    const size_t kstep = (size_t)(BK * 2);
    const size_t hstepA = (size_t)HALF * g.lda * 2, hstepB = (size_t)HALF * g.ldb * 2;
    const size_t tstepA = 2 * hstepA, tstepB = 2 * hstepB;
    const unsigned ldsw = (unsigned)wid * 1024u;
    const int aoff = lds_byte(wr * 64 + fr, fq * 8), boff = lds_byte(wc * 32 + fr, fq * 8);
#define PG8_SA(b, h) (((b) * 2 + (h)) * HTB)
#define PG8_SB(b, h) ((4 + (b) * 2 + (h)) * HTB)
#define PG8_STAGE(bufoff, gbase, voff) do { _Pragma("unroll") for (int _i = 0; _i < 2; ++_i) \
        __builtin_amdgcn_global_load_lds((const unsigned*)((const char*)(gbase) + (voff)[_i]), (LAS unsigned*)(lds + (bufoff) + ldsw + _i * 8192), 16, 0, 0); } while (0)
#define PG8_LDA(dst, b, h) do { _Pragma("unroll") for (int m = 0; m < 4; ++m) _Pragma("unroll") for (int k = 0; k < 2; ++k) dst[m][k] = *(const LAS bf16x8*)(lds + PG8_SA(b, h) + aoff + m * 2048 + k * 1024); } while (0)
#define PG8_LDB(dst, b, h) do { _Pragma("unroll") for (int n = 0; n < 2; ++n) _Pragma("unroll") for (int k = 0; k < 2; ++k) dst[n][k] = *(const LAS bf16x8*)(lds + PG8_SB(b, h) + boff + n * 2048 + k * 1024); } while (0)
#define PG8_MMA(ai, bj, At, Bt) do { __builtin_amdgcn_s_setprio(1); _Pragma("unroll") for (int m = 0; m < 4; ++m) _Pragma("unroll") for (int n = 0; n < 2; ++n) _Pragma("unroll") for (int k = 0; k < 2; ++k) \
        acc[ai][bj][m][n] = __builtin_amdgcn_mfma_f32_16x16x32_bf16(Bt[n][k], At[m][k], acc[ai][bj][m][n], 0, 0, 0); __builtin_amdgcn_s_setprio(0); } while (0)
#define PG8_WAIT_V(n) asm volatile("s_waitcnt vmcnt(" #n ")" ::: "memory")
#define PG8_WAIT_L(n) asm volatile("s_waitcnt lgkmcnt(" #n ")" ::: "memory")
#define PG8_BAR __builtin_amdgcn_s_barrier()
#define PG8_SCHED __builtin_amdgcn_sched_barrier(0)
    Unit cur, nxt; int ui = 0;
    if (!S.next(0, cur)) return;
    cur.ui = 0;
    if constexpr (Epi::HAS_PRE) E.pre(lds, cur, wid, lane);
    f32x4 acc[2][2][4][2];
#pragma unroll
    for (int a = 0; a < 2; ++a)
#pragma unroll
        for (int b = 0; b < 2; ++b)
#pragma unroll
            for (int m = 0; m < 4; ++m)
#pragma unroll
                for (int n = 0; n < 2; ++n) acc[a][b][m][n] = (f32x4){0.f, 0.f, 0.f, 0.f};
    bf16x8 At[4][2], B0[2][2], B1[2][2];
    const char* cA = (const char*)g.A + (size_t)cur.pm * tstepA; const char* cB = (const char*)g.Bt + (size_t)cur.pn * tstepB;
    if constexpr (Sched::KSPLIT) { cA += (size_t)cur.k0 * kstep; cB += (size_t)cur.k0 * kstep; }
    PG8_STAGE(PG8_SB(0, 0), cB, voffB); PG8_STAGE(PG8_SB(0, 1), cB + hstepB, voffB); PG8_STAGE(PG8_SA(0, 0), cA, voffA); PG8_STAGE(PG8_SA(0, 1), cA + hstepA, voffA);
    if (wr == 1) PG8_BAR;
    PG8_WAIT_V(2); PG8_BAR;
    PG8_STAGE(PG8_SB(1, 0), cB + kstep, voffB); PG8_STAGE(PG8_SA(1, 0), cA + kstep, voffA); PG8_STAGE(PG8_SB(1, 1), cB + hstepB + kstep, voffB);
    PG8_WAIT_V(6); PG8_BAR;
    for (;;) {
        const bool has_next = S.next(ui + 1, nxt);
        const char* nA = has_next ? (const char*)g.A + (size_t)nxt.pm * tstepA : cA; const char* nB = has_next ? (const char*)g.Bt + (size_t)nxt.pn * tstepB : cB;
        if constexpr (Sched::KSPLIT) { if (has_next) { nA += (size_t)nxt.k0 * kstep; nB += (size_t)nxt.k0 * kstep; } }
        const int ntc = Sched::KSPLIT ? cur.ntu : nt;
        for (int t = 0; t < ntc; t += 2) {
            const bool last = (t == ntc - 2);
            const char* a1 = cA + (size_t)(t + 1) * kstep;
            const char* a2 = last ? nA : cA + (size_t)(t + 2) * kstep; const char* b2 = last ? nB : cB + (size_t)(t + 2) * kstep;
            const char* a3 = a2 + kstep; const char* b3 = b2 + kstep;
            if constexpr (Epi::MIDK != 0) { if (t == Epi::MIDK) E.mid(acc, cur, wr, wc, fr, fq); }
            PG8_LDB(B0, 0, 0); PG8_LDB(B1, 0, 1); PG8_SCHED; PG8_LDA(At, 0, 0); PG8_STAGE(PG8_SA(1, 1), a1 + hstepA, voffA);
            PG8_WAIT_V(8); PG8_WAIT_L(0); PG8_BAR; PG8_MMA(0, 0, At, B0); PG8_MMA(0, 1, At, B1); PG8_BAR; PG8_SCHED;
            PG8_LDA(At, 0, 1); PG8_STAGE(PG8_SB(0, 0), b2, voffB); PG8_STAGE(PG8_SB(0, 1), b2 + hstepB, voffB); PG8_STAGE(PG8_SA(0, 0), a2, voffA);
            PG8_WAIT_V(8); PG8_WAIT_L(0); PG8_BAR; PG8_MMA(1, 0, At, B0); PG8_MMA(1, 1, At, B1); PG8_BAR; PG8_SCHED;
            PG8_LDB(B0, 1, 0); PG8_LDB(B1, 1, 1); PG8_SCHED; PG8_LDA(At, 1, 0); PG8_STAGE(PG8_SA(0, 1), a2 + hstepA, voffA);
            PG8_WAIT_V(8); PG8_WAIT_L(0); PG8_BAR; PG8_MMA(0, 0, At, B0); PG8_MMA(0, 1, At, B1); PG8_BAR; PG8_SCHED;
            PG8_LDA(At, 1, 1); PG8_STAGE(PG8_SB(1, 0), b3, voffB); PG8_STAGE(PG8_SB(1, 1), b3 + hstepB, voffB); PG8_STAGE(PG8_SA(1, 0), a3, voffA);
            PG8_WAIT_V(8); PG8_WAIT_L(0); PG8_BAR; PG8_MMA(1, 0, At, B0); PG8_MMA(1, 1, At, B1); PG8_BAR; PG8_SCHED;
        }
        if constexpr (ALIGN_EPI) { if (wr == 0) PG8_BAR; }
        if constexpr (!Epi::AFTER_DRAIN) E(acc, cur, wr, wc, fr, fq);
        if (!has_next) break;
#pragma unroll
        for (int a = 0; a < 2; ++a)
#pragma unroll
            for (int b = 0; b < 2; ++b)
#pragma unroll
                for (int m = 0; m < 4; ++m)
#pragma unroll
                    for (int n = 0; n < 2; ++n) acc[a][b][m][n] = (f32x4){0.f, 0.f, 0.f, 0.f};
        cur = nxt; cA = nA; cB = nB; ++ui; cur.ui = ui;
        if constexpr (Epi::HAS_PRE) E.pre(lds, cur, wid, lane);
        if constexpr (ALIGN_EPI) { if (wr == 1) PG8_BAR; }
    }
    PG8_WAIT_V(0);
    if constexpr (!ALIGN_EPI) { if (wr == 0) PG8_BAR; }
    PG8_BAR;
    if constexpr (Epi::AFTER_DRAIN) E.fused(acc, cur, wr, wc, fr, fq);
#undef PG8_SA
#undef PG8_SB
#undef PG8_STAGE
#undef PG8_LDA
#undef PG8_LDB
#undef PG8_MMA
#undef PG8_WAIT_V
#undef PG8_WAIT_L
#undef PG8_BAR
#undef PG8_SCHED
}
}
using pg8::Unit;
typedef f32x4 AccT[2][2][4][2];

constexpr size_t MiB = 1u << 20;
constexpr size_t WS_CTL = 0, CTL_ZERO_BYTES = 1 * MiB;
constexpr size_t WS_R1 = 1 * MiB, WS_LB = WS_R1 + 65536;
constexpr size_t WS_SSQ1 = 2 * MiB, WS_SSQ2 = 3 * MiB, WS_SSQ3 = 4 * MiB;
constexpr size_t WS_WAB = 6 * MiB, WS_WOUT = 14 * MiB, WS_WPG = 22 * MiB, WS_WPLE = 30 * MiB, WS_WDOWN = 31 * MiB, WS_WUP = 53 * MiB, WS_WIN = 96 * MiB;
constexpr size_t WS_XB = 132 * MiB;
constexpr size_t WS_UP = 164 * MiB, WS_Q = 180 * MiB, WS_KK = 196 * MiB, WS_V = 212 * MiB, WS_SG = 228 * MiB;
constexpr size_t WS_KP = 244 * MiB, WS_DL = 260 * MiB;
constexpr size_t WS_BC = 244 * MiB;
constexpr size_t WS_DOB = 276 * MiB;
constexpr size_t WS_PB = 308 * MiB;
constexpr size_t WS_ZB = 312 * MiB;
constexpr size_t WS_WAT = 336 * MiB;
constexpr size_t WS_WMX = 340 * MiB;
constexpr size_t WS_END = 344 * MiB;
constexpr size_t WS_LT = 96 * MiB;
constexpr size_t WS_TMP = 164 * MiB;
constexpr size_t WS_MG = 244 * MiB;
constexpr size_t WS_STB = 312 * MiB;
constexpr size_t WS_E = 96 * MiB;
constexpr size_t WS_ACT = 164 * MiB;
static_assert(WS_WUP + (size_t)DFF2 * DM * 2 <= WS_WIN && WS_WIN + (size_t)DIN * DM * 2 <= WS_XB && WS_LT + (size_t)256 * 16384 * 4 <= WS_XB, "ws map");
static_assert(WS_ACT + (size_t)S * DFF * 2 <= WS_DOB && WS_ZB + (size_t)128 * 4 * DFF2 * 4 <= WS_WAT && WS_WMX + (size_t)DP * DP * 2 <= WS_END, "ws map 2");

constexpr int CW_BAR = 4096;
constexpr int CW_KS = 24576;
constexpr size_t WS_SLAB = WS_DOB;
constexpr int RING_BYTES = 131072, LDSCTL_OFF = RING_BYTES, MISC_OFF = LDSCTL_OFF + 320, LDS_BYTES = 147456;
constexpr int NWAVES = 8;

typedef GAS unsigned gu32;
#define RLX_AGENT __ATOMIC_RELAXED, __HIP_MEMORY_SCOPE_AGENT
#define LDS_WAIT() asm volatile("s_waitcnt lgkmcnt(0)" ::: "memory")

#define XB_TMO      128
#define XB_XCNT(j)  (256  + 64 * (j))
#define XB_XSUB(j)  (1280 + 64 * (j))
#define XB_XGEN(j)  (2304 + 64 * (j))
#define XB_TOP      3328
#define XB_TOPGEN   3392
#define XCD_BAR_WORDS 3456
#define XB_SPIN_CAP (1u << 22)
DI unsigned xb_ld(unsigned* p)              { return __hip_atomic_load(p, __ATOMIC_RELAXED, __HIP_MEMORY_SCOPE_AGENT); }
DI unsigned xb_add(unsigned* p, unsigned v) { return __hip_atomic_fetch_add(p, v, __ATOMIC_RELAXED, __HIP_MEMORY_SCOPE_AGENT); }
DI unsigned xb_xcc_id() { return (unsigned)__builtin_amdgcn_s_getreg((3 << 11) | 20) & 0xFu; }
#define XB_SPIN(cond, bar) do { unsigned _sp = 0; while (cond) { __builtin_amdgcn_s_sleep(1); \
    if ((++_sp & 255u) == 0u) { if (xb_ld(&(bar)[XB_TMO])) break; if (_sp > XB_SPIN_CAP) { atomicAdd(&(bar)[XB_TMO], 1u); break; } } } } while (0)
struct XcdBarrier { unsigned* bar; unsigned x; volatile LAS unsigned* st; };
DI XcdBarrier xcd_barrier_post(unsigned* bar, volatile LAS unsigned* st) {
    XcdBarrier b; b.bar = bar; b.x = xb_xcc_id(); b.st = st;
    if (threadIdx.x == 0) (void)xb_add(&bar[XB_XCNT(b.x)], 1u);
    return b;
}
DI void xcd_barrier_complete(unsigned* bar, unsigned x, unsigned& nloc, unsigned& nx) {
    const unsigned G = gridDim.x * gridDim.y * gridDim.z;
    unsigned sum, cnt, mine, sp = 0u;
    for (;;) {
        sum = 0u; cnt = 0u; mine = 0u;
#pragma unroll
        for (unsigned j = 0; j < 16; ++j) { const unsigned c = xb_ld(&bar[XB_XCNT(j)]); sum += c; cnt += (c > 0u) ? 1u : 0u; mine = (j == x) ? c : mine; }
        if (sum == G) break;
        __builtin_amdgcn_s_sleep(1);
        if ((++sp & 255u) == 0u) { if (xb_ld(&bar[XB_TMO])) break; if (sp > XB_SPIN_CAP) { atomicAdd(&bar[XB_TMO], 1u); break; } }
    }
    nloc = mine > 0u ? mine : 1u; nx = cnt > 0u ? cnt : 1u;
}
DI void xcd_barrier(const XcdBarrier& b) {
    asm volatile("s_waitcnt vmcnt(0)" ::: "memory");
    __syncthreads();
    if (threadIdx.x == 0) {
        unsigned* bar = b.bar;
        __builtin_amdgcn_s_waitcnt(0);
        __builtin_amdgcn_fence(__ATOMIC_ACQUIRE, "agent");
        unsigned nloc = b.st[0], nx = b.st[1];
        if (nloc == 0u) { xcd_barrier_complete(bar, b.x, nloc, nx); b.st[0] = nloc; b.st[1] = nx; }
        const unsigned old = xb_add(&bar[XB_XSUB(b.x)], 1u);
        const unsigned gen = old / nloc;
        if (old + 1u == (gen + 1u) * nloc) {
            __builtin_amdgcn_fence(__ATOMIC_RELEASE, "agent");
            asm volatile("s_waitcnt vmcnt(0)" ::: "memory");
            const unsigned og = xb_add(&bar[XB_TOP], 1u);
            const unsigned tg = og / nx;
            if (og + 1u == (tg + 1u) * nx) xb_add(&bar[XB_TOPGEN], 1u);
            else XB_SPIN(xb_ld(&bar[XB_TOPGEN]) == tg, bar);
            xb_add(&bar[XB_XGEN(b.x)], 1u);
            asm volatile("s_waitcnt vmcnt(0)" ::: "memory");
        } else {
            XB_SPIN(xb_ld(&bar[XB_XGEN(b.x)]) == gen, bar);
            asm volatile("s_waitcnt vmcnt(0)" ::: "memory");
        }
    }
    __syncthreads();
}

struct Frame {
    LAS unsigned char* lds;
    int tid, lane, wave, vcu, G;
    unsigned char* ws;
    const float* const* in;
    float* out;
};

struct TJob { const float* W; const float* ks; bf16_t* out; int K, N, ldo, coff, upmap, ntile; };
constexpr int TRS = 260;
DI void tr_load(const TJob& J, int tile, int wave, int lane, f32x4 (&v)[8]) {
    const int nb = J.N >> 8, kb = tile / nb, n0 = (tile - kb * nb) << 8, k0 = kb << 6;
    const float* src = J.W + (size_t)(k0 + 8 * wave) * J.N + n0 + 4 * lane;
#pragma unroll
    for (int i = 0; i < 8; ++i) v[i] = NT_IN ? __builtin_nontemporal_load((const f32x4*)(src + (size_t)i * J.N)) : *(const f32x4*)(src + (size_t)i * J.N);
    if (J.ks) {
#pragma unroll
        for (int i = 0; i < 8; ++i) v[i] = v[i] * J.ks[k0 + 8 * wave + i];
    }
}
DI void tr_to_lds(LAS unsigned* P, int wave, int lane, const f32x4 (&v)[8]) {
#pragma unroll
    for (int i = 0; i < 4; ++i) {
        u32x4 w; w.x = pk2(v[2 * i].x, v[2 * i + 1].x); w.y = pk2(v[2 * i].y, v[2 * i + 1].y); w.z = pk2(v[2 * i].z, v[2 * i + 1].z); w.w = pk2(v[2 * i].w, v[2 * i + 1].w);
        *(LAS u32x4*)(P + (4 * wave + i) * TRS + 4 * lane) = w;
    }
}
DI void tr_store(const TJob& J, int tile, LAS const unsigned* P, int wave, int lane) {
    const int nb = J.N >> 8, kb = tile / nb, n0 = (tile - kb * nb) << 8, k0 = kb << 6;
    const int c = lane & 7;
#pragma unroll
    for (int jj = 0; jj < 4; ++jj) {
        const int nl = 32 * wave + 8 * jj + (lane >> 3), n = n0 + nl;
        u32x4 w; w.x = P[(4 * c + 0) * TRS + nl]; w.y = P[(4 * c + 1) * TRS + nl]; w.z = P[(4 * c + 2) * TRS + nl]; w.w = P[(4 * c + 3) * TRS + nl];
        int orow = n;
        if (J.upmap == 1) { const int b128 = n >> 7, half = b128 >= 43 ? 1 : 0; orow = 256 * (b128 - 43 * half) + 128 * half + (n & 127); }
        if (J.upmap == 2 && n >= DP && n < DP + 4 * DH) {
            const int sec = (n - DP) >> 10, c = (n - DP) & 1023, t = c >> 6, cc = c & 63;
            orow = DP + 256 * t + 128 * (sec >> 1) + 8 * (cc >> 2) + 4 * (sec & 1) + (cc & 3); }
        if (J.upmap == 2 && n >= DP + 4 * DH) {
            const int g = n - (DP + 4 * DH), half = g >= DM ? 1 : 0, ch = g - half * DM; orow = DP + 4 * DH + 256 * (ch >> 7) + 128 * half + (ch & 127); }
        *(u32x4*)(J.out + (size_t)orow * J.ldo + J.coff + k0 + 8 * c) = w;
    }
}
constexpr int TJ_NT[7] = {(DM / 64) * (DIN / 256), (DM / 64) * (DFF2 / 256), (DFF / 64) * (DM / 256), (DH / 64) * (DM / 256), (DM / 64) * (DM / 256), (DM / 64) * (DM / 256), (PLE / 64) * (DM / 256)};
constexpr int TJ_B1 = TJ_NT[0], TJ_B2 = TJ_B1 + TJ_NT[1], TJ_B3 = TJ_B2 + TJ_NT[2], TJ_B4 = TJ_B3 + TJ_NT[3], TJ_B5 = TJ_B4 + TJ_NT[4], TJ_B6 = TJ_B5 + TJ_NT[5], TJ_TOTAL = TJ_B6 + TJ_NT[6];
DI TJob tr_job(const Frame& F, int g, int& tile) {
    unsigned char* ws = F.ws; TJob J;
    if (g < TJ_B1)      { J = TJob{F.in[3],  F.in[2],  (bf16_t*)(ws + WS_WIN),   DM,  DIN,  DM,  0,  2, 0}; tile = g; }
    else if (g < TJ_B2) { J = TJob{F.in[12], F.in[11], (bf16_t*)(ws + WS_WUP),   DM,  DFF2, DM,  0,  1, 0}; tile = g - TJ_B1; }
    else if (g < TJ_B3) { J = TJob{F.in[15], nullptr,  (bf16_t*)(ws + WS_WDOWN), DFF, DM,   DFF, 0,  0, 0}; tile = g - TJ_B2; }
    else if (g < TJ_B4) { J = TJob{F.in[9],  nullptr,  (bf16_t*)(ws + WS_WAB),   DH,  DM,   DM,  DP, 0, 0}; tile = g - TJ_B3; }
    else if (g < TJ_B5) { J = TJob{F.in[10], nullptr,  (bf16_t*)(ws + WS_WOUT),  DM,  DM,   DM,  0,  0, 0}; tile = g - TJ_B4; }
    else if (g < TJ_B6) { J = TJob{F.in[17], F.in[16], (bf16_t*)(ws + WS_WPG),   DM,  DM,   DM,  0,  0, 0}; tile = g - TJ_B5; }
    else                { J = TJob{F.in[18], nullptr,  (bf16_t*)(ws + WS_WPLE),  PLE, DM,   PLE, 0,  0, 0}; tile = g - TJ_B6; }
    return J;
}
constexpr int TJ_WAT = (DP / 64) * (DM / 256), TJ_P0N = TJ_B1 + TJ_WAT;
DI TJob tr_job0(const Frame& F, int g, int& tile) {
    if (g < TJ_B1) return tr_job(F, g, tile);
    tile = g - TJ_B1; return TJob{F.in[8], F.in[5], (bf16_t*)(F.ws + WS_WAT), DP, DM, DP, 0, 0, 0};
}
DI void p0_transpose_win(Frame& F, f32x4 (&v)[8], TJob Jn, int tile, bool have) {
    LAS unsigned* P = (LAS unsigned*)F.lds;
    int g = F.vcu;
    TJob Jc{}; int tc = 0;
    while (have) {
        tr_to_lds(P, F.wave, F.lane, v);
        __syncthreads();
        Jc = Jn; tc = tile;
        g += F.G; have = g < TJ_P0N;
        if (have) { Jn = tr_job0(F, g, tile); tr_load(Jn, tile, F.wave, F.lane, v); }
        tr_store(Jc, tc, P, F.wave, F.lane);
        __syncthreads();
    }
}
DI void p0_prologue(Frame& F) {
    unsigned char* ws = F.ws;
    const int gw = F.vcu * NWAVES + F.wave, NGW = F.G * NWAVES;
    f32x4 wv[8]; TJob Jn{}; int tile0 = 0; const bool have0 = F.vcu < TJ_P0N;
    if (have0) { Jn = tr_job0(F, F.vcu, tile0); tr_load(Jn, tile0, F.wave, F.lane, wv); }
    const int gt0 = F.vcu * 512 + F.tid, NGT0 = F.G * 512;
    f32x4 pv[4];
#pragma unroll
    for (int k = 0; k < 4; ++k) { const int i = gt0 + k * NGT0; pv[k] = (f32x4){0.f, 0.f, 0.f, 0.f}; if (i < S * PLE / 4) pv[k] = ((const f32x4*)F.in[1])[i]; }
    {
        const float* x = F.in[0]; bf16_t* XB = (bf16_t*)(ws + WS_XB); float* R1 = (float*)(ws + WS_R1);
        for (int m = gw; m < S; m += NGW) {
            const f32x4* xr = (const f32x4*)(x + (size_t)m * DM) + F.lane;
            f32x4 v[8]; float s = 0.f;
#pragma unroll
            for (int j = 0; j < 8; ++j) { v[j] = NT_IN ? __builtin_nontemporal_load(xr + 64 * j) : xr[64 * j]; s += (v[j].x * v[j].x + v[j].y * v[j].y) + (v[j].z * v[j].z + v[j].w * v[j].w); }
            s = wave_sum(s);
            if (F.lane == 0) R1[m] = rsqrtf(s * (1.f / DM) + EPS);
            u32x2* o = (u32x2*)(XB + (size_t)m * DM) + F.lane;
#pragma unroll
            for (int j = 0; j < 8; ++j) { u32x2 w; w.x = pk2(v[j].x, v[j].y); w.y = pk2(v[j].z, v[j].w); o[64 * j] = w; }
        }
    }
    {
        const f32x4* p = (const f32x4*)F.in[1]; u32x2* PB = (u32x2*)(ws + WS_PB);
        const int gt = F.vcu * 512 + F.tid, NGT = F.G * 512;
#pragma unroll
        for (int k = 0; k < 4; ++k) { const int i = gt + k * NGT; if (i < S * PLE / 4) { u32x2 w; w.x = pk2(pv[k].x, pv[k].y); w.y = pk2(pv[k].z, pv[k].w); PB[i] = w; } }
        for (int i = gt + 4 * NGT; i < S * PLE / 4; i += NGT) { const f32x4 v = p[i]; u32x2 w; w.x = pk2(v.x, v.y); w.y = pk2(v.z, v.w); PB[i] = w; }
        float* LB = (float*)(ws + WS_LB); const float* lbl = F.in[6];
        { const f32x4* wm = (const f32x4*)F.in[4]; bf16_t* WMX = (bf16_t*)(ws + WS_WMX);
          for (int i = gt; i < 4 * 256 * 64; i += NGT) { const f32x4 v = wm[i]; const int g = i >> 14, c = (i >> 6) & 255, d4 = (i & 63) * 4;
              u32x2 w; w.x = pk2(v.x, v.y); w.y = pk2(v.z, v.w); *(u32x2*)(WMX + (size_t)(g * 256 + c) * DP + g * 256 + d4) = w; } }
        if (gt < DH) { const float l0 = lbl[gt], l1 = lbl[DH + gt], mx = fmaxf(l0, l1), e0 = __expf(l0 - mx), e1 = __expf(l1 - mx); LB[gt] = e0 / (e0 + e1); }
    }
    p0_transpose_win(F, wv, Jn, tile0, have0);
}
constexpr int CW_QUEUE = 20480;
DI void convert_rest(Frame& F, int quota = 1 << 30) {
    unsigned* head = (unsigned*)(F.ws + WS_CTL) + CW_QUEUE;
    volatile LAS unsigned* slot = (volatile LAS unsigned*)(F.lds + MISC_OFF) + 20;
    LAS unsigned* P = (LAS unsigned*)F.lds;
    constexpr int NFOLD = 0, NITEM = NFOLD + (TJ_TOTAL - TJ_B1);
    for (int done = 0; done < quota; ++done) {
        __syncthreads();
        if (F.tid == 0) slot[0] = __hip_atomic_fetch_add(head, 1u, __ATOMIC_RELAXED, __HIP_MEMORY_SCOPE_AGENT);
        __syncthreads();
        const int item = (int)__builtin_amdgcn_readfirstlane(slot[0]);
        if (item >= NITEM) break;
        {
            int tile = 0; const TJob J = tr_job(F, TJ_B1 + item - NFOLD, tile);
            f32x4 v[8];
            tr_load(J, tile, F.wave, F.lane, v);
            tr_to_lds(P, F.wave, F.lane, v);
            __syncthreads();
            tr_store(J, tile, P, F.wave, F.lane);
        }
    }
    __syncthreads();
}


DI float row_rstd(const float* ssq, int row, int fq) {
    const f32x4* p = (const f32x4*)(ssq + (size_t)row * 32 + fq * 8);
    const f32x4 a = p[0], b = p[1];
    float s = ((a.x + a.y) + (a.z + a.w)) + ((b.x + b.y) + (b.z + b.w));
    s += __shfl_xor(s, 16); s += __shfl_xor(s, 32);
    return rsqrtf(s * (1.f / DM) + EPS);
}

DI void row_rstd8(const float* ssq, int row0, int fq, float (&r)[2][4]) {
    f32x4 a[2][4], b[2][4];
#pragma unroll
    for (int ai = 0; ai < 2; ++ai)
#pragma unroll
        for (int m = 0; m < 4; ++m) { const f32x4* p = (const f32x4*)(ssq + (size_t)(row0 + ai * 128 + m * 16) * 32 + fq * 8); a[ai][m] = p[0]; b[ai][m] = p[1]; }
#pragma unroll
    for (int ai = 0; ai < 2; ++ai)
#pragma unroll
        for (int m = 0; m < 4; ++m) {
            float s = ((a[ai][m].x + a[ai][m].y) + (a[ai][m].z + a[ai][m].w)) + ((b[ai][m].x + b[ai][m].y) + (b[ai][m].z + b[ai][m].w));
            s += __shfl_xor(s, 16); s += __shfl_xor(s, 32);
            r[ai][m] = rsqrtf(s * (1.f / DM) + EPS);
        }
}
DI void lds_read4x16(unsigned addr, f32x4& a, f32x4& b, f32x4& c, f32x4& d) {
    asm volatile("ds_read_b128 %0, %4\n\tds_read_b128 %1, %4 offset:1024\n\tds_read_b128 %2, %4 offset:2048\n\tds_read_b128 %3, %4 offset:3072\n\ts_waitcnt lgkmcnt(0)"
                 : "=&v"(a), "=&v"(b), "=&v"(c), "=&v"(d) : "v"(addr) : "memory");
}

struct EpiProj {
    static constexpr int MIDK = 0; static constexpr bool AFTER_DRAIN = false; static constexpr bool HAS_PRE = false;
    unsigned char* ws; float* dout;
    DI void operator()(const AccT& acc, const Unit& u, int wr, int wc, int fr, int fq) const {
        asm volatile("" : "+v"(fr), "+v"(fq));
        const float* R1 = (const float*)(ws + WS_R1);
        const int pn = u.pn, row0 = u.pm * 256 + wr * 64 + fr, cl = wc * 32 + 8 * fq;
        float rs[2][4];
#pragma unroll
        for (int ai = 0; ai < 2; ++ai)
#pragma unroll
            for (int m = 0; m < 4; ++m) rs[ai][m] = R1[row0 + ai * 128 + m * 16];
        if (pn >= 4 && pn < 20) {
            const float* LB = (const float*)(ws + WS_LB); bf16_t* Qp = (bf16_t*)(ws + WS_Q); bf16_t* K2 = (bf16_t*)(ws + WS_KK);
            bf16_t* Vo = (bf16_t*)(ws + WS_V); bf16_t* SGo = (bf16_t*)(ws + WS_SG); float* DL = (float*)(ws + WS_DL);
            const int t = pn - 4, hd = t >> 1, k4 = 64 * (t & 1) + 16 * wc + 4 * fq;
            const int lane = fq * 16 + fr, bsel = ((lane & ~15) | 15) << 2;
            const f32x4 lb = *(const f32x4*)(LB + hd * 128 + k4);
#pragma unroll
            for (int ai = 0; ai < 2; ++ai) {
                f32x4 lf[4], kk[4];
#pragma unroll
                for (int m = 0; m < 4; ++m)
#pragma unroll
                    for (int c = 0; c < 4; ++c) { const float v = acc[ai][0][m][1][c] * rs[ai][m]; const float sg = sigm(v); const float f = lb[c] + (1.f - lb[c]) * sg;
                        lf[m][c] = __logf(f); kk[m][c] = (1.f - lb[c]) * (1.f - sg); }
                f32x4 b63;
#pragma unroll
                for (int c = 0; c < 4; ++c) {
                    float carry = 0.f;
#pragma unroll
                    for (int m = 0; m < 4; ++m) {
                        float x = lf[m][c];
                        x += dppf<0x111>(x); x += dppf<0x112>(x); x += dppf<0x114>(x); x += dppf<0x118>(x);
                        const float tot = __builtin_bit_cast(float, __builtin_amdgcn_ds_bpermute(bsel, __builtin_bit_cast(int, x)));
                        lf[m][c] = x + carry; carry += tot;
                    }
                    b63[c] = carry;
                }
                const int chunk = 4 * u.pm + 2 * ai + wr;
                if (fr == 0) { f32x4 e63; e63.x = __expf(b63.x); e63.y = __expf(b63.y); e63.z = __expf(b63.z); e63.w = __expf(b63.w); *(f32x4*)(DL + (size_t)chunk * DH + hd * 128 + k4) = e63; }
#pragma unroll
                for (int m = 0; m < 4; ++m) {
                    const size_t of = (size_t)(chunk * 8 + hd) * 8192 + fq_off(m >> 1, 4 * (t & 1) + wc, 16 * (m & 1) + fr + 32 * (fq >> 1)) + 4 * (fq & 1);
                    const size_t orow = (size_t)(row0 + ai * 128 + m * 16) * DH + hd * 128 + k4;
                    f32x4 qp, k2, vv, sgv;
#pragma unroll
                    for (int c = 0; c < 4; ++c) {
                        const float ex = __expf(lf[m][c]);
                        qp[c] = acc[ai][0][m][0][c] * rs[ai][m] * ex; k2[c] = kk[m][c] * __builtin_amdgcn_rcpf(ex);
                        vv[c] = acc[ai][1][m][0][c] * rs[ai][m]; const float g = acc[ai][1][m][1][c] * rs[ai][m]; sgv[c] = g * sigm(g);
                    }
                    u32x2 w;
                    w.x = pk2(qp.x, qp.y); w.y = pk2(qp.z, qp.w); *(u32x2*)(Qp + of) = w;
                    w.x = pk2(k2.x, k2.y); w.y = pk2(k2.z, k2.w); *(u32x2*)(K2 + of) = w;
                    w.x = pk2(vv.x, vv.y); w.y = pk2(vv.z, vv.w); *(u32x2*)(Vo + orow) = w;
                    w.x = pk2(sgv.x, sgv.y); w.y = pk2(sgv.z, sgv.w); *(u32x2*)(SGo + orow) = w;
                }
            }
        } else if (pn >= 20) {
            bf16_t* RT = (bf16_t*)dout; bf16_t* GBo = (bf16_t*)dout + (size_t)S * DM;
            const int ch0 = 128 * (pn - 20) + cl;
#pragma unroll
            for (int ai = 0; ai < 2; ++ai)
#pragma unroll
                for (int m = 0; m < 4; ++m) {
                    const size_t o = (size_t)(row0 + ai * 128 + m * 16) * DM + ch0;
                    f32x4 r0, r1, g0, g1;
#pragma unroll
                    for (int c = 0; c < 4; ++c) {
                        const float ea0 = __expf(-__builtin_amdgcn_fmed3f(acc[ai][0][m][0][c] * rs[ai][m], -60.f, 60.f)), eb0 = __expf(-__builtin_amdgcn_fmed3f(acc[ai][1][m][0][c] * rs[ai][m], -60.f, 60.f));
                        const float ea1 = __expf(-__builtin_amdgcn_fmed3f(acc[ai][0][m][1][c] * rs[ai][m], -60.f, 60.f)), eb1 = __expf(-__builtin_amdgcn_fmed3f(acc[ai][1][m][1][c] * rs[ai][m], -60.f, 60.f));
                        r0[c] = (1.0f + eb0) * __builtin_amdgcn_rcpf(1.0f + ea0); g0[c] = __builtin_amdgcn_rcpf(1.0f + eb0);
                        r1[c] = (1.0f + eb1) * __builtin_amdgcn_rcpf(1.0f + ea1); g1[c] = __builtin_amdgcn_rcpf(1.0f + eb1);
                    }
                    *(u32x4*)(RT + o) = pack8(r0, r1); *(u32x4*)(GBo + o) = pack8(g0, g1);
                }
        } else {
        bf16_t* O = (bf16_t*)(ws + WS_UP);
#pragma unroll
        for (int ai = 0; ai < 2; ++ai)
#pragma unroll
            for (int m = 0; m < 4; ++m) {
                bf16_t* rowp = O + (size_t)(row0 + ai * 128 + m * 16) * DP + pn * 256 + cl;
#pragma unroll
                for (int bj = 0; bj < 2; ++bj) *(u32x4*)(rowp + bj * 128) = pack8(acc[ai][bj][m][0] * rs[ai][m], acc[ai][bj][m][1] * rs[ai][m]);
            }
        }
        asm volatile("" :: "v"(rs[0][0]), "v"(rs[0][1]), "v"(rs[0][2]), "v"(rs[0][3]), "v"(rs[1][0]), "v"(rs[1][1]), "v"(rs[1][2]), "v"(rs[1][3]));
    }
};

struct EpiBf {
    static constexpr int MIDK = 0; static constexpr bool AFTER_DRAIN = false; static constexpr bool HAS_PRE = false;
    bf16_t* O; int ld;
    DI void operator()(const AccT& acc, const Unit& u, int wr, int wc, int fr, int fq) const {
        asm volatile("" : "+v"(fr), "+v"(fq));
        const int row0 = u.pm * 256 + wr * 64 + fr, col0 = u.pn * 256 + wc * 32 + 8 * fq;
#pragma unroll
        for (int ai = 0; ai < 2; ++ai)
#pragma unroll
            for (int m = 0; m < 4; ++m)
#pragma unroll
                for (int bj = 0; bj < 2; ++bj) *(u32x4*)(O + (size_t)(row0 + ai * 128 + m * 16) * ld + col0 + bj * 128) = pack8(acc[ai][bj][m][0], acc[ai][bj][m][1]);
    }
};
template <int MODE> struct EpiGate {
    static constexpr int MIDK = 0; static constexpr bool AFTER_DRAIN = false; static constexpr bool HAS_PRE = false;
    const bf16_t* G; float* TMP; bf16_t* MG;
    DI void operator()(const AccT& acc, const Unit& u, int wr, int wc, int fr, int fq) const {
        asm volatile("" : "+v"(fr), "+v"(fq));
        const int row0 = u.pm * 256 + wr * 64 + fr, col0 = u.pn * 256 + wc * 32 + 8 * fq;
#pragma unroll
        for (int ai = 0; ai < 2; ++ai)
#pragma unroll
            for (int m = 0; m < 4; ++m)
#pragma unroll
                for (int bj = 0; bj < 2; ++bj) {
                    const size_t o = (size_t)(row0 + ai * 128 + m * 16) * DM + col0 + bj * 128;
                    f32x4 g0, g1; unpack8(*(const u32x4*)(G + o), g0, g1);
                    f32x4 v0 = acc[ai][bj][m][0] * g0, v1 = acc[ai][bj][m][1] * g1;
                    if (MODE == 0) { *(f32x4*)(TMP + o) = v0; *(f32x4*)(TMP + o + 4) = v1; }
                    else { v0 += *(const f32x4*)(TMP + o); v1 += *(const f32x4*)(TMP + o + 4); *(u32x4*)(MG + o) = pack8(v0, v1); }
                }
    }
};
struct EpiMerge {
    static constexpr int MIDK = 16; static constexpr bool AFTER_DRAIN = false; static constexpr bool HAS_PRE = false;
    const bf16_t* GA; const bf16_t* GB; bf16_t* MG;
    DI void mid(AccT& acc, const Unit& u, int wr, int wc, int fr, int fq) const {
        asm volatile("" : "+v"(fr), "+v"(fq));
        const int row0 = u.pm * 256 + wr * 64 + fr, col0 = u.pn * 256 + wc * 32 + 8 * fq;
#pragma unroll
        for (int ai = 0; ai < 2; ++ai)
#pragma unroll
            for (int m = 0; m < 4; ++m)
#pragma unroll
                for (int bj = 0; bj < 2; ++bj) {
                    const size_t o = (size_t)(row0 + ai * 128 + m * 16) * DM + col0 + bj * 128;
                    f32x4 a0, a1; unpack8(*(const u32x4*)(GA + o), a0, a1);
                    acc[ai][bj][m][0] = acc[ai][bj][m][0] * a0; acc[ai][bj][m][1] = acc[ai][bj][m][1] * a1;
                }
    }
    DI void operator()(const AccT& acc, const Unit& u, int wr, int wc, int fr, int fq) const {
        asm volatile("" : "+v"(fr), "+v"(fq));
        const int row0 = u.pm * 256 + wr * 64 + fr, col0 = u.pn * 256 + wc * 32 + 8 * fq;
#pragma unroll
        for (int ai = 0; ai < 2; ++ai)
#pragma unroll
            for (int m = 0; m < 4; ++m)
#pragma unroll
                for (int bj = 0; bj < 2; ++bj) {
                    const size_t o = (size_t)(row0 + ai * 128 + m * 16) * DM + col0 + bj * 128;
                    f32x4 b0, b1; unpack8(*(const u32x4*)(GB + o), b0, b1);
                    *(u32x4*)(MG + o) = pack8(acc[ai][bj][m][0] * b0, acc[ai][bj][m][1] * b1);
                }
    }
};
template <bool BF> struct EpiResB {
    static constexpr int MIDK = 0; static constexpr bool AFTER_DRAIN = false; static constexpr bool HAS_PRE = false;
    const void* base; bf16_t* xb; float* ssq;
    DI void operator()(const AccT& acc, const Unit& u, int wr, int wc, int fr, int fq) const {
        asm volatile("" : "+v"(fr), "+v"(fq));
        const int row0 = u.pm * 256 + wr * 64 + fr, col0 = u.pn * 256 + wc * 32 + 8 * fq;
#pragma unroll
        for (int ai = 0; ai < 2; ++ai)
#pragma unroll
            for (int m = 0; m < 4; ++m) {
                const int row = row0 + ai * 128 + m * 16; float s = 0.f;
#pragma unroll
                for (int bj = 0; bj < 2; ++bj) {
                    const size_t o = (size_t)row * DM + col0 + bj * 128;
                    f32x4 x0, x1;
                    if (BF) unpack8(*(const u32x4*)((const bf16_t*)base + o), x0, x1);
                    else { x0 = *(const f32x4*)((const float*)base + o); x1 = *(const f32x4*)((const float*)base + o + 4); }
                    const f32x4 v0 = acc[ai][bj][m][0] + x0, v1 = acc[ai][bj][m][1] + x1;
                    *(u32x4*)(xb + o) = pack8(v0, v1);
                    s += ((v0.x * v0.x + v0.y * v0.y) + (v0.z * v0.z + v0.w * v0.w)) + ((v1.x * v1.x + v1.y * v1.y) + (v1.z * v1.z + v1.w * v1.w));
                }
                s += __shfl_xor(s, 16); s += __shfl_xor(s, 32);
                if (fq == 0) ssq[(size_t)row * 32 + u.pn * 4 + wc] = s;
            }
    }
};
struct EpiRes {
    static constexpr int MIDK = 0; static constexpr bool AFTER_DRAIN = false; static constexpr bool HAS_PRE = false;
    const float* base; float* xo; bf16_t* xb; float* ssq;
    DI void operator()(const AccT& acc, const Unit& u, int wr, int wc, int fr, int fq) const {
        asm volatile("" : "+v"(fr), "+v"(fq));
        const int row0 = u.pm * 256 + wr * 64 + fr, col0 = u.pn * 256 + wc * 32 + 8 * fq;
#pragma unroll
        for (int ai = 0; ai < 2; ++ai)
#pragma unroll
            for (int m = 0; m < 4; ++m) {
                const int row = row0 + ai * 128 + m * 16; float s = 0.f;
#pragma unroll
                for (int bj = 0; bj < 2; ++bj) {
                    const size_t o = (size_t)row * DM + col0 + bj * 128;
                    const f32x4 v0 = acc[ai][bj][m][0] + *(const f32x4*)(base + o), v1 = acc[ai][bj][m][1] + *(const f32x4*)(base + o + 4);
                    *(f32x4*)(xo + o) = v0; *(f32x4*)(xo + o + 4) = v1; *(u32x4*)(xb + o) = pack8(v0, v1);
                    s += ((v0.x * v0.x + v0.y * v0.y) + (v0.z * v0.z + v0.w * v0.w)) + ((v1.x * v1.x + v1.y * v1.y) + (v1.z * v1.z + v1.w * v1.w));
                }
                s += __shfl_xor(s, 16); s += __shfl_xor(s, 32);
                if (fq == 0) ssq[(size_t)row * 32 + u.pn * 4 + wc] = s;
            }
    }
};
constexpr int CONV_LDS = 131584;
struct EpiUp {
    static constexpr int MIDK = 0; static constexpr bool AFTER_DRAIN = false; static constexpr bool HAS_PRE = true;
    unsigned char* ws; const float* cw; const float* cb; LAS unsigned char* lds;
    DI void pre(LAS unsigned char* l, const Unit& u, int wid, int lane) const {
        if (wid < 4) {
            const int col = (lane < 32) ? 128 * u.pn + 4 * lane : DFF + 128 * u.pn + 4 * (lane - 32);
            const float* src = (wid < 3 ? cw + (size_t)wid * DFF2 : cb) + col;
            __builtin_amdgcn_global_load_lds((const unsigned*)src, (LAS unsigned*)(l + CONV_LDS + (u.ui & 1) * 4096 + wid * 1024), 16, 0, 0);
        }
    }
    DI void operator()(const AccT& acc, const Unit& u, int wr, int wc, int fr, int fq) const {
        asm volatile("" : "+v"(fr), "+v"(fq));
        const float* SSQ = (const float*)(ws + WS_SSQ1); bf16_t* ACT = (bf16_t*)(ws + WS_ACT); float* ZB = (float*)(ws + WS_ZB);
        const int row0 = u.pm * 256 + wr * 64 + fr, j = u.pn;
#pragma unroll
        for (int ai = 0; ai < 2; ++ai) {
            float r2[4];
#pragma unroll
            for (int m = 0; m < 4; ++m) r2[m] = row_rstd(SSQ, row0 + ai * 128 + m * 16, fq);
            const int blk = 4 * u.pm + 2 * ai + wr;
#pragma unroll
            for (int n = 0; n < 2; ++n) {
                int fq2 = fq; asm volatile("" : "+v"(fq2));
                const int ch = 128 * j + 32 * wc + 8 * fq2 + 4 * n;
                const int pc = 256 * j + 32 * wc + 8 * fq2 + 4 * n;
                const unsigned cbase = (unsigned)(size_t)(lds + CONV_LDS + (u.ui & 1) * 4096) + (unsigned)(32 * wc + 8 * fq2) * 4u;
                float* zb = ZB + (size_t)blk * 4 * DFF2 + pc;
                if (fr < 2) { *(f32x4*)(zb + (size_t)fr * DFF2) = acc[ai][0][0][n] * r2[0]; *(f32x4*)(zb + (size_t)fr * DFF2 + 128) = acc[ai][1][0][n] * r2[0]; }
                if (fr >= 14) { *(f32x4*)(zb + (size_t)(fr - 12) * DFF2) = acc[ai][0][3][n] * r2[3]; *(f32x4*)(zb + (size_t)(fr - 12) * DFF2 + 128) = acc[ai][1][3][n] * r2[3]; }
                f32x4 uv[4];
                {
                    f32x4 w0, w1, w2, bb; lds_read4x16(cbase + (128 + 4 * n) * 4u, w0, w1, w2, bb);
#pragma unroll
                    for (int m = 0; m < 4; ++m) {
                        const f32x4 zc = acc[ai][1][m][n] * r2[m], zp = acc[ai][1][m > 0 ? m - 1 : 0][n] * r2[m > 0 ? m - 1 : 0];
#pragma unroll
                        for (int c = 0; c < 4; ++c) {
                            const float s1 = (m > 0 && fr == 15) ? zp[c] : zc[c], s2 = (m > 0 && fr >= 14) ? zp[c] : zc[c];
                            uv[m][c] = bb[c] + w2[c] * zc[c] + w1[c] * dppf<0x121>(s1) + w0[c] * dppf<0x122>(s2);
                        }
                    }
                }
                {
                    f32x4 w0, w1, w2, bb; lds_read4x16(cbase + (4 * n) * 4u, w0, w1, w2, bb);
#pragma unroll
                    for (int m = 0; m < 4; ++m) {
                        const f32x4 zc = acc[ai][0][m][n] * r2[m], zp = acc[ai][0][m > 0 ? m - 1 : 0][n] * r2[m > 0 ? m - 1 : 0];
                        f32x4 ug;
#pragma unroll
                        for (int c = 0; c < 4; ++c) {
                            const float s1 = (m > 0 && fr == 15) ? zp[c] : zc[c], s2 = (m > 0 && fr >= 14) ? zp[c] : zc[c];
                            ug[c] = bb[c] + w2[c] * zc[c] + w1[c] * dppf<0x121>(s1) + w0[c] * dppf<0x122>(s2);
                        }
                        if (m > 0 || fr >= 2) {
                            u32x2 w; w.x = pk2(ug.x * sigm(ug.x) * uv[m].x, ug.y * sigm(ug.y) * uv[m].y); w.y = pk2(ug.z * sigm(ug.z) * uv[m].z, ug.w * sigm(ug.w) * uv[m].w);
                            *(u32x2*)(ACT + (size_t)(row0 + ai * 128 + m * 16) * DFF + ch) = w;
                        }
                    }
                }
                __builtin_amdgcn_sched_barrier(0);
            }
        }
    }
};
struct EpiUpKS {
    static constexpr int MIDK = 0; static constexpr bool AFTER_DRAIN = true; static constexpr bool HAS_PRE = true;
    EpiUp base;
    DI void pre(LAS unsigned char* l, const Unit& u, int wid, int lane) const {
        base.pre(l, u, wid, lane);
        if (u.kind == 1 && wid == 0 && lane == 0) __hip_atomic_store((unsigned*)(base.ws + WS_CTL) + CW_KS + 64 * u.sl + 1, 1u + xb_xcc_id(), __ATOMIC_RELAXED, __HIP_MEMORY_SCOPE_AGENT);
    }
    DI void fused(AccT& acc, const Unit& u, int wr, int wc, int fr, int fq) const {
        int f0 = fr, f1 = fq; asm volatile("" : "+v"(f0), "+v"(f1));
        float* slab = (float*)(base.ws + WS_SLAB) + (size_t)u.sl * 65536 + (size_t)(((wr * 4 + wc) * 64 + f1 * 16 + f0) * 4);
        unsigned* flag = (unsigned*)(base.ws + WS_CTL) + CW_KS + 64 * u.sl;
        if (u.kind == 2) {
#pragma unroll
            for (int a = 0; a < 2; ++a)
#pragma unroll
                for (int b = 0; b < 2; ++b)
#pragma unroll
                    for (int m = 0; m < 4; ++m)
#pragma unroll
                        for (int n = 0; n < 2; ++n) *(f32x4*)(slab + (size_t)((((a * 2 + b) * 4 + m) * 2 + n) * 2048)) = acc[a][b][m][n];
            asm volatile("s_waitcnt vmcnt(0)" ::: "memory");
            __syncthreads();
            if (wr == 0 && wc == 0 && (f0 | f1) == 0) {
                const bool same_l2 = __hip_atomic_load(flag + 1, __ATOMIC_RELAXED, __HIP_MEMORY_SCOPE_AGENT) == 1u + xb_xcc_id();
                if (!same_l2) __builtin_amdgcn_fence(__ATOMIC_RELEASE, "agent");
                asm volatile("s_waitcnt vmcnt(0)" ::: "memory");
                __hip_atomic_store(flag, 1u, __ATOMIC_RELAXED, __HIP_MEMORY_SCOPE_AGENT);
            }
            return;
        }
        if (wr == 0 && wc == 0) {
            unsigned spins = 0;
            while ((unsigned)__builtin_amdgcn_readfirstlane(__hip_atomic_load(flag, __ATOMIC_RELAXED, __HIP_MEMORY_SCOPE_AGENT)) == 0u) {
                __builtin_amdgcn_s_sleep(2);
                if (++spins > (1u << 22)) break;
            }
            __builtin_amdgcn_fence(__ATOMIC_ACQUIRE, "agent");
            asm volatile("s_waitcnt vmcnt(0)" ::: "memory");
        }
        __syncthreads();
#define KS_LOAD(t, g) _Pragma("unroll") for (int q = 0; q < 8; ++q) t[q] = *(const f32x4*)(sp + (size_t)(((g) * 8 + q) * 2048))
#define KS_ADD(t, g) do { _Pragma("unroll") for (int q = 0; q < 8; ++q) acc[(g) >> 1][(g) & 1][q >> 1][q & 1] += t[q]; \
            asm volatile("" : "+v"(sp), "+v"(acc[(g) >> 1][(g) & 1][0][0]), "+v"(acc[(g) >> 1][(g) & 1][0][1]), "+v"(acc[(g) >> 1][(g) & 1][1][0]), "+v"(acc[(g) >> 1][(g) & 1][1][1]), \
                         "+v"(acc[(g) >> 1][(g) & 1][2][0]), "+v"(acc[(g) >> 1][(g) & 1][2][1]), "+v"(acc[(g) >> 1][(g) & 1][3][0]), "+v"(acc[(g) >> 1][(g) & 1][3][1])); } while (0)
        {
            const float* sp = slab; asm volatile("" : "+v"(sp));
            f32x4 t0[8], t1[8];
            KS_LOAD(t0, 0); KS_LOAD(t1, 1);
            KS_ADD(t0, 0); KS_LOAD(t0, 2);
            KS_ADD(t1, 1); KS_LOAD(t1, 3);
            KS_ADD(t0, 2); KS_ADD(t1, 3);
        }
#undef KS_LOAD
#undef KS_ADD
        base(acc, u, wr, wc, fr, fq);
    }
};
constexpr int CW_PANEL = 16384;
struct EpiPle {
    static constexpr int MIDK = 0; static constexpr bool AFTER_DRAIN = true; static constexpr bool HAS_PRE = false;
    unsigned char* ws; float* xo; const float* wf;
    DI void fused(AccT& acc, const Unit& u, int wr, int wc, int fr, int fq) const {
        asm volatile("" : "+v"(fr), "+v"(fq));
        const float* SSQ = (const float*)(ws + WS_SSQ2); float* ssq = (float*)(ws + WS_SSQ3); const bf16_t* Eb = (const bf16_t*)(ws + WS_E); const bf16_t* X2 = (const bf16_t*)(ws + WS_XB);
        unsigned* cnt = (unsigned*)(ws + WS_CTL) + CW_PANEL + 64 * u.pm;
        const int row0 = u.pm * 256 + wr * 64 + fr, col0 = u.pn * 256 + wc * 32 + 8 * fq;
#pragma unroll
        for (int ai = 0; ai < 2; ++ai)
#pragma unroll
            for (int m = 0; m < 4; ++m) {
                const int row = row0 + ai * 128 + m * 16; float s = 0.f;
                const float r3 = row_rstd(SSQ, row, fq);
#pragma unroll
                for (int bj = 0; bj < 2; ++bj) {
                    const size_t o = (size_t)row * DM + col0 + bj * 128;
                    f32x4 e0, e1, v0, v1; unpack8(*(const u32x4*)(Eb + o), e0, e1); unpack8(*(const u32x4*)(X2 + o), v0, v1);
#pragma unroll
                    for (int c = 0; c < 4; ++c) { v0[c] += sigm(acc[ai][bj][m][0][c] * r3) * e0[c]; v1[c] += sigm(acc[ai][bj][m][1][c] * r3) * e1[c]; }
                    acc[ai][bj][m][0] = v0; acc[ai][bj][m][1] = v1;
                    s += ((v0.x * v0.x + v0.y * v0.y) + (v0.z * v0.z + v0.w * v0.w)) + ((v1.x * v1.x + v1.y * v1.y) + (v1.z * v1.z + v1.w * v1.w));
                }
                s += __shfl_xor(s, 16); s += __shfl_xor(s, 32);
                if (fq == 0) __hip_atomic_store((unsigned*)ssq + (size_t)row * 32 + u.pn * 4 + wc, __builtin_bit_cast(unsigned, s), __ATOMIC_RELAXED, __HIP_MEMORY_SCOPE_AGENT);
            }
        asm volatile("s_waitcnt vmcnt(0)" ::: "memory");
        if ((fr | fq) == 0) __hip_atomic_fetch_add(cnt, 1u, __ATOMIC_RELAXED, __HIP_MEMORY_SCOPE_AGENT);
        if (wr == 0 && wc == 0) {
            unsigned spins = 0;
            while ((unsigned)__builtin_amdgcn_readfirstlane(__hip_atomic_load(cnt, __ATOMIC_RELAXED, __HIP_MEMORY_SCOPE_AGENT)) < 64u) {
                __builtin_amdgcn_s_sleep(2);
                if (++spins > (1u << 22)) break;
            }
            __builtin_amdgcn_fence(__ATOMIC_ACQUIRE, "agent");
            asm volatile("s_waitcnt vmcnt(0)" ::: "memory");
        }
        __syncthreads();
        const f32x4 w00 = *(const f32x4*)(wf + col0), w01 = *(const f32x4*)(wf + col0 + 4), w10 = *(const f32x4*)(wf + col0 + 128), w11 = *(const f32x4*)(wf + col0 + 132);
#pragma unroll
        for (int ai = 0; ai < 2; ++ai)
#pragma unroll
            for (int m = 0; m < 4; ++m) {
                const int row = row0 + ai * 128 + m * 16;
                const float r4 = row_rstd(ssq, row, fq);
                const size_t o = (size_t)row * DM + col0;
                *(f32x4*)(xo + o) = acc[ai][0][m][0] * r4 * w00; *(f32x4*)(xo + o + 4) = acc[ai][0][m][1] * r4 * w01;
                *(f32x4*)(xo + o + 128) = acc[ai][1][m][0] * r4 * w10; *(f32x4*)(xo + o + 132) = acc[ai][1][m][1] * r4 * w11;
            }
    }
};

template <int W> DI void pool_item(const bf16_t* UP, bf16_t* DOB, int t0, int c0) {
    f32x4 ra[W + 7], rb[W + 7];
#pragma unroll
    for (int i = 0; i < W + 7; ++i) { const int t = t0 - (W - 1) + i; if (t >= 0) unpack8(*(const u32x4*)(UP + (size_t)t * DP + c0), ra[i], rb[i]); else { ra[i] = (f32x4){0.f, 0.f, 0.f, 0.f}; rb[i] = ra[i]; } }
    f32x4 sa = {0.f, 0.f, 0.f, 0.f}, sb = sa;
#pragma unroll
    for (int i = 0; i < W - 1; ++i) { sa += ra[i]; sb += rb[i]; }
#pragma unroll
    for (int j = 0; j < 8; ++j) {
        sa += ra[W - 1 + j]; sb += rb[W - 1 + j];
        const int t = t0 + j; const float inv = 1.f / (float)((t + 1 < W) ? t + 1 : W);
        *(u32x4*)(DOB + (size_t)t * DM + c0) = pack8(sa * inv - ra[W - 1 + j], sb * inv - rb[W - 1 + j]);
        sa -= ra[j]; sb -= rb[j];
    }
}
DI void pool_phase(Frame& F) {
    const bf16_t* UP = (const bf16_t*)(F.ws + WS_UP); bf16_t* DOB = (bf16_t*)(F.ws + WS_DOB);
    const int gt = F.vcu * 512 + F.tid, NGT = F.G * 512;
    for (int idx = gt; idx < (S / 8) * 128; idx += NGT) {
        const int t0 = (idx >> 7) * 8, c0 = (idx & 127) * 8, g = c0 >> 8;
        if (g == 0) pool_item<2>(UP, DOB, t0, c0); else if (g == 1) pool_item<4>(UP, DOB, t0, c0); else if (g == 2) pool_item<8>(UP, DOB, t0, c0); else pool_item<16>(UP, DOB, t0, c0);
    }
}

struct PoolRegs { u32x4 v[23]; int t0, c0, W; };
DI void pool_load(Frame& F, PoolRegs& P) {
    const bf16_t* UP = (const bf16_t*)(F.ws + WS_UP);
    const int idx = F.vcu * 512 + F.tid;
    P.t0 = (idx >> 7) * 8; P.c0 = (idx & 127) * 8; P.W = 2 << (P.c0 >> 8);
#pragma unroll
    for (int i = 0; i < 23; ++i) {
        const int t = P.t0 - 15 + i;
        P.v[i] = (u32x4){0u, 0u, 0u, 0u};
        if (i >= 16 - P.W && t >= 0) P.v[i] = *(const u32x4*)(UP + (size_t)t * DP + P.c0);
    }
}
DI void pool_finish(Frame& F, const PoolRegs& P) {
    bf16_t* DOB = (bf16_t*)(F.ws + WS_DOB);
    f32x4 sa = {0.f, 0.f, 0.f, 0.f}, sb = sa;
#pragma unroll
    for (int i = 0; i < 15; ++i) { f32x4 a, b; unpack8(P.v[i], a, b); sa += a; sb += b; }
#pragma unroll
    for (int j = 0; j < 8; ++j) {
        f32x4 ca, cb; unpack8(P.v[15 + j], ca, cb); sa += ca; sb += cb;
        const int t = P.t0 + j; const float inv = 1.f / (float)((t + 1 < P.W) ? t + 1 : P.W);
        *(u32x4*)(DOB + (size_t)t * DM + P.c0) = pack8(sa * inv - ca, sb * inv - cb);
        const u32x4 lv = P.W == 2 ? P.v[14 + j] : P.W == 4 ? P.v[12 + j] : P.W == 8 ? P.v[8 + j] : P.v[j];
        f32x4 la, lb; unpack8(lv, la, lb); sa -= la; sb -= lb;
    }
}

constexpr int TROW = 72;
constexpr int SROW = 136;
constexpr int H_VT = 0, H_KT = 18432, H_ST = 36864, H_QF = 71680, H_KF = 88064, H_NRM = 104448;
DI int ctile_off(int vt, int kt, int i, int lane) { return ((vt * 4 + kt) * 16 + i) * 64 + lane; }
DI int b63_off(int k) { return fq_off(1, k >> 4, 31 + 32 * ((k >> 3) & 1)) + (k & 7); }

struct HRegs { u32x4 v0, v1, q[2], k2[2]; f32x4 ea[2], eb[2]; float d0, d1; };
struct HCur { float d0, d1; };
template <bool WITH_Q>
DI void h_load_chunk(Frame& F, int uidx, HRegs& R) {
    const bf16_t* V = (const bf16_t*)(F.ws + WS_V); const bf16_t* K2 = (const bf16_t*)(F.ws + WS_KK); const bf16_t* Q = (const bf16_t*)(F.ws + WS_Q);
    const float* DL = (const float*)(F.ws + WS_DL);
    const int tid = F.tid, s = tid & 63, cg = F.wave;
    const int n = uidx >> 3, h = uidx & 7, t = 64 * n + s, col = h * 128 + 16 * cg;
    R.v0 = *(const u32x4*)(V + (size_t)t * DH + col); R.v1 = *(const u32x4*)(V + (size_t)t * DH + col + 8);
#pragma unroll
    for (int i = 0; i < 2; ++i) {
        const int f = tid + 512 * i, k0 = 16 * ((f >> 6) & 7) + 8 * ((f & 63) >> 5);
        R.k2[i] = *(const u32x4*)(K2 + (size_t)uidx * 8192 + f * 8);
        if (WITH_Q) R.q[i] = *(const u32x4*)(Q + (size_t)uidx * 8192 + f * 8);
        R.ea[i] = *(const f32x4*)(DL + (size_t)n * DH + h * 128 + k0); R.eb[i] = *(const f32x4*)(DL + (size_t)n * DH + h * 128 + k0 + 4);
    }
    { const int kt0 = 2 * (F.wave & 1), r = F.lane & 31; R.d0 = DL[(size_t)n * DH + h * 128 + 32 * kt0 + r]; R.d1 = DL[(size_t)n * DH + h * 128 + 32 * kt0 + 32 + r]; }
}
template <bool WITH_Q>
DI void h_stage_chunk(Frame& F, const HRegs& R, HCur& C) {
    C.d0 = R.d0; C.d1 = R.d1;
    LAS short* VT = (LAS short*)(F.lds + H_VT); LAS short* KT = (LAS short*)(F.lds + H_KT);
    const int tid = F.tid, s = tid & 63, cg = F.wave;
    const unsigned vw[8] = {R.v0.x, R.v0.y, R.v0.z, R.v0.w, R.v1.x, R.v1.y, R.v1.z, R.v1.w};
#pragma unroll
    for (int i = 0; i < 8; ++i) { VT[(16 * cg + 2 * i) * TROW + s] = (short)(vw[i] & 0xffffu); VT[(16 * cg + 2 * i + 1) * TROW + s] = (short)(vw[i] >> 16); }
#pragma unroll
    for (int i = 0; i < 2; ++i) {
        const int f = tid + 512 * i, ti = f >> 9, st = (f >> 6) & 7, lp = f & 63, ss = 32 * ti + (lp & 31), k0 = 16 * st + 8 * (lp >> 5);
        if (WITH_Q) { *(LAS u32x4*)(F.lds + H_QF + f * 16) = R.q[i]; *(LAS u32x4*)(F.lds + H_KF + f * 16) = R.k2[i]; }
        f32x4 ka, kb; unpack8(R.k2[i], ka, kb);
        const u32x4 kp = pack8(ka * R.ea[i], kb * R.eb[i]);
        const unsigned kw[4] = {kp.x, kp.y, kp.z, kp.w};
#pragma unroll
        for (int c = 0; c < 4; ++c) { KT[(k0 + 2 * c) * TROW + ss] = (short)(kw[c] & 0xffffu); KT[(k0 + 2 * c + 1) * TROW + ss] = (short)(kw[c] >> 16); }
    }
}
DI void h_state_update(Frame& F, const HCur& C, f32x16& s0, f32x16& s1) {
    const LAS short* VT = (const LAS short*)(F.lds + H_VT); const LAS short* KT = (const LAS short*)(F.lds + H_KT);
    const int vt = F.wave >> 1, kt0 = 2 * (F.wave & 1), r = F.lane & 31, hh = F.lane >> 5;
    const float d0 = C.d0, d1 = C.d1;
#pragma unroll
    for (int i = 0; i < 16; ++i) { s0[i] *= d0; s1[i] *= d1; }
#pragma unroll
    for (int st = 0; st < 4; ++st) {
        const int sx = 16 * st + 8 * hh;
        const bf16x8 af = *(const LAS bf16x8*)(VT + (32 * vt + r) * TROW + sx);
        const bf16x8 b0 = *(const LAS bf16x8*)(KT + (32 * kt0 + r) * TROW + sx), b1 = *(const LAS bf16x8*)(KT + (32 * (kt0 + 1) + r) * TROW + sx);
        s0 = __builtin_amdgcn_mfma_f32_32x32x16_bf16(af, b0, s0, 0, 0, 0);
        s1 = __builtin_amdgcn_mfma_f32_32x32x16_bf16(af, b1, s1, 0, 0, 0);
    }
}
DI void h1_phase(Frame& F) {
    float* LT = (float*)(F.ws + WS_LT);
    for (int ub = F.vcu; ub < (NCHUNK / 4) * 8; ub += F.G) {
        const int blk = ub >> 3, h = ub & 7;
        f32x16 s0, s1;
#pragma unroll
        for (int i = 0; i < 16; ++i) { s0[i] = 0.f; s1[i] = 0.f; }
        HRegs R; h_load_chunk<false>(F, (4 * blk) * 8 + h, R);
#pragma unroll 1
        for (int c = 0; c < 4; ++c) {
            const int uidx = (4 * blk + c) * 8 + h;
            __syncthreads();
            HCur C; h_stage_chunk<false>(F, R, C);
            if (c < 3) h_load_chunk<false>(F, uidx + 8, R);
            __syncthreads();
            h_state_update(F, C, s0, s1);
        }
        float* lt = LT + (size_t)ub * 16384; const int vt = F.wave >> 1, kt0 = 2 * (F.wave & 1);
#pragma unroll
        for (int i = 0; i < 16; ++i) { lt[ctile_off(vt, kt0, i, F.lane)] = s0[i]; lt[ctile_off(vt, kt0 + 1, i, F.lane)] = s1[i]; }
    }
    __syncthreads();
}
DI void h2_phase(Frame& F) {
    float* LT = (float*)(F.ws + WS_LT); const float* DL = (const float*)(F.ws + WS_DL);
    const int gt = F.vcu * 512 + F.tid, NGT = F.G * 512;
    for (int idx = gt; idx < 8 * 16384; idx += NGT) {
        const int h = idx >> 14, e = idx & 16383, k = 32 * ((e >> 10) & 3) + (e & 31);
        float st = 0.f;
        for (int b0 = 0; b0 < NCHUNK / 4; b0 += 4) {
            float L[4], d[4];
#pragma unroll
            for (int j = 0; j < 4; ++j) {
                L[j] = LT[(size_t)((b0 + j) * 8 + h) * 16384 + e];
                const float* dl = DL + (size_t)(4 * (b0 + j)) * DH + h * 128 + k;
                d[j] = (dl[0] * dl[DH]) * (dl[2 * DH] * dl[3 * DH]);
            }
#pragma unroll
            for (int j = 0; j < 4; ++j) { LT[(size_t)((b0 + j) * 8 + h) * 16384 + e] = st; st = d[j] * st + L[j]; }
        }
    }
}
DI void h3_phase(Frame& F) {
    const float* LT = (const float*)(F.ws + WS_LT); const bf16_t* SG = (const bf16_t*)(F.ws + WS_SG); bf16_t* DOB = (bf16_t*)(F.ws + WS_DOB); const float* NW = F.in[7];
    const int lane = F.lane, r = lane & 31, hh = lane >> 5;
    const LAS short* VT = (const LAS short*)(F.lds + H_VT); LAS short* ST = (LAS short*)(F.lds + H_ST); LAS float* NRM = (LAS float*)(F.lds + H_NRM);
    for (int ub = F.vcu; ub < (NCHUNK / 4) * 8; ub += F.G) {
        const int blk = ub >> 3, h = ub & 7, hc = h * 128;
        const int vts = F.wave >> 1, kt0 = 2 * (F.wave & 1);
        const int vto = F.wave & 3, ti = F.wave >> 2;
        f32x16 s0, s1;
        { const float* lt = LT + (size_t)ub * 16384;
#pragma unroll
          for (int i = 0; i < 16; ++i) { s0[i] = lt[ctile_off(vts, kt0, i, lane)]; s1[i] = lt[ctile_off(vts, kt0 + 1, i, lane)]; } }
        HRegs R; h_load_chunk<true>(F, (4 * blk) * 8 + h, R);
        f32x4 nwv[4];
#pragma unroll
        for (int g4 = 0; g4 < 4; ++g4) nwv[g4] = *(const f32x4*)(NW + hc + 32 * vto + 8 * g4 + 4 * hh);
#pragma unroll 1
        for (int c = 0; c < 4; ++c) {
            const int uidx = (4 * blk + c) * 8 + h, t0 = 64 * (4 * blk + c);
            u32x2 sgv[4];
#pragma unroll
            for (int g4 = 0; g4 < 4; ++g4) sgv[g4] = *(const u32x2*)(SG + (size_t)(t0 + 32 * ti + r) * DH + hc + 32 * vto + 8 * g4 + 4 * hh);
            __syncthreads();
            HCur C; h_stage_chunk<true>(F, R, C);
            if (c < 3) h_load_chunk<true>(F, uidx + 8, R);
#pragma unroll
            for (int i = 0; i < 16; ++i) { const int v = 32 * vts + 8 * (i >> 2) + 4 * hh + (i & 3);
                ST[v * SROW + 32 * kt0 + r] = (short)(pk2(s0[i], 0.f) & 0xffffu); ST[v * SROW + 32 * kt0 + 32 + r] = (short)(pk2(s1[i], 0.f) & 0xffffu); }
            __syncthreads();
            f32x16 O;
            {
                bf16x8 qf[8];
#pragma unroll
                for (int st = 0; st < 8; ++st) qf[st] = *(const LAS bf16x8*)(F.lds + H_QF + ((ti * 8 + st) * 64 + lane) * 16);
                f32x16 X[2];
#pragma unroll
                for (int i = 0; i < 16; ++i) { X[0][i] = 0.f; X[1][i] = 0.f; O[i] = 0.f; }
#pragma unroll
                for (int sb = 0; sb < 2; ++sb) {
                    if (sb <= ti) {
#pragma unroll
                        for (int st = 0; st < 8; ++st)
                            X[sb] = __builtin_amdgcn_mfma_f32_32x32x16_bf16(*(const LAS bf16x8*)(F.lds + H_KF + ((sb * 8 + st) * 64 + lane) * 16), qf[st], X[sb], 0, 0, 0);
                    }
                }
#pragma unroll
                for (int i = 0; i < 16; ++i) { const int sl = 8 * (i >> 2) + 4 * hh + (i & 3); const bool keep = sl <= r;
                    if (ti == 0) X[0][i] = keep ? X[0][i] : 0.f; else X[1][i] = keep ? X[1][i] : 0.f; }
#pragma unroll
                for (int sb = 0; sb < 2; ++sb) {
                    if (sb <= ti) {
#pragma unroll
                        for (int sp = 0; sp < 2; ++sp) {
                            u32x4 xb; xb.x = pk2(X[sb][8 * sp + 0], X[sb][8 * sp + 1]); xb.y = pk2(X[sb][8 * sp + 2], X[sb][8 * sp + 3]); xb.z = pk2(X[sb][8 * sp + 4], X[sb][8 * sp + 5]); xb.w = pk2(X[sb][8 * sp + 6], X[sb][8 * sp + 7]);
                            const int sbase = 32 * sb + 16 * sp + 4 * hh;
                            const s16x4 lo = *(const LAS s16x4*)(VT + (32 * vto + r) * TROW + sbase), hi = *(const LAS s16x4*)(VT + (32 * vto + r) * TROW + sbase + 8);
                            O = __builtin_amdgcn_mfma_f32_32x32x16_bf16(__builtin_shufflevector(lo, hi, 0, 1, 2, 3, 4, 5, 6, 7), __builtin_bit_cast(bf16x8, xb), O, 0, 0, 0);
                        }
                    }
                }
#pragma unroll
                for (int st = 0; st < 8; ++st)
                    O = __builtin_amdgcn_mfma_f32_32x32x16_bf16(*(const LAS bf16x8*)(ST + (32 * vto + r) * SROW + 16 * st + 8 * hh), qf[st], O, 0, 0, 0);
            }
            { float ss = 0.f;
#pragma unroll
              for (int i = 0; i < 16; ++i) ss += O[i] * O[i];
              ss += __shfl_xor(ss, 32);
              if (hh == 0) NRM[(ti * 4 + vto) * 32 + r] = ss; }
            h_state_update(F, C, s0, s1);
            __syncthreads();
            {
                const float ssum = (NRM[(ti * 4 + 0) * 32 + r] + NRM[(ti * 4 + 1) * 32 + r]) + (NRM[(ti * 4 + 2) * 32 + r] + NRM[(ti * 4 + 3) * 32 + r]);
                const float rn = rsqrtf(ssum * (1.f / 128.f) + EPS);
                const int tq = t0 + 32 * ti + r;
#pragma unroll
                for (int g4 = 0; g4 < 4; ++g4) {
                    const int v0 = 32 * vto + 8 * g4 + 4 * hh;
                    const f32x4 nw = nwv[g4];
                    const u32x2 sg = sgv[g4];
                    u32x2 w;
                    w.x = pk2(O[4 * g4 + 0] * rn * nw.x * bf_lo(sg.x), O[4 * g4 + 1] * rn * nw.y * bf_hi(sg.x));
                    w.y = pk2(O[4 * g4 + 2] * rn * nw.z * bf_lo(sg.y), O[4 * g4 + 3] * rn * nw.w * bf_hi(sg.y));
                    *(u32x2*)(DOB + (size_t)tq * DM + DP + hc + v0) = w;
                }
            }
        }
    }
    __syncthreads();
}
DI void fixup_panel(Frame& F, int pm) {
    const float* ZB = (const float*)(F.ws + WS_ZB); bf16_t* ACT = (bf16_t*)(F.ws + WS_ACT); const float* cw = F.in[13]; const float* cb = F.in[14];
    const f32x4 zero = {0.f, 0.f, 0.f, 0.f};
    for (int cg = F.tid; cg < DFF / 4; cg += NWAVES * 64) {
        const int c = 4 * cg, pg = 256 * (c >> 7) + (c & 127);
        f32x4 w0[2], w1[2], w2[2], bb[2];
#pragma unroll
        for (int hv = 0; hv < 2; ++hv) { const int oc = c + DFF * hv; w0[hv] = *(const f32x4*)(cw + oc); w1[hv] = *(const f32x4*)(cw + DFF2 + oc); w2[hv] = *(const f32x4*)(cw + 2 * DFF2 + oc); bb[hv] = *(const f32x4*)(cb + oc); }
#pragma unroll
        for (int bi = 0; bi < 4; ++bi) {
            const int b = 4 * pm + bi;
            f32x4 u0[2], u1[2];
#pragma unroll
            for (int hv = 0; hv < 2; ++hv) {
                const float* zb = ZB + (size_t)b * 4 * DFF2 + pg + 128 * hv;
                const f32x4 r0 = *(const f32x4*)zb, r1 = *(const f32x4*)(zb + DFF2);
                const f32x4 p2 = b > 0 ? *(const f32x4*)(zb - 2 * DFF2) : zero, p3 = b > 0 ? *(const f32x4*)(zb - DFF2) : zero;
                u0[hv] = bb[hv] + w2[hv] * r0 + w1[hv] * p3 + w0[hv] * p2;
                u1[hv] = bb[hv] + w2[hv] * r1 + w1[hv] * r0 + w0[hv] * p3;
            }
            u32x2 a, d;
            a.x = pk2(u0[0].x * sigm(u0[0].x) * u0[1].x, u0[0].y * sigm(u0[0].y) * u0[1].y); a.y = pk2(u0[0].z * sigm(u0[0].z) * u0[1].z, u0[0].w * sigm(u0[0].w) * u0[1].w);
            d.x = pk2(u1[0].x * sigm(u1[0].x) * u1[1].x, u1[0].y * sigm(u1[0].y) * u1[1].y); d.y = pk2(u1[0].z * sigm(u1[0].z) * u1[1].z, u1[0].w * sigm(u1[0].w) * u1[1].w);
            *(u32x2*)(ACT + (size_t)(64 * b) * DFF + c) = a;
            *(u32x2*)(ACT + (size_t)(64 * b + 1) * DFF + c) = d;
        }
    }
    asm volatile("s_waitcnt vmcnt(0)" ::: "memory");
    __syncthreads();
}
constexpr int CW_FIX = 32768;
DI void fixup_split(Frame& F, int pm, int pn, unsigned nown) {
    const float* ZB = (const float*)(F.ws + WS_ZB); bf16_t* ACT = (bf16_t*)(F.ws + WS_ACT); const float* cw = F.in[13]; const float* cb = F.in[14];
    constexpr int NG = DFF / 32;
    f32x4 w0[2][2], w1[2][2], w2[2][2], bb[2][2], r0[2][2], r1[2][2], p2[2][2], p3[2][2];
    int bq[2], cq[2]; bool live[2];
#pragma unroll
    for (int it = 0; it < 2; ++it) {
        const int item0 = F.tid + 512 * it; live[it] = item0 < 4 * NG;
        const int item = live[it] ? item0 : 4 * NG - 1, bi = item / NG, c = 4 * (pn * NG + (item - bi * NG)), pg = 256 * (c >> 7) + (c & 127), b = 4 * pm + bi;
        bq[it] = b; cq[it] = c;
#pragma unroll
        for (int hv = 0; hv < 2; ++hv) {
            const int oc = c + DFF * hv;
            w0[it][hv] = *(const f32x4*)(cw + oc); w1[it][hv] = *(const f32x4*)(cw + DFF2 + oc); w2[it][hv] = *(const f32x4*)(cw + 2 * DFF2 + oc); bb[it][hv] = *(const f32x4*)(cb + oc);
            const float* zb = ZB + (size_t)b * 4 * DFF2 + pg + 128 * hv; const float* zp = b > 0 ? zb - 2 * DFF2 : zb;
            r0[it][hv] = *(const f32x4*)zb; r1[it][hv] = *(const f32x4*)(zb + DFF2); p2[it][hv] = *(const f32x4*)zp; p3[it][hv] = *(const f32x4*)(zp + DFF2);
        }
    }
#pragma unroll
    for (int it = 0; it < 2; ++it) {
        f32x4 u0[2], u1[2]; const float pz = bq[it] > 0 ? 1.f : 0.f;
#pragma unroll
        for (int hv = 0; hv < 2; ++hv) {
            u0[hv] = bb[it][hv] + w2[it][hv] * r0[it][hv] + (w1[it][hv] * p3[it][hv] + w0[it][hv] * p2[it][hv]) * pz;
            u1[hv] = bb[it][hv] + w2[it][hv] * r1[it][hv] + w1[it][hv] * r0[it][hv] + (w0[it][hv] * p3[it][hv]) * pz;
        }
        u32x2 a, d;
        a.x = pk2(u0[0].x * sigm(u0[0].x) * u0[1].x, u0[0].y * sigm(u0[0].y) * u0[1].y); a.y = pk2(u0[0].z * sigm(u0[0].z) * u0[1].z, u0[0].w * sigm(u0[0].w) * u0[1].w);
        d.x = pk2(u1[0].x * sigm(u1[0].x) * u1[1].x, u1[0].y * sigm(u1[0].y) * u1[1].y); d.y = pk2(u1[0].z * sigm(u1[0].z) * u1[1].z, u1[0].w * sigm(u1[0].w) * u1[1].w);
        if (live[it]) {
            __hip_atomic_store((unsigned long long*)(ACT + (size_t)(64 * bq[it]) * DFF + cq[it]), __builtin_bit_cast(unsigned long long, a), __ATOMIC_RELAXED, __HIP_MEMORY_SCOPE_AGENT);
            __hip_atomic_store((unsigned long long*)(ACT + (size_t)(64 * bq[it] + 1) * DFF + cq[it]), __builtin_bit_cast(unsigned long long, d), __ATOMIC_RELAXED, __HIP_MEMORY_SCOPE_AGENT);
        }
    }
    asm volatile("s_waitcnt vmcnt(0)" ::: "memory");
    __syncthreads();
    if (F.tid == 0) {
        unsigned* cnt = (unsigned*)(F.ws + WS_CTL) + CW_FIX + 64 * pm;
        __builtin_amdgcn_fence(__ATOMIC_ACQUIRE, "agent");
        __hip_atomic_fetch_add(cnt, 1u, __ATOMIC_RELAXED, __HIP_MEMORY_SCOPE_AGENT);
        unsigned spins = 0;
        while (__hip_atomic_load(cnt, __ATOMIC_RELAXED, __HIP_MEMORY_SCOPE_AGENT) < nown) {
            __builtin_amdgcn_s_sleep(1);
            if (++spins > (1u << 22)) break;
        }
        asm volatile("s_waitcnt vmcnt(0)" ::: "memory");
    }
    __syncthreads();
}
DI void final_phase(Frame& F) {
    const float* SSQ = (const float*)(F.ws + WS_SSQ3); const float* wf = F.in[19]; float* out = F.out;
    const int gw = F.vcu * NWAVES + F.wave, NGW = F.G * NWAVES;
    for (int m = gw; m < S; m += NGW) {
        float s = F.lane < 32 ? SSQ[(size_t)m * 32 + F.lane] : 0.f;
        s = wave_sum(s);
        const float rr = rsqrtf(s * (1.f / DM) + EPS);
        f32x4* xr = (f32x4*)(out + (size_t)m * DM) + F.lane; const f32x4* wr_ = (const f32x4*)wf + F.lane;
#pragma unroll
        for (int j = 0; j < 8; ++j) { const f32x4 v = xr[64 * j], w = wr_[64 * j]; xr[64 * j] = v * rr * w; }
    }
}

struct Args { const float* in[20]; float* out; unsigned char* ws; int ph_lo, ph_hi, li, pad; };
constexpr int NPHASE = 10;
#define WGM_G1 2
#define WGM_G5 2
#define WGM_SQ 2

#define REP_P0 1
#define REP_P1 1
#define REP_P2 1
#define REP_P4 1
#define REP_P5 1
#define REP_P6 1
#define REP_P7 1
#define REP_BAR 1
#define KS_NTP 18
#define TS_PHASE 99

__global__ void __launch_bounds__(NWAVES * 64, 2) mk_fwd(Args args) {
    extern __shared__ __attribute__((aligned(16))) unsigned char lds[];
    Frame F;
    F.lds = (LAS unsigned char*)lds;
    F.tid = threadIdx.x; F.lane = F.tid & 63; F.wave = __builtin_amdgcn_readfirstlane(F.tid >> 6);
    F.G = gridDim.x; { const int bx = blockIdx.x; F.vcu = (F.G % 8 == 0) ? (bx % 8) * (F.G / 8) + bx / 8 : bx; }
    F.ws = args.ws; F.out = args.out; F.in = args.in;
    volatile LAS unsigned* MISC = (volatile LAS unsigned*)(F.lds + MISC_OFF);
    for (int u = F.tid; u < (LDS_BYTES - LDSCTL_OFF) / 4; u += NWAVES * 64) ((LAS unsigned*)(F.lds + LDSCTL_OFF))[u] = 0u;
    __syncthreads();
    const bool multi = (args.ph_hi - args.ph_lo) > 1;
    XcdBarrier bar; bar.bar = (unsigned*)(args.ws + WS_CTL) + CW_BAR + args.li * XCD_BAR_WORDS; bar.x = 0; bar.st = nullptr;
    if (multi) bar = xcd_barrier_post(bar.bar, MISC + 8);
    const int lo = args.ph_lo, hi = args.ph_hi;
    if (TS_PHASE == 0 && blockIdx.x == 0 && F.tid == 0) MISC[16] = (unsigned)__builtin_amdgcn_s_memrealtime();
#define IN(k) (lo <= (k) && (k) < hi)
#define SEAM(k) do { if (IN(k) && IN((k) + 1)) xcd_barrier(bar); if (TS_PHASE != 99 && blockIdx.x == 0 && F.tid == 0) { const unsigned long long _t = __builtin_amdgcn_s_memrealtime(); if ((k) + 1 == TS_PHASE) MISC[16] = (unsigned)_t; if ((k) == TS_PHASE) MISC[17] = (unsigned)_t; } } while (0)
    unsigned char* ws = args.ws;
    const int bid = (int)blockIdx.x;

#define BODY_P1 {     \
          \
        if (CONV_QUOTA > 0 && bid >= (int)F.G / 2) convert_rest(F, CONV_QUOTA); \
        pg8::Gemm g{(const bf16_t*)(ws + WS_XB), (const bf16_t*)(ws + WS_WIN), DM, DM, DM}; pg8::StaticOrder So; So.init(S, DIN, F.G, bid, WGM_G1); \
        EpiProj E{ws, F.out}; \
        pg8::gemm_phase<EpiProj, true>(F.lds, g, So, E); \
        { pg8::Gemm gf{(const bf16_t*)(ws + WS_WAT), (const bf16_t*)(ws + WS_WMX), DP, DP, 256}; pg8::FoldOrder Sf{bid, F.G / 2}; EpiBf Ef{(bf16_t*)(ws + WS_WAB), DM}; \
          pg8::gemm_phase<EpiBf, false, pg8::FoldOrder>(F.lds, gf, Sf, Ef); } \
        convert_rest(F); }
#define BODY_P5 {     \
        pg8::Gemm g{(const bf16_t*)(ws + WS_DOB), (const bf16_t*)(ws + WS_WAB), DM, DM, DM}; pg8::StaticOrder So; So.init(S, DM, F.G, bid, WGM_SQ); \
        EpiMerge E{(const bf16_t*)F.out, (const bf16_t*)F.out + (size_t)S * DM, (bf16_t*)(ws + WS_MG)}; \
        pg8::gemm_phase<EpiMerge, true>(F.lds, g, So, E); }
#define BODY_P6 {     \
        pg8::Gemm g{(const bf16_t*)(ws + WS_MG), (const bf16_t*)(ws + WS_WOUT), DM, DM, DM}; pg8::StaticOrder So; So.init(S, DM, F.G, bid, WGM_SQ); \
        EpiResB<true> E{(const void*)(ws + WS_XB), (bf16_t*)(ws + WS_XB), (float*)(ws + WS_SSQ1)}; \
        pg8::gemm_phase<EpiResB<true>, true>(F.lds, g, So, E); }
#define BODY_P7 {     \
        pg8::Gemm g{(const bf16_t*)(ws + WS_XB), (const bf16_t*)(ws + WS_WUP), DM, DM, DM}; pg8::StaticOrder So; So.init(S, DFF2, F.G, bid, WGM_G5); \
        pg8::SplitTail Ss; Ss.init(S, DFF2, F.G, bid, WGM_G5, DM / 64, KS_NTP); if (Ss.split) So.lim = Ss.full * F.G; \
        EpiUp E{ws, F.in[13], F.in[14], F.lds}; \
        pg8::gemm_phase<EpiUp, true>(F.lds, g, So, E); \
        { EpiUpKS Ek{E}; pg8::gemm_phase<EpiUpKS, true, pg8::SplitTail>(F.lds, g, Ss, Ek); } \
        {   \
          pg8::Gemm g2{(const bf16_t*)(ws + WS_PB), (const bf16_t*)(ws + WS_WPLE), PLE, PLE, PLE}; pg8::TailOrder2 St; St.init(S, DM, F.G, bid, Ss.rem, Ss.split); \
          EpiBf E2{(bf16_t*)(ws + WS_E), DM}; \
          pg8::gemm_phase<EpiBf, false, pg8::TailOrder2>(F.lds, g2, St, E2); } }

    if (IN(0)) { for (int rp = 0; rp <= args.pad; ++rp) p0_prologue(F); } SEAM(0);
    if (multi) for (int rb = 1; rb < REP_BAR; ++rb) xcd_barrier(bar);
    if (IN(1)) { BODY_P1 if (REP_P1 > 1) BODY_P1 } SEAM(1);
    if (IN(2)) {
        if (F.G * 512 == (S / 8) * 128) { PoolRegs P; pool_load(F, P); h1_phase(F); pool_finish(F, P); }
        else { h1_phase(F); pool_phase(F); }
    } SEAM(2);
    if (IN(3)) { h2_phase(F); } SEAM(3);
    if (IN(4)) { h3_phase(F); if (REP_P4 > 1) h3_phase(F); if (REP_P4 > 2) h3_phase(F); } SEAM(4);
    if (IN(5)) { BODY_P5 if (REP_P5 > 1) BODY_P5 } SEAM(5);
    if (IN(6)) { BODY_P6 if (REP_P6 > 1) BODY_P6 } SEAM(6);
    if (IN(7)) { BODY_P7 if (REP_P7 > 1) BODY_P7 } SEAM(7);
    if (IN(8)) {
        pg8::Gemm g{(const bf16_t*)(ws + WS_ACT), (const bf16_t*)(ws + WS_WDOWN), DFF, DFF, DFF}; pg8::StaticOrder So; So.init(S, DM, F.G, bid, WGM_SQ);
        if (F.G == (S / 256) * (DM / 256)) { Unit u0; if (So.next(0, u0)) fixup_split(F, u0.pm, u0.pn, DM / 256); }
        else { Unit u0; for (int i = 0; So.next(i, u0); ++i) fixup_panel(F, u0.pm); }
        EpiResB<true> E{(const void*)(ws + WS_XB), (bf16_t*)(ws + WS_XB), (float*)(ws + WS_SSQ2)};
        pg8::gemm_phase<EpiResB<true>, true>(F.lds, g, So, E);
    } SEAM(8);
    if (IN(9)) {
        pg8::Gemm g{(const bf16_t*)(ws + WS_XB), (const bf16_t*)(ws + WS_WPG), DM, DM, DM}; pg8::StaticOrder So; So.init(S, DM, F.G, bid, WGM_SQ);
        EpiPle E{ws, F.out, F.in[19]};
        pg8::gemm_phase<EpiPle, true>(F.lds, g, So, E);
    }
    if (TS_PHASE != 99 && blockIdx.x == 0 && F.tid == 0) { const unsigned long long t1 = __builtin_amdgcn_s_memrealtime(); if (TS_PHASE == 9) MISC[17] = (unsigned)t1; unsigned span = MISC[17] - MISC[16]; if (span > 100000u) span = 100000u;
        while ((unsigned)(__builtin_amdgcn_s_memrealtime() - t1) < 2u * span) __builtin_amdgcn_s_sleep(8); }
#undef IN
#undef SEAM
}

#ifndef MK_N_LAUNCHES
#define MK_N_LAUNCHES 1
#endif
extern "C" void kernel_launch(void* const* d_in, const int* in_sizes, int n_in, void* d_out, int out_size, void* d_ws, size_t ws_size, hipStream_t stream) {
    static int grid = 0;
    if (grid == 0) {
        if (n_in != 20 || in_sizes[0] != S * DM || out_size != S * DM || ws_size < WS_END) { fprintf(stderr, "kernel_launch: unexpected shapes / workspace (%zu < %zu)\n", ws_size, (size_t)WS_END); grid = -1; return; }
        int dev = 0, cus = 0, per_cu = 0;
        if (hipGetDevice(&dev) != hipSuccess || hipDeviceGetAttribute(&cus, hipDeviceAttributeMultiprocessorCount, dev) != hipSuccess) { grid = -1; return; }
        if (hipFuncSetAttribute((const void*)mk_fwd, hipFuncAttributeMaxDynamicSharedMemorySize, LDS_BYTES) != hipSuccess) { fprintf(stderr, "kernel_launch: hipFuncSetAttribute failed\n"); grid = -1; return; }
        if (hipOccupancyMaxActiveBlocksPerMultiprocessor(&per_cu, (const void*)mk_fwd, NWAVES * 64, LDS_BYTES) != hipSuccess || per_cu < 1) { fprintf(stderr, "kernel_launch: occupancy query says %d\n", per_cu); per_cu = 1; }
        (void)hipGetLastError();
        grid = cus;
    }
    if (grid < 0) return;
    (void)hipMemsetAsync((char*)d_ws + WS_CTL, 0, CTL_ZERO_BYTES, stream);
    Args a{};
    for (int i = 0; i < 20; ++i) a.in[i] = (const float*)d_in[i];
    a.out = (float*)d_out; a.ws = (unsigned char*)d_ws; a.pad = REP_P0 - 1;
    if (MK_N_LAUNCHES == 1) {
        a.ph_lo = 0; a.ph_hi = NPHASE; a.li = 0;
        hipLaunchKernelGGL(mk_fwd, dim3(grid), dim3(NWAVES * 64), LDS_BYTES, stream, a);
    } else {
        for (int ph = 0; ph < NPHASE; ++ph) { a.ph_lo = ph; a.ph_hi = ph + 1; a.li = 0; hipLaunchKernelGGL(mk_fwd, dim3(grid), dim3(NWAVES * 64), LDS_BYTES, stream, a); }
    }
}
```
